# Optimizing an MI355X kernel written in HIP

```python
import jax, jax.numpy as jnp
from jax import lax
import numpy as np

D_MODEL = 1024
BATCH = 4
SEQ = 8192
DEPTH = 1

SSM_WIDTH = D_MODEL // 2
SSM_GROUP = 16
SSM_GROUPS = SSM_WIDTH // SSM_GROUP
SSM_STATE = 64
NSA_HEADS = 8
NSA_KV_GROUPS = 2
HEADS_PER_GROUP = NSA_HEADS // NSA_KV_GROUPS
HEAD_DIM = 64
NSA_WIDTH = NSA_HEADS * HEAD_DIM
CMP_STRIDE = 16
CMP_BLOCK = 2 * CMP_STRIDE
CMP_HIDDEN = 2 * HEAD_DIM
SEL_BLOCK = 64
SEL_TOP_K = 16
WINDOW = 512
Q_BLOCK = 128
D_FF = 4 * D_MODEL
N_MIXERS = 2
KV_WIDTH = 3 * 2 * NSA_KV_GROUPS * HEAD_DIM
IN_WIDTH = SSM_WIDTH + NSA_WIDTH + KV_WIDTH + 3 * NSA_HEADS + N_MIXERS * D_MODEL
EPS = 1e-6
NEG_INF = -1e30
FORCE_BONUS = 1e4

kernel_name = "hybrid_s5_nsa_gated_block"


def rmsnorm(x, g):
    xf = x.astype(jnp.float32)
    y = xf * lax.rsqrt(jnp.mean(xf * xf, axis=-1, keepdims=True) + EPS)
    return (y * g.astype(jnp.float32)).astype(x.dtype)


def masked_softmax(s, mask):
    s = jnp.where(mask, s.astype(jnp.float32), NEG_INF)
    p = jax.nn.softmax(s, axis=-1)
    return jnp.where(mask, p, 0.0)


def alibi_slopes():
    h = jnp.arange(1, NSA_HEADS + 1, dtype=jnp.float32)
    return jnp.exp2(-8.0 * h / NSA_HEADS).reshape(NSA_KV_GROUPS, HEADS_PER_GROUP, 1, 1)


def s5_mixer(u, a_re, a_im, log_dt, b_re, b_im, c_re, c_im, d_skip, w_glu, b_glu):
    bsz, s, _ = u.shape
    f32 = jnp.float32
    ug = u.astype(f32).reshape(bsz, s, SSM_GROUPS, SSM_GROUP)
    ar = a_re.astype(f32)
    ai = a_im.astype(f32)
    dt = jnp.exp(log_dt.astype(f32))[:, None]
    mag = jnp.exp(ar * dt)
    abar_re = mag * jnp.cos(ai * dt)
    abar_im = mag * jnp.sin(ai * dt)
    den = ar * ar + ai * ai
    nr = abar_re - 1.0
    fr = (nr * ar + abar_im * ai) / den
    fi = (abar_im * ar - nr * ai) / den
    br = b_re.astype(f32)
    bi = b_im.astype(f32)
    bbar_re = fr[..., None] * br - fi[..., None] * bi
    bbar_im = fr[..., None] * bi + fi[..., None] * br
    bu_re = jnp.einsum('bsgc,gpc->bsgp', ug, bbar_re)
    bu_im = jnp.einsum('bsgc,gpc->bsgp', ug, bbar_im)
    a_seq_re = jnp.broadcast_to(abar_re, (1, s, SSM_GROUPS, SSM_STATE))
    a_seq_im = jnp.broadcast_to(abar_im, (1, s, SSM_GROUPS, SSM_STATE))

    def combine(left, right):
        a1r, a1i, b1r, b1i = left
        a2r, a2i, b2r, b2i = right
        return (a2r * a1r - a2i * a1i, a2r * a1i + a2i * a1r,
                a2r * b1r - a2i * b1i + b2r, a2r * b1i + a2i * b1r + b2i)

    _, _, xr, xi = lax.associative_scan(combine, (a_seq_re, a_seq_im, bu_re, bu_im), axis=1)
    y = (jnp.einsum('bsgp,gcp->bsgc', xr, c_re.astype(f32))
         - jnp.einsum('bsgp,gcp->bsgc', xi, c_im.astype(f32))
         + d_skip.astype(f32).reshape(SSM_GROUPS, SSM_GROUP) * ug).reshape(bsz, s, SSM_WIDTH)
    yg = jax.nn.gelu(y)
    out = yg * jax.nn.sigmoid(yg @ w_glu.astype(f32) + b_glu.astype(f32))
    return out.astype(u.dtype)


def compress_blocks(tok, pe, w1, w2):
    bsz, g, s, d = tok.shape
    chunks = tok.reshape(bsz, g, s // CMP_STRIDE, CMP_STRIDE, d)
    blocks = jnp.concatenate([chunks[:, :, :-1], chunks[:, :, 1:]], axis=3) + pe
    flat = blocks.reshape(bsz, g, s // CMP_STRIDE - 1, CMP_BLOCK * d)
    return jax.nn.gelu(flat @ w1) @ w2


def nsa_mixer(q, kv, gate_logits, cmp_pe_k, cmp_pe_v, cmp_wk1, cmp_wk2, cmp_wv1, cmp_wv2,
              q_norm_g, k_norm_g):
    bsz, s, _ = q.shape
    G, HG, d = NSA_KV_GROUPS, HEADS_PER_GROUP, HEAD_DIM
    f32 = jnp.float32
    q = rmsnorm(q.reshape(bsz, s, G, HG, d), q_norm_g).transpose(0, 2, 3, 1, 4)
    kv = kv.reshape(bsz, s, 3, 2, G, d).transpose(2, 3, 0, 4, 1, 5)
    kc = rmsnorm(compress_blocks(kv[0, 0], cmp_pe_k, cmp_wk1, cmp_wk2), k_norm_g[0])
    vc = compress_blocks(kv[0, 1], cmp_pe_v, cmp_wv1, cmp_wv2)
    n_cmp = kc.shape[2]
    n_sel = s // SEL_BLOCK
    k_top = min(SEL_TOP_K, n_sel)
    ks = rmsnorm(kv[1, 0], k_norm_g[1]).reshape(bsz, G, n_sel, SEL_BLOCK, d)
    vs = kv[1, 1].reshape(bsz, G, n_sel, SEL_BLOCK, d)
    pad = ((0, 0), (0, 0), (WINDOW, 0), (0, 0))
    kw = jnp.pad(rmsnorm(kv[2, 0], k_norm_g[2]), pad)
    vw = jnp.pad(kv[2, 1], pad)
    gates = jax.nn.sigmoid(gate_logits.reshape(bsz, s, 3, G, HG).astype(f32))
    gates = gates.astype(q.dtype).transpose(0, 3, 4, 1, 2)
    slopes = alibi_slopes()
    scale = HEAD_DIM ** -0.5
    c_end = (jnp.arange(n_cmp) * CMP_STRIDE + CMP_BLOCK - 1).astype(f32)
    blk_ids = jnp.arange(n_sel)
    bi = jnp.arange(bsz)[:, None, None, None]
    gi = jnp.arange(G)[None, :, None, None]
    sel_off = jnp.arange(SEL_BLOCK)
    win_off = jnp.arange(Q_BLOCK + WINDOW)

    def query_block(i):
        qs = i * Q_BLOCK
        qb = lax.dynamic_slice_in_dim(q, qs, Q_BLOCK, axis=3)
        gb = lax.dynamic_slice_in_dim(gates, qs, Q_BLOCK, axis=3)
        t = qs + jnp.arange(Q_BLOCK)
        tf = t.astype(f32)
        dist_c = tf[:, None] - c_end[None, :]
        sc = jnp.einsum('bghqd,bgcd->bghqc', qb, kc).astype(f32) * scale - slopes * dist_c
        pc = masked_softmax(sc, dist_c >= 0)
        o_cmp = jnp.einsum('bghqc,bgcd->bghqd', pc.astype(vc.dtype), vc)
        imp = jnp.pad(pc.sum(axis=2), ((0, 0), (0, 0), (0, 0), (0, 1)))
        chunks = imp.reshape(bsz, G, Q_BLOCK, n_sel, SEL_BLOCK // CMP_STRIDE)
        prev = jnp.pad(chunks[..., :-1, -1], ((0, 0), (0, 0), (0, 0), (1, 0)))
        imp_sel = chunks.sum(axis=-1) + prev
        cur = t // SEL_BLOCK
        valid = blk_ids[None, :] <= cur[:, None]
        forced = ((blk_ids[None, :] == 0) | (blk_ids[None, :] == cur[:, None])
                  | (blk_ids[None, :] == cur[:, None] - 1))
        imp_sel = jnp.where(valid, imp_sel + jnp.where(forced, FORCE_BONUS, 0.0), NEG_INF)
        _, idx = lax.top_k(imp_sel, k_top)
        k_g = ks[bi, gi, idx].reshape(bsz, G, Q_BLOCK, k_top * SEL_BLOCK, d)
        v_g = vs[bi, gi, idx].reshape(bsz, G, Q_BLOCK, k_top * SEL_BLOCK, d)
        pos = (idx[..., None] * SEL_BLOCK + sel_off).reshape(bsz, G, Q_BLOCK, k_top * SEL_BLOCK)
        dist_s = (t[None, None, :, None] - pos).astype(f32)[:, :, None]
        ss = jnp.einsum('bghqd,bgqkd->bghqk', qb, k_g).astype(f32) * scale - slopes * dist_s
        ps = masked_softmax(ss, dist_s >= 0)
        o_slc = jnp.einsum('bghqk,bgqkd->bghqd', ps.astype(v_g.dtype), v_g)
        kwb = lax.dynamic_slice_in_dim(kw, qs, Q_BLOCK + WINDOW, axis=2)
        vwb = lax.dynamic_slice_in_dim(vw, qs, Q_BLOCK + WINDOW, axis=2)
        s_pos = qs - WINDOW + win_off
        dist_w = t[:, None] - s_pos[None, :]
        mask_w = (dist_w >= 0) & (dist_w < WINDOW) & (s_pos[None, :] >= 0)
        sw = jnp.einsum('bghqd,bgkd->bghqk', qb, kwb).astype(f32) * scale - slopes * dist_w.astype(f32)
        pw = masked_softmax(sw, mask_w)
        o_win = jnp.einsum('bghqk,bgkd->bghqd', pw.astype(vwb.dtype), vwb)
        return gb[..., 0:1] * o_cmp + gb[..., 1:2] * o_slc + gb[..., 2:3] * o_win

    out = lax.map(query_block, jnp.arange(s // Q_BLOCK))
    return out.transpose(1, 0, 4, 2, 3, 5).reshape(bsz, s, NSA_WIDTH)


def setup_inputs(seed: int = 0) -> dict:
    key = jax.random.key(seed)
    ks = jax.random.split(key, 32)
    L = DEPTH
    f32 = jnp.float32

    def nrm(k, shape, scale):
        return jax.random.normal(k, shape, f32) * scale

    return {
        'x': nrm(ks[0], (BATCH, SEQ, D_MODEL), 1.0),
        'norm1_g': 1.0 + nrm(ks[1], (L, D_MODEL), 0.02),
        'w_in': nrm(ks[2], (L, D_MODEL, IN_WIDTH), D_MODEL ** -0.5),
        'ssm_a_re': -0.5 + nrm(ks[3], (L, SSM_GROUPS, SSM_STATE), 0.01),
        'ssm_a_im': np.pi * jnp.arange(SSM_STATE, dtype=f32) + nrm(ks[4], (L, SSM_GROUPS, SSM_STATE), 0.01),
        'ssm_log_dt': jax.random.uniform(ks[5], (L, SSM_GROUPS), f32, np.log(1e-3), np.log(1e-1)),
        'ssm_b_re': nrm(ks[6], (L, SSM_GROUPS, SSM_STATE, SSM_GROUP), (2 * SSM_GROUP) ** -0.5),
        'ssm_b_im': nrm(ks[7], (L, SSM_GROUPS, SSM_STATE, SSM_GROUP), (2 * SSM_GROUP) ** -0.5),
        'ssm_c_re': nrm(ks[8], (L, SSM_GROUPS, SSM_GROUP, SSM_STATE), SSM_STATE ** -0.5),
        'ssm_c_im': nrm(ks[9], (L, SSM_GROUPS, SSM_GROUP, SSM_STATE), SSM_STATE ** -0.5),
        'ssm_d': nrm(ks[10], (L, SSM_WIDTH), 1.0),
        'ssm_w_glu': nrm(ks[11], (L, SSM_WIDTH, SSM_WIDTH), SSM_WIDTH ** -0.5),
        'ssm_b_glu': nrm(ks[12], (L, SSM_WIDTH), 0.01),
        'cmp_pe_k': nrm(ks[13], (L, CMP_BLOCK, HEAD_DIM), 0.1),
        'cmp_pe_v': nrm(ks[14], (L, CMP_BLOCK, HEAD_DIM), 0.1),
        'cmp_wk1': nrm(ks[15], (L, CMP_BLOCK * HEAD_DIM, CMP_HIDDEN), (CMP_BLOCK * HEAD_DIM) ** -0.5),
        'cmp_wk2': nrm(ks[16], (L, CMP_HIDDEN, HEAD_DIM), CMP_HIDDEN ** -0.5),
        'cmp_wv1': nrm(ks[17], (L, CMP_BLOCK * HEAD_DIM, CMP_HIDDEN), (CMP_BLOCK * HEAD_DIM) ** -0.5),
        'cmp_wv2': nrm(ks[18], (L, CMP_HIDDEN, HEAD_DIM), CMP_HIDDEN ** -0.5),
        'q_norm_g': 1.0 + nrm(ks[19], (L, HEAD_DIM), 0.02),
        'k_norm_g': 1.0 + nrm(ks[20], (L, 3, HEAD_DIM), 0.02),
        'w_proj_ssm': nrm(ks[21], (L, SSM_WIDTH, D_MODEL), SSM_WIDTH ** -0.5),
        'w_proj_nsa': nrm(ks[22], (L, NSA_WIDTH, D_MODEL), NSA_WIDTH ** -0.5),
        'w_out': nrm(ks[23], (L, D_MODEL, D_MODEL), D_MODEL ** -0.5),
        'norm2_g': 1.0 + nrm(ks[24], (L, D_MODEL), 0.02),
        'w_up': nrm(ks[25], (L, D_MODEL, D_FF), D_MODEL ** -0.5),
        'w_down': nrm(ks[26], (L, D_FF, D_MODEL), D_FF ** -0.5),
    }


def reference(x, norm1_g, w_in, ssm_a_re, ssm_a_im, ssm_log_dt, ssm_b_re, ssm_b_im, ssm_c_re, ssm_c_im,
              ssm_d, ssm_w_glu, ssm_b_glu, cmp_pe_k, cmp_pe_v, cmp_wk1, cmp_wk2, cmp_wv1, cmp_wv2,
              q_norm_g, k_norm_g, w_proj_ssm, w_proj_nsa, w_out, norm2_g, w_up, w_down):
    bsz, s, _ = x.shape
    o1 = SSM_WIDTH
    o2 = o1 + NSA_WIDTH
    o3 = o2 + KV_WIDTH
    o4 = o3 + 3 * NSA_HEADS
    for l in range(DEPTH):
        h = rmsnorm(x, norm1_g[l])
        hp = h @ w_in[l]
        y_ssm = s5_mixer(hp[..., :o1], ssm_a_re[l], ssm_a_im[l], ssm_log_dt[l], ssm_b_re[l], ssm_b_im[l],
                         ssm_c_re[l], ssm_c_im[l], ssm_d[l], ssm_w_glu[l], ssm_b_glu[l])
        y_nsa = nsa_mixer(hp[..., o1:o2], hp[..., o2:o3], hp[..., o3:o4], cmp_pe_k[l], cmp_pe_v[l],
                          cmp_wk1[l], cmp_wk2[l], cmp_wv1[l], cmp_wv2[l], q_norm_g[l], k_norm_g[l])
        gate = jax.nn.sigmoid(hp[..., o4:].reshape(bsz, s, N_MIXERS, D_MODEL))
        merged = gate[..., 0, :] * (y_ssm @ w_proj_ssm[l]) + gate[..., 1, :] * (y_nsa @ w_proj_nsa[l])
        x = x + merged @ w_out[l]
        h2 = rmsnorm(x, norm2_g[l])
        x = x + jnp.square(jax.nn.relu(h2 @ w_up[l])) @ w_down[l]
    return x
```

```cpp
#include <hip/hip_runtime.h>
#include <cstdio>
#include <cstdint>

typedef unsigned short bf16_t;
typedef short bf16x8 __attribute__((ext_vector_type(8)));
typedef float f32x4 __attribute__((ext_vector_type(4)));
typedef unsigned u32x4 __attribute__((ext_vector_type(4)));

constexpr int NB = 4, SEQ = 8192, DM = 1024, NTOK = NB * SEQ;
constexpr int NIN = 3968;
constexpr int DFF = 4096;
constexpr int CHUNK = 128, NCHUNK = SEQ / CHUNK;
constexpr float EPS = 1e-6f;

constexpr size_t MiB = 1024 * 1024;
constexpr size_t al256(size_t x) { return (x + 255) & ~(size_t)255; }
constexpr size_t O_WT_IN = 0;
constexpr size_t O_WT_GLU = O_WT_IN + (size_t)NIN * 1024 * 2;
constexpr size_t O_WT_PS = O_WT_GLU + 512 * 512 * 2;
constexpr size_t O_WT_PN = O_WT_PS + 1024 * 512 * 2;
constexpr size_t O_WT_OUT = O_WT_PN + 1024 * 512 * 2;
constexpr size_t O_WT_UP = O_WT_OUT + 1024 * 1024 * 2;
constexpr size_t O_WT_DOWN = O_WT_UP + (size_t)4096 * 1024 * 2;
constexpr size_t O_WT_CK1 = O_WT_DOWN + (size_t)4096 * 1024 * 2;
constexpr size_t O_WT_CV1 = O_WT_CK1 + 128 * 2048 * 2;
constexpr size_t O_WT_CK2 = O_WT_CV1 + 128 * 2048 * 2;
constexpr size_t O_WT_CV2 = O_WT_CK2 + 64 * 128 * 2;
constexpr size_t O_B1K = O_WT_CV2 + 64 * 128 * 2;
constexpr size_t O_B1V = O_B1K + 512;
constexpr size_t O_ABAR = O_B1V + 512;
constexpr size_t O_AL = O_ABAR + 32 * 64 * 2 * 4;
constexpr size_t O_BBT = O_AL + 32 * 64 * 2 * 4;
constexpr size_t O_CT = O_BBT + 32 * 128 * 16 * 2;
constexpr size_t O_ENDS = O_CT + 32 * 16 * 128 * 2;
constexpr size_t O_SSQ = O_ENDS + (size_t)NB * NCHUNK * 32 * 64 * 2 * 4;
constexpr size_t O_GATES = O_SSQ + (size_t)NTOK * 4;
constexpr size_t O_KC = O_GATES + (size_t)NTOK * 24 * 4;
constexpr size_t O_VC = O_KC + 8 * 512 * 64 * 2;
constexpr size_t O_REGA = al256(O_VC + 8 * 512 * 64 * 2 + 4096);
constexpr size_t O_XN = O_REGA;
constexpr size_t O_YSSM = O_XN;
constexpr size_t O_YNSA = O_XN + 32 * MiB;
constexpr size_t O_U = O_XN + 64 * MiB;
constexpr size_t O_QN = O_U + 32 * MiB;
constexpr size_t O_KCIN = O_QN + 32 * MiB;
constexpr size_t O_VCIN = O_KCIN + 8 * MiB;
constexpr size_t O_KS = O_VCIN + 8 * MiB;
constexpr size_t O_VS = O_KS + 8 * MiB;
constexpr size_t O_KW = O_VS + 8 * MiB;
constexpr size_t O_VW = O_KW + 8 * MiB;
constexpr size_t O_YG = O_VW + 8 * MiB;
constexpr size_t O_FF = O_REGA;
constexpr size_t O_REGB = O_REGA + 256 * MiB;
constexpr size_t O_MG = O_REGB;
constexpr size_t O_X1B = O_REGB;
constexpr size_t O_MERGED = O_REGB + 128 * MiB;
constexpr size_t WS_END = O_MERGED + 64 * MiB;
static_assert(O_YG + 32 * MiB <= O_REGB, "region A overflow");

__device__ __forceinline__ float bf2f(bf16_t h) { return __uint_as_float(((unsigned)h) << 16); }
__device__ __forceinline__ bf16_t f2bf(float f) { unsigned u = __float_as_uint(f); u += 0x7fffu + ((u >> 16) & 1u); return (bf16_t)(u >> 16); }
__device__ __forceinline__ unsigned pk2(float lo, float hi) { return (unsigned)f2bf(lo) | ((unsigned)f2bf(hi) << 16); }
__device__ __forceinline__ float sigmoidf_(float x) { return 1.0f / (1.0f + __expf(-x)); }
__device__ __forceinline__ float gelu_tanh(float x) { const float u = 0.7978845608028654f * (x + 0.044715f * x * x * x); return 0.5f * x * (1.0f + tanhf(u)); }
__device__ __forceinline__ float wave_sum(float v) {
#pragma unroll
    for (int o = 1; o < 64; o <<= 1) v += __shfl_xor(v, o);
    return v;
}
__device__ __forceinline__ float wave_max(float v) {
#pragma unroll
    for (int o = 1; o < 64; o <<= 1) v = fmaxf(v, __shfl_xor(v, o));
    return v;
}

struct Ptrs {
    const float* in[27];
    float* out;
    unsigned char* ws;
};

struct TrDesc { const float* src; bf16_t* dst; const float* kscale; int K, N, ldsrc, mode, tiles_n, tile0; };
constexpr int NTR = 11;
struct TrTable { TrDesc d[NTR]; int total; int pad; };

__device__ __forceinline__ int in_col(int n) {
    if (n < 1792) return n;
    if (n < 3840) return n + 24;
    if (n < 3864) return n - 3840 + 1792;
    return -1;
}

__device__ void transpose_phase(const TrTable& tt, char* smem, int vb, int nvb) {
    float* tile = (float*)smem;
    const int tid = threadIdx.x;
    for (int it = vb; it < tt.total; it += nvb) {
        int di = 0;
#pragma unroll
        for (int i = 1; i < NTR; ++i) if (it >= tt.d[i].tile0) di = i;
        const TrDesc& d = tt.d[di];
        const int lt = it - d.tile0, tn = lt % d.tiles_n, tk = lt / d.tiles_n, k0 = tk * 64, n0 = tn * 64;
#pragma unroll 4
        for (int i = 0; i < 16; ++i) {
            const int kk = (tid >> 6) + 4 * i, nn = tid & 63;
            int col = n0 + nn; if (d.mode == 1) col = in_col(col);
            float v = 0.f;
            if (col >= 0) v = d.src[(size_t)(k0 + kk) * d.ldsrc + col];
            if (d.kscale) v *= d.kscale[k0 + kk];
            tile[kk * 65 + nn] = v;
        }
        __syncthreads();
#pragma unroll 4
        for (int i = 0; i < 16; ++i) {
            const int nn = (tid >> 6) + 4 * i, kk = tid & 63;
            d.dst[(size_t)(n0 + nn) * d.K + k0 + kk] = f2bf(tile[kk * 65 + nn]);
        }
        __syncthreads();
    }
}

__device__ void consts_phase(const Ptrs& P, int vb, int nvb) {
    const int gt = vb * 256 + threadIdx.x, ngt = nvb * 256;
    unsigned char* ws = P.ws;
    for (int i = gt; i < 32 * 64; i += ngt) {
        const int g = i >> 6, p = i & 63;
        const double ar = (double)P.in[3][i], ai = (double)P.in[4][i], dt = exp((double)P.in[5][g]);
        const double mag = exp(ar * dt), abr = mag * cos(ai * dt), abi = mag * sin(ai * dt);
        const double den = ar * ar + ai * ai, nr = abr - 1.0;
        const double fr = (nr * ar + abi * ai) / den, fi = (abi * ar - nr * ai) / den;
        float* ABAR = (float*)(ws + O_ABAR); float* AL = (float*)(ws + O_AL);
        ABAR[i * 2] = (float)abr; ABAR[i * 2 + 1] = (float)abi;
        double pr = abr, pi = abi;
        for (int s = 0; s < 7; ++s) { const double nr2 = pr * pr - pi * pi, ni2 = 2.0 * pr * pi; pr = nr2; pi = ni2; }
        AL[i * 2] = (float)pr; AL[i * 2 + 1] = (float)pi;
        bf16_t* BBT = (bf16_t*)(ws + O_BBT);
        for (int c = 0; c < 16; ++c) {
            const double br = (double)P.in[6][(size_t)i * 16 + c], bi = (double)P.in[7][(size_t)i * 16 + c];
            BBT[((size_t)g * 128 + p) * 16 + c] = f2bf((float)(fr * br - fi * bi));
            BBT[((size_t)g * 128 + 64 + p) * 16 + c] = f2bf((float)(fr * bi + fi * br));
        }
        bf16_t* CT = (bf16_t*)(ws + O_CT);
        for (int c = 0; c < 16; ++c) {
            CT[((size_t)g * 16 + c) * 128 + p] = f2bf(P.in[8][((size_t)g * 16 + c) * 64 + p]);
            CT[((size_t)g * 16 + c) * 128 + 64 + p] = f2bf(-P.in[9][((size_t)g * 16 + c) * 64 + p]);
        }
    }
    for (int i = gt; i < 256; i += ngt) {
        const int n = i & 127; const bool isv = i >= 128;
        const float* pe = P.in[isv ? 14 : 13]; const float* w1 = P.in[isv ? 17 : 15];
        float s = 0.f;
        for (int k = 0; k < 2048; ++k) s += pe[k] * w1[(size_t)k * 128 + n];
        ((float*)(ws + (isv ? O_B1V : O_B1K)))[n] = s;
    }
    float* SSQ = (float*)(ws + O_SSQ);
    for (int i = gt; i < NTOK; i += ngt) SSQ[i] = 0.f;
}

__device__ void rmsnorm1_phase(const Ptrs& P, int vb, int nvb) {
    const int lane = threadIdx.x & 63, gw = vb * 4 + (threadIdx.x >> 6), ngw = nvb * 4;
    const float* x = P.in[0]; const float* g = P.in[1]; bf16_t* XN = (bf16_t*)(P.ws + O_XN);
    for (int row = gw; row < NTOK; row += ngw) {
        const float4* xr = (const float4*)(x + (size_t)row * DM);
        float4 v[4]; float ss = 0.f;
#pragma unroll
        for (int j = 0; j < 4; ++j) { v[j] = xr[j * 64 + lane]; ss += v[j].x * v[j].x + v[j].y * v[j].y + v[j].z * v[j].z + v[j].w * v[j].w; }
        ss = wave_sum(ss);
        const float rstd = rsqrtf(ss * (1.0f / DM) + EPS);
#pragma unroll
        for (int j = 0; j < 4; ++j) {
            const float4 gg = ((const float4*)g)[j * 64 + lane];
            uint2 o; o.x = pk2(v[j].x * rstd * gg.x, v[j].y * rstd * gg.y); o.y = pk2(v[j].z * rstd * gg.z, v[j].w * rstd * gg.w);
            ((uint2*)(XN + (size_t)row * DM))[j * 64 + lane] = o;
        }
    }
}

struct GemmDesc { const bf16_t* A; const bf16_t* Bt; int lda, ldb, K, pad; };
constexpr int LSTR = 72;
constexpr int GEMM_LDS = 2 * 128 * LSTR * 2;

template <int NP>
__device__ __forceinline__ void gemm_tile(char* smem, const GemmDesc* g, int m0, int n0, f32x4 (&acc)[NP][4][4]) {
    bf16_t* As = (bf16_t*)smem; bf16_t* Bs = As + 128 * LSTR;
    const int tid = threadIdx.x, lane = tid & 63, wave = tid >> 6, wm = wave >> 1, wn = wave & 1, fr = lane & 15, q = lane >> 4;
    const int sc = tid & 7, sr = tid >> 3;
#pragma unroll
    for (int p = 0; p < NP; ++p)
#pragma unroll
        for (int i = 0; i < 4; ++i)
#pragma unroll
            for (int j = 0; j < 4; ++j) acc[p][i][j] = (f32x4){0.f, 0.f, 0.f, 0.f};
#pragma unroll
    for (int p = 0; p < NP; ++p) {
        const bf16_t* Ag = g[p].A + (size_t)m0 * g[p].lda + sc * 8;
        const bf16_t* Bg = g[p].Bt + (size_t)n0 * g[p].ldb + sc * 8;
        const int lda = g[p].lda, ldb = g[p].ldb, nk = g[p].K / 64;
        u32x4 ra[4], rb[4];
#pragma unroll
        for (int i = 0; i < 4; ++i) { ra[i] = *(const u32x4*)(Ag + (size_t)(sr + 32 * i) * lda); rb[i] = *(const u32x4*)(Bg + (size_t)(sr + 32 * i) * ldb); }
        for (int kt = 0; kt < nk; ++kt) {
            __syncthreads();
#pragma unroll
            for (int i = 0; i < 4; ++i) { *(u32x4*)(As + (sr + 32 * i) * LSTR + sc * 8) = ra[i]; *(u32x4*)(Bs + (sr + 32 * i) * LSTR + sc * 8) = rb[i]; }
            __syncthreads();
            if (kt + 1 < nk) {
#pragma unroll
                for (int i = 0; i < 4; ++i) { ra[i] = *(const u32x4*)(Ag + (size_t)(sr + 32 * i) * lda + (kt + 1) * 64); rb[i] = *(const u32x4*)(Bg + (size_t)(sr + 32 * i) * ldb + (kt + 1) * 64); }
            }
#pragma unroll
            for (int ks = 0; ks < 2; ++ks) {
                bf16x8 a[4], b[4];
#pragma unroll
                for (int i = 0; i < 4; ++i) a[i] = *(const bf16x8*)(As + (wm * 64 + 16 * i + fr) * LSTR + ks * 32 + 8 * q);
#pragma unroll
                for (int j = 0; j < 4; ++j) b[j] = *(const bf16x8*)(Bs + (wn * 64 + 16 * j + fr) * LSTR + ks * 32 + 8 * q);
#pragma unroll
                for (int i = 0; i < 4; ++i)
#pragma unroll
                    for (int j = 0; j < 4; ++j) acc[p][i][j] = __builtin_amdgcn_mfma_f32_16x16x32_bf16(b[j], a[i], acc[p][i][j], 0, 0, 0);
            }
        }
    }
    __syncthreads();
}

__device__ __forceinline__ float row_ssq64(const f32x4 (&a)[4]) {
    float s = 0.f;
#pragma unroll
    for (int j = 0; j < 4; ++j) s += a[j][0] * a[j][0] + a[j][1] * a[j][1] + a[j][2] * a[j][2] + a[j][3] * a[j][3];
    s += __shfl_xor(s, 16); s += __shfl_xor(s, 32);
    return s;
}

__device__ void inproj_phase(const Ptrs& P, char* smem, int vb, int nvb) {
    unsigned char* ws = P.ws;
    GemmDesc g[1] = {{(const bf16_t*)(ws + O_XN), (const bf16_t*)(ws + O_WT_IN), DM, DM, DM, 0}};
    constexpr int TN = NIN / 128, TM = NTOK / 128;
    const int lane = threadIdx.x & 63, wave = threadIdx.x >> 6, wm = wave >> 1, wn = wave & 1, fr = lane & 15, q = lane >> 4;
    for (int t = vb; t < TM * TN; t += nvb) {
        const int tm = t / TN, tn = t % TN, m0 = tm * 128, n0 = tn * 128;
        f32x4 acc[1][4][4];
        gemm_tile<1>(smem, g, m0, n0, acc);
        const int mb = m0 + wm * 64, nb = n0 + wn * 64;
        if (nb < 512) {
            bf16_t* U = (bf16_t*)(ws + O_U);
#pragma unroll
            for (int i = 0; i < 4; ++i)
#pragma unroll
                for (int j = 0; j < 4; ++j) { const f32x4 v = acc[0][i][j]; uint2 o; o.x = pk2(v[0], v[1]); o.y = pk2(v[2], v[3]);
                    *(uint2*)(U + (size_t)(mb + 16 * i + fr) * 512 + nb + 16 * j + 4 * q) = o; }
        } else if (nb < 1024) {
            bf16_t* QN = (bf16_t*)(ws + O_QN); const float* gq = P.in[19];
#pragma unroll
            for (int i = 0; i < 4; ++i) {
                const float rstd = rsqrtf(row_ssq64(acc[0][i]) * (1.0f / 64) + EPS);
#pragma unroll
                for (int j = 0; j < 4; ++j) { const f32x4 v = acc[0][i][j]; const float4 gg = *(const float4*)(gq + 16 * j + 4 * q);
                    uint2 o; o.x = pk2(v[0] * rstd * gg.x, v[1] * rstd * gg.y); o.y = pk2(v[2] * rstd * gg.z, v[3] * rstd * gg.w);
                    *(uint2*)(QN + (size_t)(mb + 16 * i + fr) * 512 + (nb - 512) + 16 * j + 4 * q) = o; }
            }
        } else if (nb < 1792) {
            const int idx = (nb - 1024) >> 6, br = idx >> 2, isv = (idx >> 1) & 1, gg_ = idx & 1;
            bf16_t* dst = (bf16_t*)(ws + O_KCIN + (size_t)(br * 2 + isv) * 8 * MiB);
            const bool donorm = (br > 0) && !isv; const float* gk = P.in[20] + br * 64;
#pragma unroll
            for (int i = 0; i < 4; ++i) {
                const int m = mb + 16 * i + fr, b = m >> 13, s = m & 8191;
                float rstd = 1.f; if (donorm) rstd = rsqrtf(row_ssq64(acc[0][i]) * (1.0f / 64) + EPS);
#pragma unroll
                for (int j = 0; j < 4; ++j) { f32x4 v = acc[0][i][j];
                    if (donorm) { const float4 gg = *(const float4*)(gk + 16 * j + 4 * q); v[0] *= rstd * gg.x; v[1] *= rstd * gg.y; v[2] *= rstd * gg.z; v[3] *= rstd * gg.w; }
                    uint2 o; o.x = pk2(v[0], v[1]); o.y = pk2(v[2], v[3]);
                    *(uint2*)(dst + ((size_t)(b * 2 + gg_) * SEQ + s) * 64 + 16 * j + 4 * q) = o; }
            }
        } else if (nb < 3840) {
            bf16_t* MG = (bf16_t*)(ws + O_MG);
#pragma unroll
            for (int i = 0; i < 4; ++i)
#pragma unroll
                for (int j = 0; j < 4; ++j) { const f32x4 v = acc[0][i][j]; uint2 o; o.x = pk2(sigmoidf_(v[0]), sigmoidf_(v[1])); o.y = pk2(sigmoidf_(v[2]), sigmoidf_(v[3]));
                    *(uint2*)(MG + (size_t)(mb + 16 * i + fr) * 2048 + (nb - 1792) + 16 * j + 4 * q) = o; }
        } else if (nb == 3840) {
            float* G = (float*)(ws + O_GATES);
#pragma unroll
            for (int i = 0; i < 4; ++i)
#pragma unroll
                for (int j = 0; j < 2; ++j) { const int c = 16 * j + 4 * q;
                    if (c < 24) { const f32x4 v = acc[0][i][j]; float4 o = {sigmoidf_(v[0]), sigmoidf_(v[1]), sigmoidf_(v[2]), sigmoidf_(v[3])};
                        *(float4*)(G + (size_t)(mb + 16 * i + fr) * 24 + c) = o; } }
        }
    }
}

__device__ void compress_phase(const Ptrs& P, char* smem, int vb, int nvb) {
    unsigned char* ws = P.ws;
    const int lane = threadIdx.x & 63, wave = threadIdx.x >> 6, wm = wave >> 1, wn = wave & 1, fr = lane & 15, q = lane >> 4;
    bf16_t* H = (bf16_t*)smem;
    constexpr int HS = 136;
    for (int t = vb; t < 64; t += nvb) {
        const int isv = t >> 5, tm = t & 31, m0 = tm * 128;
        GemmDesc g[1] = {{(const bf16_t*)(ws + (isv ? O_VCIN : O_KCIN)), (const bf16_t*)(ws + (isv ? O_WT_CV1 : O_WT_CK1)), 1024, 2048, 2048, 0}};
        f32x4 acc[1][4][4];
        gemm_tile<1>(smem, g, m0, 0, acc);
        const float* b1 = (const float*)(ws + (isv ? O_B1V : O_B1K));
#pragma unroll
        for (int i = 0; i < 4; ++i)
#pragma unroll
            for (int j = 0; j < 4; ++j) { const f32x4 v = acc[0][i][j]; const int n = wn * 64 + 16 * j + 4 * q; const float4 bb = *(const float4*)(b1 + n);
                uint2 o; o.x = pk2(gelu_tanh(v[0] + bb.x), gelu_tanh(v[1] + bb.y)); o.y = pk2(gelu_tanh(v[2] + bb.z), gelu_tanh(v[3] + bb.w));
                *(uint2*)(H + (wm * 64 + 16 * i + fr) * HS + n) = o; }
        __syncthreads();
        const bf16_t* W2t = (const bf16_t*)(ws + (isv ? O_WT_CV2 : O_WT_CK2));
        f32x4 o2[2][4];
#pragma unroll
        for (int i = 0; i < 2; ++i)
#pragma unroll
            for (int j = 0; j < 4; ++j) o2[i][j] = (f32x4){0.f, 0.f, 0.f, 0.f};
#pragma unroll
        for (int ks = 0; ks < 4; ++ks) {
            bf16x8 a[2], b[4];
#pragma unroll
            for (int i = 0; i < 2; ++i) a[i] = *(const bf16x8*)(H + (wave * 32 + 16 * i + fr) * HS + ks * 32 + 8 * q);
#pragma unroll
            for (int j = 0; j < 4; ++j) b[j] = *(const bf16x8*)(W2t + (size_t)(16 * j + fr) * 128 + ks * 32 + 8 * q);
#pragma unroll
            for (int i = 0; i < 2; ++i)
#pragma unroll
                for (int j = 0; j < 4; ++j) o2[i][j] = __builtin_amdgcn_mfma_f32_16x16x32_bf16(b[j], a[i], o2[i][j], 0, 0, 0);
        }
        bf16_t* dst = (bf16_t*)(ws + (isv ? O_VC : O_KC));
        const float* gk = P.in[20];
#pragma unroll
        for (int i = 0; i < 2; ++i) {
            float rstd = 1.f; if (!isv) rstd = rsqrtf(row_ssq64(o2[i]) * (1.0f / 64) + EPS);
            const int R = m0 + wave * 32 + 16 * i + fr;
#pragma unroll
            for (int j = 0; j < 4; ++j) { f32x4 v = o2[i][j];
                if (!isv) { const float4 gg = *(const float4*)(gk + 16 * j + 4 * q); v[0] *= rstd * gg.x; v[1] *= rstd * gg.y; v[2] *= rstd * gg.z; v[3] *= rstd * gg.w; }
                uint2 o; o.x = pk2(v[0], v[1]); o.y = pk2(v[2], v[3]);
                *(uint2*)(dst + (size_t)R * 64 + 16 * j + 4 * q) = o; }
        }
        __syncthreads();
    }
}

constexpr int S5_BU_STR = 132, S5_XB_STR = 136;
constexpr int S5_WAVE_LDS = 16 * S5_BU_STR * 4 + 16 * S5_XB_STR * 2;
template <bool ENDS_ONLY>
__device__ void s5_phase(const Ptrs& P, char* smem, int vb, int nvb) {
    unsigned char* ws = P.ws;
    const int lane = threadIdx.x & 63, wave = threadIdx.x >> 6, fr = lane & 15, q = lane >> 4;
    float* BU = (float*)(smem + wave * S5_WAVE_LDS);
    bf16_t* XB = (bf16_t*)(smem + wave * S5_WAVE_LDS + 16 * S5_BU_STR * 4);
    const bf16_t* U = (const bf16_t*)(ws + O_U);
    const float* ABAR = (const float*)(ws + O_ABAR); const float* AL = (const float*)(ws + O_AL);
    float* ENDS = (float*)(ws + O_ENDS);
    const int gw = vb * 4 + wave, ngw = nvb * 4;
    for (int it = gw; it < NB * NCHUNK * 32; it += ngw) {
        const int g = it & 31, c = (it >> 5) & (NCHUNK - 1), b = it >> 11;
        const float ar = ABAR[(g * 64 + lane) * 2], ai = ABAR[(g * 64 + lane) * 2 + 1];
        bf16x8 bb[8];
#pragma unroll
        for (int nt = 0; nt < 8; ++nt) {
            bb[nt] = (bf16x8){0, 0, 0, 0, 0, 0, 0, 0};
            if (q < 2) bb[nt] = *(const bf16x8*)((const bf16_t*)(ws + O_BBT) + ((size_t)g * 128 + 16 * nt + fr) * 16 + 8 * q);
        }
        bf16x8 ct[4];
        if (!ENDS_ONLY) {
#pragma unroll
            for (int ks = 0; ks < 4; ++ks) ct[ks] = *(const bf16x8*)((const bf16_t*)(ws + O_CT) + ((size_t)g * 16 + fr) * 128 + ks * 32 + 8 * q);
        }
        float xr = 0.f, xi = 0.f;
        if (!ENDS_ONLY) {
            const float alr = AL[(g * 64 + lane) * 2], ali = AL[(g * 64 + lane) * 2 + 1];
            for (int cp = 0; cp < c; ++cp) {
                const float2 e = *(const float2*)(ENDS + (((size_t)(b * NCHUNK + cp) * 32 + g) * 64 + lane) * 2);
                const float nr = alr * xr - ali * xi + e.x, ni = alr * xi + ali * xr + e.y; xr = nr; xi = ni;
            }
        }
        const size_t tok0 = (size_t)b * SEQ + (size_t)c * CHUNK;
        for (int sub = 0; sub < CHUNK / 16; ++sub) {
            const size_t tk = tok0 + sub * 16;
            bf16x8 uf = (bf16x8){0, 0, 0, 0, 0, 0, 0, 0};
            if (q < 2) uf = *(const bf16x8*)(U + (tk + fr) * 512 + g * 16 + 8 * q);
#pragma unroll
            for (int nt = 0; nt < 8; ++nt) {
                f32x4 d = __builtin_amdgcn_mfma_f32_16x16x32_bf16(bb[nt], uf, (f32x4){0.f, 0.f, 0.f, 0.f}, 0, 0, 0);
                *(f32x4*)(BU + fr * S5_BU_STR + 16 * nt + 4 * q) = d;
            }
            asm volatile("s_waitcnt lgkmcnt(0)" ::: "memory");
#pragma unroll 4
            for (int s = 0; s < 16; ++s) {
                const float br = BU[s * S5_BU_STR + lane], bi = BU[s * S5_BU_STR + 64 + lane];
                const float nr = ar * xr - ai * xi + br, ni = ar * xi + ai * xr + bi; xr = nr; xi = ni;
                if (!ENDS_ONLY) { XB[s * S5_XB_STR + lane] = f2bf(xr); XB[s * S5_XB_STR + 64 + lane] = f2bf(xi); }
            }
            asm volatile("s_waitcnt lgkmcnt(0)" ::: "memory");
            if (!ENDS_ONLY) {
                f32x4 y = (f32x4){0.f, 0.f, 0.f, 0.f};
#pragma unroll
                for (int ks = 0; ks < 4; ++ks) {
                    const bf16x8 xf = *(const bf16x8*)(XB + fr * S5_XB_STR + ks * 32 + 8 * q);
                    y = __builtin_amdgcn_mfma_f32_16x16x32_bf16(ct[ks], xf, y, 0, 0, 0);
                }
                const uint2 uu = *(const uint2*)(U + (tk + fr) * 512 + g * 16 + 4 * q);
                const float4 dd = *(const float4*)(P.in[10] + g * 16 + 4 * q);
                const float y0 = gelu_tanh(y[0] + dd.x * bf2f((bf16_t)(uu.x & 0xffff))), y1 = gelu_tanh(y[1] + dd.y * bf2f((bf16_t)(uu.x >> 16)));
                const float y2 = gelu_tanh(y[2] + dd.z * bf2f((bf16_t)(uu.y & 0xffff))), y3 = gelu_tanh(y[3] + dd.w * bf2f((bf16_t)(uu.y >> 16)));
                uint2 o; o.x = pk2(y0, y1); o.y = pk2(y2, y3);
                *(uint2*)((bf16_t*)(ws + O_YG) + (tk + fr) * 512 + g * 16 + 4 * q) = o;
                asm volatile("s_waitcnt lgkmcnt(0)" ::: "memory");
            }
        }
        if (ENDS_ONLY) *(float2*)(ENDS + (((size_t)(b * NCHUNK + c) * 32 + g) * 64 + lane) * 2) = make_float2(xr, xi);
    }
}

constexpr int ATT_LDS = (4 * 64 + 4 * 512 + 128 + 4 * 1024) * 4;
__device__ __forceinline__ float dot64(const float (&qv)[64], const bf16_t* krow) {
    float s = 0.f;
#pragma unroll
    for (int c = 0; c < 8; ++c) {
        const uint4 w = *(const uint4*)(krow + c * 8);
        s += qv[c * 8 + 0] * __uint_as_float(w.x << 16) + qv[c * 8 + 1] * __uint_as_float(w.x & 0xffff0000u);
        s += qv[c * 8 + 2] * __uint_as_float(w.y << 16) + qv[c * 8 + 3] * __uint_as_float(w.y & 0xffff0000u);
        s += qv[c * 8 + 4] * __uint_as_float(w.z << 16) + qv[c * 8 + 5] * __uint_as_float(w.z & 0xffff0000u);
        s += qv[c * 8 + 6] * __uint_as_float(w.w << 16) + qv[c * 8 + 7] * __uint_as_float(w.w & 0xffff0000u);
    }
    return s;
}
__device__ void attn_ref_phase(const Ptrs& P, char* smem, int vb, int nvb) {
    unsigned char* ws = P.ws;
    const int tid = threadIdx.x, lane = tid & 63, w = tid >> 6;
    float* qs = (float*)smem;
    float* pc = qs + 256;
    float* imp = pc + 2048;
    float* pw = imp + 128;
    int* sel_s = (int*)(pw + 4096);
    const bf16_t* QN = (const bf16_t*)(ws + O_QN);
    const float NEG = -1e30f;
    for (int it = vb; it < NB * 2 * SEQ; it += nvb) {
        const int t = it & (SEQ - 1), g = (it >> 13) & 1, b = it >> 14, bg = b * 2 + g;
        const size_t tok = (size_t)b * SEQ + t;
        const int h = g * 4 + w;
        const float slope = exp2f(-(float)(h + 1));
        __syncthreads();
        qs[w * 64 + lane] = bf2f(QN[tok * 512 + h * 64 + lane]);
        __syncthreads();
        float qv[64];
#pragma unroll
        for (int d = 0; d < 64; ++d) qv[d] = qs[w * 64 + d];
        const int n_vis = (t >= 31) ? ((t - 31) / 16 + 1) : 0;
        const bf16_t* KC = (const bf16_t*)(ws + O_KC) + (size_t)bg * 512 * 64;
        const bf16_t* VC = (const bf16_t*)(ws + O_VC) + (size_t)bg * 512 * 64;
        float sc[8]; float mx = NEG;
#pragma unroll
        for (int i = 0; i < 8; ++i) { const int j = lane + 64 * i; sc[i] = NEG;
            if (j < n_vis) { sc[i] = dot64(qv, KC + (size_t)j * 64) * 0.125f - slope * (float)(t - (16 * j + 31)); mx = fmaxf(mx, sc[i]); } }
        mx = wave_max(mx);
        float sum = 0.f;
#pragma unroll
        for (int i = 0; i < 8; ++i) { const int j = lane + 64 * i; sc[i] = (j < n_vis) ? __expf(sc[i] - mx) : 0.f; sum += sc[i]; }
        sum = wave_sum(sum);
        const float inv = (n_vis > 0) ? 1.0f / sum : 0.f;
#pragma unroll
        for (int i = 0; i < 8; ++i) pc[w * 512 + lane + 64 * i] = sc[i] * inv;
        __syncthreads();
        float o_cmp = 0.f;
        for (int j = 0; j < n_vis; ++j) o_cmp += pc[w * 512 + j] * bf2f(VC[(size_t)j * 64 + lane]);
        const int cur = t >> 6;
        if (tid < 128) {
            const int blk = tid; float v = 0.f;
#pragma unroll
            for (int hh = 0; hh < 4; ++hh) { v += pc[hh * 512 + 4 * blk] + pc[hh * 512 + 4 * blk + 1] + pc[hh * 512 + 4 * blk + 2] + pc[hh * 512 + 4 * blk + 3]; if (blk > 0) v += pc[hh * 512 + 4 * blk - 1]; }
            const bool valid = blk <= cur, forced = (blk == 0) || (blk == cur) || (blk == cur - 1);
            imp[blk] = valid ? (v + (forced ? 1e4f : 0.f)) : NEG;
        }
        __syncthreads();
        float v0 = imp[lane], v1 = imp[lane + 64];
        int sel[16];
#pragma unroll
        for (int r = 0; r < 16; ++r) {
            float bv; int bi;
            if (v0 >= v1) { bv = v0; bi = lane; } else { bv = v1; bi = lane + 64; }
#pragma unroll
            for (int o = 1; o < 64; o <<= 1) { const float ov = __shfl_xor(bv, o); const int oi = __shfl_xor(bi, o); if (ov > bv || (ov == bv && oi < bi)) { bv = ov; bi = oi; } }
            sel[r] = bi; if (lane == 0) sel_s[w * 16 + r] = bi;
            if (bi == lane) v0 = -3e38f; if (bi == lane + 64) v1 = -3e38f;
        }
        const bf16_t* KS = (const bf16_t*)(ws + O_KS) + (size_t)bg * SEQ * 64;
        const bf16_t* VS = (const bf16_t*)(ws + O_VS) + (size_t)bg * SEQ * 64;
        float ss[16]; mx = NEG;
#pragma unroll
        for (int r = 0; r < 16; ++r) { const int pos = sel[r] * 64 + lane; ss[r] = NEG;
            if (pos <= t) { ss[r] = dot64(qv, KS + (size_t)pos * 64) * 0.125f - slope * (float)(t - pos); mx = fmaxf(mx, ss[r]); } }
        mx = wave_max(mx); sum = 0.f;
#pragma unroll
        for (int r = 0; r < 16; ++r) { const int pos = sel[r] * 64 + lane; ss[r] = (pos <= t) ? __expf(ss[r] - mx) : 0.f; sum += ss[r]; }
        sum = wave_sum(sum);
        { const float iv = 1.0f / sum;
#pragma unroll
          for (int r = 0; r < 16; ++r) pw[w * 1024 + r * 64 + lane] = ss[r] * iv; }
        __syncthreads();
        float o_slc = 0.f;
#pragma unroll 1
        for (int r = 0; r < 16; ++r) { const int blk = sel_s[w * 16 + r]; if (blk > cur) continue; const bf16_t* vb_ = VS + (size_t)blk * 64 * 64 + lane;
            for (int kk = 0; kk < 64; ++kk) o_slc += pw[w * 1024 + r * 64 + kk] * bf2f(vb_[(size_t)kk * 64]); }
        __syncthreads();
        const bf16_t* KW = (const bf16_t*)(ws + O_KW) + (size_t)bg * SEQ * 64;
        const bf16_t* VW = (const bf16_t*)(ws + O_VW) + (size_t)bg * SEQ * 64;
        float sw[8]; mx = NEG;
#pragma unroll
        for (int i = 0; i < 8; ++i) { const int pos = t - 511 + lane + 64 * i; sw[i] = NEG;
            if (pos >= 0) { sw[i] = dot64(qv, KW + (size_t)pos * 64) * 0.125f - slope * (float)(t - pos); mx = fmaxf(mx, sw[i]); } }
        mx = wave_max(mx); sum = 0.f;
#pragma unroll
        for (int i = 0; i < 8; ++i) { const int pos = t - 511 + lane + 64 * i; sw[i] = (pos >= 0) ? __expf(sw[i] - mx) : 0.f; sum += sw[i]; }
        sum = wave_sum(sum);
        { const float iv = 1.0f / sum;
#pragma unroll
          for (int i = 0; i < 8; ++i) pw[w * 1024 + lane + 64 * i] = sw[i] * iv; }
        __syncthreads();
        float o_win = 0.f;
        { const int i0 = (t >= 511) ? 0 : (511 - t);
          for (int i = i0; i < 512; ++i) o_win += pw[w * 1024 + i] * bf2f(VW[(size_t)(t - 511 + i) * 64 + lane]); }
        const float* G = (const float*)(ws + O_GATES) + tok * 24;
        const float y = G[h] * o_cmp + G[8 + h] * o_slc + G[16 + h] * o_win;
        ((bf16_t*)(ws + O_YNSA))[tok * 512 + h * 64 + lane] = f2bf(y);
    }
}

__device__ void glu_phase(const Ptrs& P, char* smem, int vb, int nvb) {
    unsigned char* ws = P.ws;
    GemmDesc g[1] = {{(const bf16_t*)(ws + O_YG), (const bf16_t*)(ws + O_WT_GLU), 512, 512, 512, 0}};
    const int lane = threadIdx.x & 63, wave = threadIdx.x >> 6, wm = wave >> 1, wn = wave & 1, fr = lane & 15, q = lane >> 4;
    const bf16_t* YG = (const bf16_t*)(ws + O_YG); bf16_t* YS = (bf16_t*)(ws + O_YSSM); const float* bg = P.in[12];
    for (int t = vb; t < (NTOK / 128) * 4; t += nvb) {
        const int tm = t >> 2, tn = t & 3, m0 = tm * 128, n0 = tn * 128;
        f32x4 acc[1][4][4];
        gemm_tile<1>(smem, g, m0, n0, acc);
        const int mb = m0 + wm * 64, nb = n0 + wn * 64;
#pragma unroll
        for (int i = 0; i < 4; ++i)
#pragma unroll
            for (int j = 0; j < 4; ++j) { const f32x4 v = acc[0][i][j]; const size_t off = (size_t)(mb + 16 * i + fr) * 512 + nb + 16 * j + 4 * q;
                const uint2 yy = *(const uint2*)(YG + off); const float4 bb = *(const float4*)(bg + nb + 16 * j + 4 * q);
                uint2 o; o.x = pk2(bf2f((bf16_t)(yy.x & 0xffff)) * sigmoidf_(v[0] + bb.x), bf2f((bf16_t)(yy.x >> 16)) * sigmoidf_(v[1] + bb.y));
                o.y = pk2(bf2f((bf16_t)(yy.y & 0xffff)) * sigmoidf_(v[2] + bb.z), bf2f((bf16_t)(yy.y >> 16)) * sigmoidf_(v[3] + bb.w));
                *(uint2*)(YS + off) = o; }
    }
}

__device__ void merge_phase(const Ptrs& P, char* smem, int vb, int nvb) {
    unsigned char* ws = P.ws;
    GemmDesc g[2] = {{(const bf16_t*)(ws + O_YSSM), (const bf16_t*)(ws + O_WT_PS), 512, 512, 512, 0}, {(const bf16_t*)(ws + O_YNSA), (const bf16_t*)(ws + O_WT_PN), 512, 512, 512, 0}};
    const int lane = threadIdx.x & 63, wave = threadIdx.x >> 6, wm = wave >> 1, wn = wave & 1, fr = lane & 15, q = lane >> 4;
    const bf16_t* MG = (const bf16_t*)(ws + O_MG); bf16_t* ME = (bf16_t*)(ws + O_MERGED);
    for (int t = vb; t < (NTOK / 128) * 8; t += nvb) {
        const int tm = t >> 3, tn = t & 7, m0 = tm * 128, n0 = tn * 128;
        f32x4 acc[2][4][4];
        gemm_tile<2>(smem, g, m0, n0, acc);
        const int mb = m0 + wm * 64, nb = n0 + wn * 64;
#pragma unroll
        for (int i = 0; i < 4; ++i)
#pragma unroll
            for (int j = 0; j < 4; ++j) { const f32x4 a = acc[0][i][j], c = acc[1][i][j]; const int m = mb + 16 * i + fr, n = nb + 16 * j + 4 * q;
                const uint2 g0 = *(const uint2*)(MG + (size_t)m * 2048 + n), g1 = *(const uint2*)(MG + (size_t)m * 2048 + 1024 + n);
                uint2 o;
                o.x = pk2(bf2f((bf16_t)(g0.x & 0xffff)) * a[0] + bf2f((bf16_t)(g1.x & 0xffff)) * c[0], bf2f((bf16_t)(g0.x >> 16)) * a[1] + bf2f((bf16_t)(g1.x >> 16)) * c[1]);
                o.y = pk2(bf2f((bf16_t)(g0.y & 0xffff)) * a[2] + bf2f((bf16_t)(g1.y & 0xffff)) * c[2], bf2f((bf16_t)(g0.y >> 16)) * a[3] + bf2f((bf16_t)(g1.y >> 16)) * c[3]);
                *(uint2*)(ME + (size_t)m * 1024 + n) = o; }
    }
}

__device__ void outproj_phase(const Ptrs& P, char* smem, int vb, int nvb) {
    unsigned char* ws = P.ws;
    GemmDesc g[1] = {{(const bf16_t*)(ws + O_MERGED), (const bf16_t*)(ws + O_WT_OUT), 1024, 1024, 1024, 0}};
    const int lane = threadIdx.x & 63, wave = threadIdx.x >> 6, wm = wave >> 1, wn = wave & 1, fr = lane & 15, q = lane >> 4;
    const float* x = P.in[0]; float* out = P.out; bf16_t* X1B = (bf16_t*)(ws + O_X1B); float* SSQ = (float*)(ws + O_SSQ);
    for (int t = vb; t < (NTOK / 128) * 8; t += nvb) {
        const int tm = t >> 3, tn = t & 7, m0 = tm * 128, n0 = tn * 128;
        f32x4 acc[1][4][4];
        gemm_tile<1>(smem, g, m0, n0, acc);
        const int mb = m0 + wm * 64, nb = n0 + wn * 64;
#pragma unroll
        for (int i = 0; i < 4; ++i) {
            const int m = mb + 16 * i + fr; f32x4 r[4];
#pragma unroll
            for (int j = 0; j < 4; ++j) { const size_t off = (size_t)m * 1024 + nb + 16 * j + 4 * q; const float4 xv = *(const float4*)(x + off);
                f32x4 v = acc[0][i][j]; v[0] += xv.x; v[1] += xv.y; v[2] += xv.z; v[3] += xv.w; r[j] = v;
                *(float4*)(out + off) = make_float4(v[0], v[1], v[2], v[3]);
                uint2 o; o.x = pk2(v[0], v[1]); o.y = pk2(v[2], v[3]); *(uint2*)(X1B + off) = o; }
            const float s = row_ssq64(r);
            if (q == 0) atomicAdd(SSQ + m, s);
        }
    }
}

__device__ void up_phase(const Ptrs& P, char* smem, int vb, int nvb) {
    unsigned char* ws = P.ws;
    GemmDesc g[1] = {{(const bf16_t*)(ws + O_X1B), (const bf16_t*)(ws + O_WT_UP), 1024, 1024, 1024, 0}};
    const int lane = threadIdx.x & 63, wave = threadIdx.x >> 6, wm = wave >> 1, wn = wave & 1, fr = lane & 15, q = lane >> 4;
    bf16_t* FF = (bf16_t*)(ws + O_FF); const float* SSQ = (const float*)(ws + O_SSQ);
    for (int t = vb; t < (NTOK / 128) * 32; t += nvb) {
        const int tm = t >> 5, tn = t & 31, m0 = tm * 128, n0 = tn * 128;
        f32x4 acc[1][4][4];
        gemm_tile<1>(smem, g, m0, n0, acc);
        const int mb = m0 + wm * 64, nb = n0 + wn * 64;
#pragma unroll
        for (int i = 0; i < 4; ++i) {
            const int m = mb + 16 * i + fr; const float rstd = rsqrtf(SSQ[m] * (1.0f / DM) + EPS);
#pragma unroll
            for (int j = 0; j < 4; ++j) { f32x4 v = acc[0][i][j];
#pragma unroll
                for (int r = 0; r < 4; ++r) { const float a = fmaxf(v[r], 0.f) * rstd; v[r] = a * a; }
                uint2 o; o.x = pk2(v[0], v[1]); o.y = pk2(v[2], v[3]);
                *(uint2*)(FF + (size_t)m * DFF + nb + 16 * j + 4 * q) = o; }
        }
    }
}

__device__ void down_phase(const Ptrs& P, char* smem, int vb, int nvb) {
    unsigned char* ws = P.ws;
    GemmDesc g[1] = {{(const bf16_t*)(ws + O_FF), (const bf16_t*)(ws + O_WT_DOWN), DFF, DFF, DFF, 0}};
    const int lane = threadIdx.x & 63, wave = threadIdx.x >> 6, wm = wave >> 1, wn = wave & 1, fr = lane & 15, q = lane >> 4;
    float* out = P.out;
    for (int t = vb; t < (NTOK / 128) * 8; t += nvb) {
        const int tm = t >> 3, tn = t & 7, m0 = tm * 128, n0 = tn * 128;
        f32x4 acc[1][4][4];
        gemm_tile<1>(smem, g, m0, n0, acc);
        const int mb = m0 + wm * 64, nb = n0 + wn * 64;
#pragma unroll
        for (int i = 0; i < 4; ++i)
#pragma unroll
            for (int j = 0; j < 4; ++j) { const size_t off = (size_t)(mb + 16 * i + fr) * 1024 + nb + 16 * j + 4 * q; const float4 xv = *(const float4*)(out + off);
                const f32x4 v = acc[0][i][j]; *(float4*)(out + off) = make_float4(v[0] + xv.x, v[1] + xv.y, v[2] + xv.z, v[3] + xv.w); }
    }
}

constexpr int SMEM_BYTES = 52 * 1024;
#define KDEF(name, call) __global__ void __launch_bounds__(256) name(Ptrs P, TrTable tt) { extern __shared__ __attribute__((aligned(16))) char smem[]; (void)tt; call; }
KDEF(k_transpose, transpose_phase(tt, smem, blockIdx.x, gridDim.x))
KDEF(k_consts, consts_phase(P, blockIdx.x, gridDim.x))
KDEF(k_rms1, rmsnorm1_phase(P, blockIdx.x, gridDim.x))
KDEF(k_inproj, inproj_phase(P, smem, blockIdx.x, gridDim.x))
KDEF(k_compress, compress_phase(P, smem, blockIdx.x, gridDim.x))
KDEF(k_s5ends, s5_phase<true>(P, smem, blockIdx.x, gridDim.x))
KDEF(k_s5main, s5_phase<false>(P, smem, blockIdx.x, gridDim.x))
KDEF(k_attn, attn_ref_phase(P, smem, blockIdx.x, gridDim.x))
KDEF(k_glu, glu_phase(P, smem, blockIdx.x, gridDim.x))
KDEF(k_merge, merge_phase(P, smem, blockIdx.x, gridDim.x))
KDEF(k_outproj, outproj_phase(P, smem, blockIdx.x, gridDim.x))
KDEF(k_up, up_phase(P, smem, blockIdx.x, gridDim.x))
KDEF(k_down, down_phase(P, smem, blockIdx.x, gridDim.x))

static void add_tr(TrTable& tt, int& n, const float* src, bf16_t* dst, const float* kscale, int K, int N, int ldsrc, int mode) {
    TrDesc& d = tt.d[n]; d.src = src; d.dst = dst; d.kscale = kscale; d.K = K; d.N = N; d.ldsrc = ldsrc; d.mode = mode; d.tiles_n = N / 64; d.tile0 = tt.total;
    tt.total += (K / 64) * (N / 64); ++n;
}

extern "C" void kernel_launch(void* const* d_in, const int* in_sizes, int n_in, void* d_out, int out_size, void* d_ws, size_t ws_size, hipStream_t stream) {
    if (n_in != 27 || ws_size < WS_END) { fprintf(stderr, "kernel_launch: unexpected n_in %d or ws_size %zu (need %zu)\n", n_in, ws_size, (size_t)WS_END); return; }
    Ptrs P{};
    for (int i = 0; i < 27; ++i) P.in[i] = (const float*)d_in[i];
    P.out = (float*)d_out; P.ws = (unsigned char*)d_ws;
    unsigned char* ws = P.ws;
    TrTable tt{}; int n = 0;
    add_tr(tt, n, P.in[2], (bf16_t*)(ws + O_WT_IN), nullptr, 1024, NIN, 3864, 1);
    add_tr(tt, n, P.in[11], (bf16_t*)(ws + O_WT_GLU), nullptr, 512, 512, 512, 0);
    add_tr(tt, n, P.in[21], (bf16_t*)(ws + O_WT_PS), nullptr, 512, 1024, 1024, 0);
    add_tr(tt, n, P.in[22], (bf16_t*)(ws + O_WT_PN), nullptr, 512, 1024, 1024, 0);
    add_tr(tt, n, P.in[23], (bf16_t*)(ws + O_WT_OUT), nullptr, 1024, 1024, 1024, 0);
    add_tr(tt, n, P.in[25], (bf16_t*)(ws + O_WT_UP), P.in[24], 1024, 4096, 4096, 0);
    add_tr(tt, n, P.in[26], (bf16_t*)(ws + O_WT_DOWN), nullptr, 4096, 1024, 1024, 0);
    add_tr(tt, n, P.in[15], (bf16_t*)(ws + O_WT_CK1), nullptr, 2048, 128, 128, 0);
    add_tr(tt, n, P.in[17], (bf16_t*)(ws + O_WT_CV1), nullptr, 2048, 128, 128, 0);
    add_tr(tt, n, P.in[16], (bf16_t*)(ws + O_WT_CK2), nullptr, 128, 64, 64, 0);
    add_tr(tt, n, P.in[18], (bf16_t*)(ws + O_WT_CV2), nullptr, 128, 64, 64, 0);
    const int G = 1024;
#define LAUNCH(k, grid) hipLaunchKernelGGL(k, dim3(grid), dim3(256), SMEM_BYTES, stream, P, tt)
    LAUNCH(k_transpose, G);
    LAUNCH(k_consts, 64);
    LAUNCH(k_rms1, G);
    LAUNCH(k_inproj, G);
    LAUNCH(k_compress, 64);
    LAUNCH(k_s5ends, G);
    LAUNCH(k_attn, 2048);
    LAUNCH(k_s5main, G);
    LAUNCH(k_glu, G);
    LAUNCH(k_merge, G);
    LAUNCH(k_outproj, G);
    LAUNCH(k_up, G);
    LAUNCH(k_down, G);
}
```

```cpp
#include <hip/hip_runtime.h>
#include <hip/hip_cooperative_groups.h>
namespace cg = cooperative_groups;
#ifndef MULTI_LAUNCH
#define MULTI_LAUNCH 0
#endif
#include <cstdio>
#include <cstdint>

typedef unsigned short bf16_t;
typedef short bf16x8 __attribute__((ext_vector_type(8)));
typedef float f32x4 __attribute__((ext_vector_type(4)));
typedef unsigned u32x4 __attribute__((ext_vector_type(4)));

constexpr int NB = 4, SEQ = 8192, DM = 1024, NTOK = NB * SEQ;
constexpr int NIN = 3968;
constexpr int DFF = 4096;
constexpr int CHUNK = 128, NCHUNK = SEQ / CHUNK;
constexpr float EPS = 1e-6f;

constexpr size_t MiB = 1024 * 1024;
constexpr size_t al256(size_t x) { return (x + 255) & ~(size_t)255; }
constexpr size_t O_WT_IN = 0;
constexpr size_t O_WT_GLU = O_WT_IN + (size_t)NIN * 1024 * 2;
constexpr size_t O_WT_PS = O_WT_GLU + 512 * 512 * 2;
constexpr size_t O_WT_PN = O_WT_PS + 1024 * 512 * 2;
constexpr size_t O_WT_OUT = O_WT_PN + 1024 * 512 * 2;
constexpr size_t O_WT_UP = O_WT_OUT + 1024 * 1024 * 2;
constexpr size_t O_WT_DOWN = O_WT_UP + (size_t)4096 * 1024 * 2;
constexpr size_t O_WT_CK1 = O_WT_DOWN + (size_t)4096 * 1024 * 2;
constexpr size_t O_WT_CV1 = O_WT_CK1 + 128 * 2048 * 2;
constexpr size_t O_WT_CK2 = O_WT_CV1 + 128 * 2048 * 2;
constexpr size_t O_WT_CV2 = O_WT_CK2 + 64 * 128 * 2;
constexpr size_t O_B1K = O_WT_CV2 + 64 * 128 * 2;
constexpr size_t O_B1V = O_B1K + 512;
constexpr size_t O_ABAR = O_B1V + 512;
constexpr size_t O_AL = O_ABAR + 32 * 64 * 2 * 4;
constexpr size_t O_BBT = O_AL + 32 * 64 * 2 * 4;
constexpr size_t O_CT = O_BBT + 32 * 128 * 16 * 2;
constexpr size_t O_ENDS = O_CT + 32 * 16 * 128 * 2;
constexpr size_t O_SSQ = O_ENDS + (size_t)NB * NCHUNK * 32 * 64 * 2 * 4;
constexpr size_t O_GATES = O_SSQ + (size_t)NTOK * 4;
constexpr size_t O_KC = O_GATES + (size_t)NTOK * 24 * 4;
constexpr size_t O_VC = O_KC + 8 * 512 * 64 * 2;
constexpr size_t O_REGA = al256(O_VC + 8 * 512 * 64 * 2 + 4096);
constexpr size_t O_XN = O_REGA;
constexpr size_t O_YSSM = O_XN;
constexpr size_t O_YNSA = O_XN + 32 * MiB;
constexpr size_t O_U = O_XN + 64 * MiB;
constexpr size_t O_QN = O_U + 32 * MiB;
constexpr size_t O_KCIN = O_QN + 32 * MiB;
constexpr size_t O_VCIN = O_KCIN + 8 * MiB;
constexpr size_t O_KS = O_VCIN + 8 * MiB;
constexpr size_t O_VS = O_KS + 8 * MiB;
constexpr size_t O_KW = O_VS + 8 * MiB;
constexpr size_t O_VW = O_KW + 8 * MiB;
constexpr size_t O_YG = O_VW + 8 * MiB;
constexpr size_t O_FF = O_REGA;
constexpr size_t O_REGB = O_REGA + 256 * MiB;
constexpr size_t O_MG = O_REGB;
constexpr size_t O_X1B = O_REGB;
constexpr size_t O_MERGED = O_REGB + 128 * MiB;
constexpr size_t WS_END = O_MERGED + 64 * MiB;
static_assert(O_YG + 32 * MiB <= O_REGB, "region A overflow");

__device__ __forceinline__ float bf2f(bf16_t h) { return __uint_as_float(((unsigned)h) << 16); }
__device__ __forceinline__ bf16_t f2bf(float f) { unsigned u = __float_as_uint(f); u += 0x7fffu + ((u >> 16) & 1u); return (bf16_t)(u >> 16); }
__device__ __forceinline__ unsigned pk2(float lo, float hi) { return (unsigned)f2bf(lo) | ((unsigned)f2bf(hi) << 16); }
__device__ __forceinline__ float sigmoidf_(float x) { return 1.0f / (1.0f + __expf(-x)); }
__device__ __forceinline__ float gelu_tanh(float x) { const float u = 0.7978845608028654f * (x + 0.044715f * x * x * x); return 0.5f * x * (1.0f + tanhf(u)); }
__device__ __forceinline__ float wave_sum(float v) {
#pragma unroll
    for (int o = 1; o < 64; o <<= 1) v += __shfl_xor(v, o);
    return v;
}
__device__ __forceinline__ float wave_max(float v) {
#pragma unroll
    for (int o = 1; o < 64; o <<= 1) v = fmaxf(v, __shfl_xor(v, o));
    return v;
}

struct Ptrs {
    const float* in[27];
    float* out;
    unsigned char* ws;
};

struct TrDesc { const float* src; bf16_t* dst; const float* kscale; int K, N, ldsrc, mode, tiles_n, tile0; };
constexpr int NTR = 11;
struct TrTable { TrDesc d[NTR]; int total; int pad; };

__device__ __forceinline__ int in_col(int n) {
    if (n < 1792) return n;
    if (n < 3840) return n + 24;
    if (n < 3864) return n - 3840 + 1792;
    return -1;
}

__device__ __forceinline__ void transpose_phase(const TrTable& tt, char* smem, int vb, int nvb) {
    float* tile = (float*)smem;
    const int tid = threadIdx.x;
    for (int it = vb; it < tt.total; it += nvb) {
        int di = 0;
#pragma unroll
        for (int i = 1; i < NTR; ++i) if (it >= tt.d[i].tile0) di = i;
        const TrDesc& d = tt.d[di];
        const int lt = it - d.tile0, tn = lt % d.tiles_n, tk = lt / d.tiles_n, k0 = tk * 64, n0 = tn * 64;
#pragma unroll 4
        for (int i = 0; i < 16; ++i) {
            const int kk = (tid >> 6) + 4 * i, nn = tid & 63;
            int col = n0 + nn; if (d.mode == 1) col = in_col(col);
            float v = 0.f;
            if (col >= 0) v = d.src[(size_t)(k0 + kk) * d.ldsrc + col];
            if (d.kscale) v *= d.kscale[k0 + kk];
            tile[kk * 65 + nn] = v;
        }
        __syncthreads();
#pragma unroll 4
        for (int i = 0; i < 16; ++i) {
            const int nn = (tid >> 6) + 4 * i, kk = tid & 63;
            d.dst[(size_t)(n0 + nn) * d.K + k0 + kk] = f2bf(tile[kk * 65 + nn]);
        }
        __syncthreads();
    }
}

__device__ __forceinline__ void consts_phase(const Ptrs& P, int vb, int nvb) {
    const int gt = vb * 256 + threadIdx.x, ngt = nvb * 256;
    unsigned char* ws = P.ws;
    for (int i = gt; i < 32 * 64; i += ngt) {
        const int g = i >> 6, p = i & 63;
        const double ar = (double)P.in[3][i], ai = (double)P.in[4][i], dt = exp((double)P.in[5][g]);
        const double mag = exp(ar * dt), abr = mag * cos(ai * dt), abi = mag * sin(ai * dt);
        const double den = ar * ar + ai * ai, nr = abr - 1.0;
        const double fr = (nr * ar + abi * ai) / den, fi = (abi * ar - nr * ai) / den;
        float* ABAR = (float*)(ws + O_ABAR); float* AL = (float*)(ws + O_AL);
        ABAR[i * 2] = (float)abr; ABAR[i * 2 + 1] = (float)abi;
        double pr = abr, pi = abi;
        for (int s = 0; s < 7; ++s) { const double nr2 = pr * pr - pi * pi, ni2 = 2.0 * pr * pi; pr = nr2; pi = ni2; }
        AL[i * 2] = (float)pr; AL[i * 2 + 1] = (float)pi;
        bf16_t* BBT = (bf16_t*)(ws + O_BBT);
        for (int c = 0; c < 16; ++c) {
            const double br = (double)P.in[6][(size_t)i * 16 + c], bi = (double)P.in[7][(size_t)i * 16 + c];
            BBT[((size_t)g * 128 + p) * 16 + c] = f2bf((float)(fr * br - fi * bi));
            BBT[((size_t)g * 128 + 64 + p) * 16 + c] = f2bf((float)(fr * bi + fi * br));
        }
        bf16_t* CT = (bf16_t*)(ws + O_CT);
        for (int c = 0; c < 16; ++c) {
            CT[((size_t)g * 16 + c) * 128 + p] = f2bf(P.in[8][((size_t)g * 16 + c) * 64 + p]);
            CT[((size_t)g * 16 + c) * 128 + 64 + p] = f2bf(-P.in[9][((size_t)g * 16 + c) * 64 + p]);
        }
    }
    for (int i = gt; i < 256; i += ngt) {
        const int n = i & 127; const bool isv = i >= 128;
        const float* pe = P.in[isv ? 14 : 13]; const float* w1 = P.in[isv ? 17 : 15];
        float s = 0.f;
        for (int k = 0; k < 2048; ++k) s += pe[k] * w1[(size_t)k * 128 + n];
        ((float*)(ws + (isv ? O_B1V : O_B1K)))[n] = s;
    }
    float* SSQ = (float*)(ws + O_SSQ);
    for (int i = gt; i < NTOK; i += ngt) SSQ[i] = 0.f;
}

__device__ __forceinline__ void rmsnorm1_phase(const Ptrs& P, int vb, int nvb) {
    const int lane = threadIdx.x & 63, gw = vb * 4 + (threadIdx.x >> 6), ngw = nvb * 4;
    const float* x = P.in[0]; const float* g = P.in[1]; bf16_t* XN = (bf16_t*)(P.ws + O_XN);
    for (int row = gw; row < NTOK; row += ngw) {
        const float4* xr = (const float4*)(x + (size_t)row * DM);
        float4 v[4]; float ss = 0.f;
#pragma unroll
        for (int j = 0; j < 4; ++j) { v[j] = xr[j * 64 + lane]; ss += v[j].x * v[j].x + v[j].y * v[j].y + v[j].z * v[j].z + v[j].w * v[j].w; }
        ss = wave_sum(ss);
        const float rstd = rsqrtf(ss * (1.0f / DM) + EPS);
#pragma unroll
        for (int j = 0; j < 4; ++j) {
            const float4 gg = ((const float4*)g)[j * 64 + lane];
            uint2 o; o.x = pk2(v[j].x * rstd * gg.x, v[j].y * rstd * gg.y); o.y = pk2(v[j].z * rstd * gg.z, v[j].w * rstd * gg.w);
            ((uint2*)(XN + (size_t)row * DM))[j * 64 + lane] = o;
        }
    }
}

struct GemmDesc { const bf16_t* A; const bf16_t* Bt; int lda, ldb, K, pad; };
constexpr int LSTR = 72;
constexpr int GEMM_LDS = 2 * 128 * LSTR * 2;

template <int NP>
__device__ __forceinline__ void gemm_tile(char* smem, const GemmDesc* g, int m0, int n0, f32x4 (&acc)[NP][4][4]) {
    bf16_t* As = (bf16_t*)smem; bf16_t* Bs = As + 128 * LSTR;
    const int tid = threadIdx.x, lane = tid & 63, wave = tid >> 6, wm = wave >> 1, wn = wave & 1, fr = lane & 15, q = lane >> 4;
    const int sc = tid & 7, sr = tid >> 3;
#pragma unroll
    for (int p = 0; p < NP; ++p)
#pragma unroll
        for (int i = 0; i < 4; ++i)
#pragma unroll
            for (int j = 0; j < 4; ++j) acc[p][i][j] = (f32x4){0.f, 0.f, 0.f, 0.f};
#pragma unroll
    for (int p = 0; p < NP; ++p) {
        const bf16_t* Ag = g[p].A + (size_t)m0 * g[p].lda + sc * 8;
        const bf16_t* Bg = g[p].Bt + (size_t)n0 * g[p].ldb + sc * 8;
        const int lda = g[p].lda, ldb = g[p].ldb, nk = g[p].K / 64;
        u32x4 ra[4], rb[4];
#pragma unroll
        for (int i = 0; i < 4; ++i) { ra[i] = *(const u32x4*)(Ag + (size_t)(sr + 32 * i) * lda); rb[i] = *(const u32x4*)(Bg + (size_t)(sr + 32 * i) * ldb); }
        for (int kt = 0; kt < nk; ++kt) {
            __syncthreads();
#pragma unroll
            for (int i = 0; i < 4; ++i) { *(u32x4*)(As + (sr + 32 * i) * LSTR + sc * 8) = ra[i]; *(u32x4*)(Bs + (sr + 32 * i) * LSTR + sc * 8) = rb[i]; }
            __syncthreads();
            if (kt + 1 < nk) {
#pragma unroll
                for (int i = 0; i < 4; ++i) { ra[i] = *(const u32x4*)(Ag + (size_t)(sr + 32 * i) * lda + (kt + 1) * 64); rb[i] = *(const u32x4*)(Bg + (size_t)(sr + 32 * i) * ldb + (kt + 1) * 64); }
            }
#pragma unroll
            for (int ks = 0; ks < 2; ++ks) {
                bf16x8 a[4], b[4];
#pragma unroll
                for (int i = 0; i < 4; ++i) a[i] = *(const bf16x8*)(As + (wm * 64 + 16 * i + fr) * LSTR + ks * 32 + 8 * q);
#pragma unroll
                for (int j = 0; j < 4; ++j) b[j] = *(const bf16x8*)(Bs + (wn * 64 + 16 * j + fr) * LSTR + ks * 32 + 8 * q);
#pragma unroll
                for (int i = 0; i < 4; ++i)
#pragma unroll
                    for (int j = 0; j < 4; ++j) acc[p][i][j] = __builtin_amdgcn_mfma_f32_16x16x32_bf16(b[j], a[i], acc[p][i][j], 0, 0, 0);
            }
        }
    }
    __syncthreads();
}

__device__ __forceinline__ float row_ssq64(const f32x4 (&a)[4]) {
    float s = 0.f;
#pragma unroll
    for (int j = 0; j < 4; ++j) s += a[j][0] * a[j][0] + a[j][1] * a[j][1] + a[j][2] * a[j][2] + a[j][3] * a[j][3];
    s += __shfl_xor(s, 16); s += __shfl_xor(s, 32);
    return s;
}

__device__ __forceinline__ void inproj_phase(const Ptrs& P, char* smem, int vb, int nvb) {
    unsigned char* ws = P.ws;
    GemmDesc g[1] = {{(const bf16_t*)(ws + O_XN), (const bf16_t*)(ws + O_WT_IN), DM, DM, DM, 0}};
    constexpr int TN = NIN / 128, TM = NTOK / 128;
    const int lane = threadIdx.x & 63, wave = threadIdx.x >> 6, wm = wave >> 1, wn = wave & 1, fr = lane & 15, q = lane >> 4;
    for (int t = vb; t < TM * TN; t += nvb) {
        const int tm = t / TN, tn = t % TN, m0 = tm * 128, n0 = tn * 128;
        f32x4 acc[1][4][4];
        gemm_tile<1>(smem, g, m0, n0, acc);
        const int mb = m0 + wm * 64, nb = n0 + wn * 64;
        if (nb < 512) {
            bf16_t* U = (bf16_t*)(ws + O_U);
#pragma unroll
            for (int i = 0; i < 4; ++i)
#pragma unroll
                for (int j = 0; j < 4; ++j) { const f32x4 v = acc[0][i][j]; uint2 o; o.x = pk2(v[0], v[1]); o.y = pk2(v[2], v[3]);
                    *(uint2*)(U + (size_t)(mb + 16 * i + fr) * 512 + nb + 16 * j + 4 * q) = o; }
        } else if (nb < 1024) {
            bf16_t* QN = (bf16_t*)(ws + O_QN); const float* gq = P.in[19];
#pragma unroll
            for (int i = 0; i < 4; ++i) {
                const float rstd = rsqrtf(row_ssq64(acc[0][i]) * (1.0f / 64) + EPS);
#pragma unroll
                for (int j = 0; j < 4; ++j) { const f32x4 v = acc[0][i][j]; const float4 gg = *(const float4*)(gq + 16 * j + 4 * q);
                    uint2 o; o.x = pk2(v[0] * rstd * gg.x, v[1] * rstd * gg.y); o.y = pk2(v[2] * rstd * gg.z, v[3] * rstd * gg.w);
                    *(uint2*)(QN + (size_t)(mb + 16 * i + fr) * 512 + (nb - 512) + 16 * j + 4 * q) = o; }
            }
        } else if (nb < 1792) {
            const int idx = (nb - 1024) >> 6, br = idx >> 2, isv = (idx >> 1) & 1, gg_ = idx & 1;
            bf16_t* dst = (bf16_t*)(ws + O_KCIN + (size_t)(br * 2 + isv) * 8 * MiB);
            const bool donorm = (br > 0) && !isv; const float* gk = P.in[20] + br * 64;
#pragma unroll
            for (int i = 0; i < 4; ++i) {
                const int m = mb + 16 * i + fr, b = m >> 13, s = m & 8191;
                float rstd = 1.f; if (donorm) rstd = rsqrtf(row_ssq64(acc[0][i]) * (1.0f / 64) + EPS);
#pragma unroll
                for (int j = 0; j < 4; ++j) { f32x4 v = acc[0][i][j];
                    if (donorm) { const float4 gg = *(const float4*)(gk + 16 * j + 4 * q); v[0] *= rstd * gg.x; v[1] *= rstd * gg.y; v[2] *= rstd * gg.z; v[3] *= rstd * gg.w; }
                    uint2 o; o.x = pk2(v[0], v[1]); o.y = pk2(v[2], v[3]);
                    *(uint2*)(dst + ((size_t)(b * 2 + gg_) * SEQ + s) * 64 + 16 * j + 4 * q) = o; }
            }
        } else if (nb < 3840) {
            bf16_t* MG = (bf16_t*)(ws + O_MG);
#pragma unroll
            for (int i = 0; i < 4; ++i)
#pragma unroll
                for (int j = 0; j < 4; ++j) { const f32x4 v = acc[0][i][j]; uint2 o; o.x = pk2(sigmoidf_(v[0]), sigmoidf_(v[1])); o.y = pk2(sigmoidf_(v[2]), sigmoidf_(v[3]));
                    *(uint2*)(MG + (size_t)(mb + 16 * i + fr) * 2048 + (nb - 1792) + 16 * j + 4 * q) = o; }
        } else if (nb == 3840) {
            float* G = (float*)(ws + O_GATES);
#pragma unroll
            for (int i = 0; i < 4; ++i)
#pragma unroll
                for (int j = 0; j < 2; ++j) { const int c = 16 * j + 4 * q;
                    if (c < 24) { const f32x4 v = acc[0][i][j]; float4 o = {sigmoidf_(v[0]), sigmoidf_(v[1]), sigmoidf_(v[2]), sigmoidf_(v[3])};
                        *(float4*)(G + (size_t)(mb + 16 * i + fr) * 24 + c) = o; } }
        }
    }
}

__device__ __forceinline__ void compress_phase(const Ptrs& P, char* smem, int vb, int nvb) {
    unsigned char* ws = P.ws;
    const int lane = threadIdx.x & 63, wave = threadIdx.x >> 6, wm = wave >> 1, wn = wave & 1, fr = lane & 15, q = lane >> 4;
    bf16_t* H = (bf16_t*)smem;
    constexpr int HS = 136;
    for (int t = vb; t < 64; t += nvb) {
        const int isv = t >> 5, tm = t & 31, m0 = tm * 128;
        GemmDesc g[1] = {{(const bf16_t*)(ws + (isv ? O_VCIN : O_KCIN)), (const bf16_t*)(ws + (isv ? O_WT_CV1 : O_WT_CK1)), 1024, 2048, 2048, 0}};
        f32x4 acc[1][4][4];
        gemm_tile<1>(smem, g, m0, 0, acc);
        const float* b1 = (const float*)(ws + (isv ? O_B1V : O_B1K));
#pragma unroll
        for (int i = 0; i < 4; ++i)
#pragma unroll
            for (int j = 0; j < 4; ++j) { const f32x4 v = acc[0][i][j]; const int n = wn * 64 + 16 * j + 4 * q; const float4 bb = *(const float4*)(b1 + n);
                uint2 o; o.x = pk2(gelu_tanh(v[0] + bb.x), gelu_tanh(v[1] + bb.y)); o.y = pk2(gelu_tanh(v[2] + bb.z), gelu_tanh(v[3] + bb.w));
                *(uint2*)(H + (wm * 64 + 16 * i + fr) * HS + n) = o; }
        __syncthreads();
        const bf16_t* W2t = (const bf16_t*)(ws + (isv ? O_WT_CV2 : O_WT_CK2));
        f32x4 o2[2][4];
#pragma unroll
        for (int i = 0; i < 2; ++i)
#pragma unroll
            for (int j = 0; j < 4; ++j) o2[i][j] = (f32x4){0.f, 0.f, 0.f, 0.f};
#pragma unroll
        for (int ks = 0; ks < 4; ++ks) {
            bf16x8 a[2], b[4];
#pragma unroll
            for (int i = 0; i < 2; ++i) a[i] = *(const bf16x8*)(H + (wave * 32 + 16 * i + fr) * HS + ks * 32 + 8 * q);
#pragma unroll
            for (int j = 0; j < 4; ++j) b[j] = *(const bf16x8*)(W2t + (size_t)(16 * j + fr) * 128 + ks * 32 + 8 * q);
#pragma unroll
            for (int i = 0; i < 2; ++i)
#pragma unroll
                for (int j = 0; j < 4; ++j) o2[i][j] = __builtin_amdgcn_mfma_f32_16x16x32_bf16(b[j], a[i], o2[i][j], 0, 0, 0);
        }
        bf16_t* dst = (bf16_t*)(ws + (isv ? O_VC : O_KC));
        const float* gk = P.in[20];
#pragma unroll
        for (int i = 0; i < 2; ++i) {
            float rstd = 1.f; if (!isv) rstd = rsqrtf(row_ssq64(o2[i]) * (1.0f / 64) + EPS);
            const int R = m0 + wave * 32 + 16 * i + fr;
#pragma unroll
            for (int j = 0; j < 4; ++j) { f32x4 v = o2[i][j];
                if (!isv) { const float4 gg = *(const float4*)(gk + 16 * j + 4 * q); v[0] *= rstd * gg.x; v[1] *= rstd * gg.y; v[2] *= rstd * gg.z; v[3] *= rstd * gg.w; }
                uint2 o; o.x = pk2(v[0], v[1]); o.y = pk2(v[2], v[3]);
                *(uint2*)(dst + (size_t)R * 64 + 16 * j + 4 * q) = o; }
        }
        __syncthreads();
    }
}

constexpr int S5_BU_STR = 132, S5_XB_STR = 136;
constexpr int S5_WAVE_LDS = 16 * S5_BU_STR * 4 + 16 * S5_XB_STR * 2;
template <bool ENDS_ONLY>
__device__ __forceinline__ void s5_phase(const Ptrs& P, char* smem, int vb, int nvb) {
    unsigned char* ws = P.ws;
    const int lane = threadIdx.x & 63, wave = threadIdx.x >> 6, fr = lane & 15, q = lane >> 4;
    float* BU = (float*)(smem + wave * S5_WAVE_LDS);
    bf16_t* XB = (bf16_t*)(smem + wave * S5_WAVE_LDS + 16 * S5_BU_STR * 4);
    const bf16_t* U = (const bf16_t*)(ws + O_U);
    const float* ABAR = (const float*)(ws + O_ABAR); const float* AL = (const float*)(ws + O_AL);
    float* ENDS = (float*)(ws + O_ENDS);
    const int gw = vb * 4 + wave, ngw = nvb * 4;
    for (int it = gw; it < NB * NCHUNK * 32; it += ngw) {
        const int g = it & 31, c = (it >> 5) & (NCHUNK - 1), b = it >> 11;
        const float ar = ABAR[(g * 64 + lane) * 2], ai = ABAR[(g * 64 + lane) * 2 + 1];
        bf16x8 bb[8];
#pragma unroll
        for (int nt = 0; nt < 8; ++nt) {
            bb[nt] = (bf16x8){0, 0, 0, 0, 0, 0, 0, 0};
            if (q < 2) bb[nt] = *(const bf16x8*)((const bf16_t*)(ws + O_BBT) + ((size_t)g * 128 + 16 * nt + fr) * 16 + 8 * q);
        }
        bf16x8 ct[4];
        if (!ENDS_ONLY) {
#pragma unroll
            for (int ks = 0; ks < 4; ++ks) ct[ks] = *(const bf16x8*)((const bf16_t*)(ws + O_CT) + ((size_t)g * 16 + fr) * 128 + ks * 32 + 8 * q);
        }
        float xr = 0.f, xi = 0.f;
        if (!ENDS_ONLY) {
            const float alr = AL[(g * 64 + lane) * 2], ali = AL[(g * 64 + lane) * 2 + 1];
            for (int cp = 0; cp < c; ++cp) {
                const float2 e = *(const float2*)(ENDS + (((size_t)(b * NCHUNK + cp) * 32 + g) * 64 + lane) * 2);
                const float nr = alr * xr - ali * xi + e.x, ni = alr * xi + ali * xr + e.y; xr = nr; xi = ni;
            }
        }
        const size_t tok0 = (size_t)b * SEQ + (size_t)c * CHUNK;
        for (int sub = 0; sub < CHUNK / 16; ++sub) {
            const size_t tk = tok0 + sub * 16;
            bf16x8 uf = (bf16x8){0, 0, 0, 0, 0, 0, 0, 0};
            if (q < 2) uf = *(const bf16x8*)(U + (tk + fr) * 512 + g * 16 + 8 * q);
#pragma unroll
            for (int nt = 0; nt < 8; ++nt) {
                f32x4 d = __builtin_amdgcn_mfma_f32_16x16x32_bf16(bb[nt], uf, (f32x4){0.f, 0.f, 0.f, 0.f}, 0, 0, 0);
                *(f32x4*)(BU + fr * S5_BU_STR + 16 * nt + 4 * q) = d;
            }
            asm volatile("s_waitcnt lgkmcnt(0)" ::: "memory");
#pragma unroll 4
            for (int s = 0; s < 16; ++s) {
                const float br = BU[s * S5_BU_STR + lane], bi = BU[s * S5_BU_STR + 64 + lane];
                const float nr = ar * xr - ai * xi + br, ni = ar * xi + ai * xr + bi; xr = nr; xi = ni;
                if (!ENDS_ONLY) { XB[s * S5_XB_STR + lane] = f2bf(xr); XB[s * S5_XB_STR + 64 + lane] = f2bf(xi); }
            }
            asm volatile("s_waitcnt lgkmcnt(0)" ::: "memory");
            if (!ENDS_ONLY) {
                f32x4 y = (f32x4){0.f, 0.f, 0.f, 0.f};
#pragma unroll
                for (int ks = 0; ks < 4; ++ks) {
                    const bf16x8 xf = *(const bf16x8*)(XB + fr * S5_XB_STR + ks * 32 + 8 * q);
                    y = __builtin_amdgcn_mfma_f32_16x16x32_bf16(ct[ks], xf, y, 0, 0, 0);
                }
                const uint2 uu = *(const uint2*)(U + (tk + fr) * 512 + g * 16 + 4 * q);
                const float4 dd = *(const float4*)(P.in[10] + g * 16 + 4 * q);
                const float y0 = gelu_tanh(y[0] + dd.x * bf2f((bf16_t)(uu.x & 0xffff))), y1 = gelu_tanh(y[1] + dd.y * bf2f((bf16_t)(uu.x >> 16)));
                const float y2 = gelu_tanh(y[2] + dd.z * bf2f((bf16_t)(uu.y & 0xffff))), y3 = gelu_tanh(y[3] + dd.w * bf2f((bf16_t)(uu.y >> 16)));
                uint2 o; o.x = pk2(y0, y1); o.y = pk2(y2, y3);
                *(uint2*)((bf16_t*)(ws + O_YG) + (tk + fr) * 512 + g * 16 + 4 * q) = o;
                asm volatile("s_waitcnt lgkmcnt(0)" ::: "memory");
            }
        }
        if (ENDS_ONLY) *(float2*)(ENDS + (((size_t)(b * NCHUNK + c) * 32 + g) * 64 + lane) * 2) = make_float2(xr, xi);
    }
}

constexpr int ATT_LDS = (4 * 64 + 4 * 512 + 128 + 4 * 1024) * 4;
__device__ __forceinline__ float dot64(const float (&qv)[64], const bf16_t* krow) {
    float s = 0.f;
#pragma unroll
    for (int c = 0; c < 8; ++c) {
        const uint4 w = *(const uint4*)(krow + c * 8);
        s += qv[c * 8 + 0] * __uint_as_float(w.x << 16) + qv[c * 8 + 1] * __uint_as_float(w.x & 0xffff0000u);
        s += qv[c * 8 + 2] * __uint_as_float(w.y << 16) + qv[c * 8 + 3] * __uint_as_float(w.y & 0xffff0000u);
        s += qv[c * 8 + 4] * __uint_as_float(w.z << 16) + qv[c * 8 + 5] * __uint_as_float(w.z & 0xffff0000u);
        s += qv[c * 8 + 6] * __uint_as_float(w.w << 16) + qv[c * 8 + 7] * __uint_as_float(w.w & 0xffff0000u);
    }
    return s;
}
__device__ __forceinline__ void attn_ref_phase(const Ptrs& P, char* smem, int vb, int nvb) {
    unsigned char* ws = P.ws;
    const int tid = threadIdx.x, lane = tid & 63, w = tid >> 6;
    float* qs = (float*)smem;
    float* pc = qs + 256;
    float* imp = pc + 2048;
    float* pw = imp + 128;
    int* sel_s = (int*)(pw + 4096);
    const bf16_t* QN = (const bf16_t*)(ws + O_QN);
    const float NEG = -1e30f;
    for (int it = vb; it < NB * 2 * SEQ; it += nvb) {
        const int t = it & (SEQ - 1), g = (it >> 13) & 1, b = it >> 14, bg = b * 2 + g;
        const size_t tok = (size_t)b * SEQ + t;
        const int h = g * 4 + w;
        const float slope = exp2f(-(float)(h + 1));
        __syncthreads();
        qs[w * 64 + lane] = bf2f(QN[tok * 512 + h * 64 + lane]);
        __syncthreads();
        float qv[64];
#pragma unroll
        for (int d = 0; d < 64; ++d) qv[d] = qs[w * 64 + d];
        const int n_vis = (t >= 31) ? ((t - 31) / 16 + 1) : 0;
        const bf16_t* KC = (const bf16_t*)(ws + O_KC) + (size_t)bg * 512 * 64;
        const bf16_t* VC = (const bf16_t*)(ws + O_VC) + (size_t)bg * 512 * 64;
        float sc[8]; float mx = NEG;
#pragma unroll
        for (int i = 0; i < 8; ++i) { const int j = lane + 64 * i; sc[i] = NEG;
            if (j < n_vis) { sc[i] = dot64(qv, KC + (size_t)j * 64) * 0.125f - slope * (float)(t - (16 * j + 31)); mx = fmaxf(mx, sc[i]); } }
        mx = wave_max(mx);
        float sum = 0.f;
#pragma unroll
        for (int i = 0; i < 8; ++i) { const int j = lane + 64 * i; sc[i] = (j < n_vis) ? __expf(sc[i] - mx) : 0.f; sum += sc[i]; }
        sum = wave_sum(sum);
        const float inv = (n_vis > 0) ? 1.0f / sum : 0.f;
#pragma unroll
        for (int i = 0; i < 8; ++i) pc[w * 512 + lane + 64 * i] = sc[i] * inv;
        __syncthreads();
        float o_cmp = 0.f;
        for (int j = 0; j < n_vis; ++j) o_cmp += pc[w * 512 + j] * bf2f(VC[(size_t)j * 64 + lane]);
        const int cur = t >> 6;
        if (tid < 128) {
            const int blk = tid; float v = 0.f;
#pragma unroll
            for (int hh = 0; hh < 4; ++hh) { v += pc[hh * 512 + 4 * blk] + pc[hh * 512 + 4 * blk + 1] + pc[hh * 512 + 4 * blk + 2] + pc[hh * 512 + 4 * blk + 3]; if (blk > 0) v += pc[hh * 512 + 4 * blk - 1]; }
            const bool valid = blk <= cur, forced = (blk == 0) || (blk == cur) || (blk == cur - 1);
            imp[blk] = valid ? (v + (forced ? 1e4f : 0.f)) : NEG;
        }
        __syncthreads();
        float v0 = imp[lane], v1 = imp[lane + 64];
        int sel[16];
#pragma unroll
        for (int r = 0; r < 16; ++r) {
            float bv; int bi;
            if (v0 >= v1) { bv = v0; bi = lane; } else { bv = v1; bi = lane + 64; }
#pragma unroll
            for (int o = 1; o < 64; o <<= 1) { const float ov = __shfl_xor(bv, o); const int oi = __shfl_xor(bi, o); if (ov > bv || (ov == bv && oi < bi)) { bv = ov; bi = oi; } }
            sel[r] = bi; if (lane == 0) sel_s[w * 16 + r] = bi;
            if (bi == lane) v0 = -3e38f; if (bi == lane + 64) v1 = -3e38f;
        }
        const bf16_t* KS = (const bf16_t*)(ws + O_KS) + (size_t)bg * SEQ * 64;
        const bf16_t* VS = (const bf16_t*)(ws + O_VS) + (size_t)bg * SEQ * 64;
        float ss[16]; mx = NEG;
#pragma unroll
        for (int r = 0; r < 16; ++r) { const int pos = sel[r] * 64 + lane; ss[r] = NEG;
            if (pos <= t) { ss[r] = dot64(qv, KS + (size_t)pos * 64) * 0.125f - slope * (float)(t - pos); mx = fmaxf(mx, ss[r]); } }
        mx = wave_max(mx); sum = 0.f;
#pragma unroll
        for (int r = 0; r < 16; ++r) { const int pos = sel[r] * 64 + lane; ss[r] = (pos <= t) ? __expf(ss[r] - mx) : 0.f; sum += ss[r]; }
        sum = wave_sum(sum);
        { const float iv = 1.0f / sum;
#pragma unroll
          for (int r = 0; r < 16; ++r) pw[w * 1024 + r * 64 + lane] = ss[r] * iv; }
        __syncthreads();
        float o_slc = 0.f;
#pragma unroll 1
        for (int r = 0; r < 16; ++r) { const int blk = sel_s[w * 16 + r]; if (blk > cur) continue; const bf16_t* vb_ = VS + (size_t)blk * 64 * 64 + lane;
            for (int kk = 0; kk < 64; ++kk) o_slc += pw[w * 1024 + r * 64 + kk] * bf2f(vb_[(size_t)kk * 64]); }
        __syncthreads();
        const bf16_t* KW = (const bf16_t*)(ws + O_KW) + (size_t)bg * SEQ * 64;
        const bf16_t* VW = (const bf16_t*)(ws + O_VW) + (size_t)bg * SEQ * 64;
        float sw[8]; mx = NEG;
#pragma unroll
        for (int i = 0; i < 8; ++i) { const int pos = t - 511 + lane + 64 * i; sw[i] = NEG;
            if (pos >= 0) { sw[i] = dot64(qv, KW + (size_t)pos * 64) * 0.125f - slope * (float)(t - pos); mx = fmaxf(mx, sw[i]); } }
        mx = wave_max(mx); sum = 0.f;
#pragma unroll
        for (int i = 0; i < 8; ++i) { const int pos = t - 511 + lane + 64 * i; sw[i] = (pos >= 0) ? __expf(sw[i] - mx) : 0.f; sum += sw[i]; }
        sum = wave_sum(sum);
        { const float iv = 1.0f / sum;
#pragma unroll
          for (int i = 0; i < 8; ++i) pw[w * 1024 + lane + 64 * i] = sw[i] * iv; }
        __syncthreads();
        float o_win = 0.f;
        { const int i0 = (t >= 511) ? 0 : (511 - t);
          for (int i = i0; i < 512; ++i) o_win += pw[w * 1024 + i] * bf2f(VW[(size_t)(t - 511 + i) * 64 + lane]); }
        const float* G = (const float*)(ws + O_GATES) + tok * 24;
        const float y = G[h] * o_cmp + G[8 + h] * o_slc + G[16 + h] * o_win;
        ((bf16_t*)(ws + O_YNSA))[tok * 512 + h * 64 + lane] = f2bf(y);
    }
}

__device__ __forceinline__ void glu_phase(const Ptrs& P, char* smem, int vb, int nvb) {
    unsigned char* ws = P.ws;
    GemmDesc g[1] = {{(const bf16_t*)(ws + O_YG), (const bf16_t*)(ws + O_WT_GLU), 512, 512, 512, 0}};
    const int lane = threadIdx.x & 63, wave = threadIdx.x >> 6, wm = wave >> 1, wn = wave & 1, fr = lane & 15, q = lane >> 4;
    const bf16_t* YG = (const bf16_t*)(ws + O_YG); bf16_t* YS = (bf16_t*)(ws + O_YSSM); const float* bg = P.in[12];
    for (int t = vb; t < (NTOK / 128) * 4; t += nvb) {
        const int tm = t >> 2, tn = t & 3, m0 = tm * 128, n0 = tn * 128;
        f32x4 acc[1][4][4];
        gemm_tile<1>(smem, g, m0, n0, acc);
        const int mb = m0 + wm * 64, nb = n0 + wn * 64;
#pragma unroll
        for (int i = 0; i < 4; ++i)
#pragma unroll
            for (int j = 0; j < 4; ++j) { const f32x4 v = acc[0][i][j]; const size_t off = (size_t)(mb + 16 * i + fr) * 512 + nb + 16 * j + 4 * q;
                const uint2 yy = *(const uint2*)(YG + off); const float4 bb = *(const float4*)(bg + nb + 16 * j + 4 * q);
                uint2 o; o.x = pk2(bf2f((bf16_t)(yy.x & 0xffff)) * sigmoidf_(v[0] + bb.x), bf2f((bf16_t)(yy.x >> 16)) * sigmoidf_(v[1] + bb.y));
                o.y = pk2(bf2f((bf16_t)(yy.y & 0xffff)) * sigmoidf_(v[2] + bb.z), bf2f((bf16_t)(yy.y >> 16)) * sigmoidf_(v[3] + bb.w));
                *(uint2*)(YS + off) = o; }
    }
}

__device__ __forceinline__ void merge_phase(const Ptrs& P, char* smem, int vb, int nvb) {
    unsigned char* ws = P.ws;
    GemmDesc g[2] = {{(const bf16_t*)(ws + O_YSSM), (const bf16_t*)(ws + O_WT_PS), 512, 512, 512, 0}, {(const bf16_t*)(ws + O_YNSA), (const bf16_t*)(ws + O_WT_PN), 512, 512, 512, 0}};
    const int lane = threadIdx.x & 63, wave = threadIdx.x >> 6, wm = wave >> 1, wn = wave & 1, fr = lane & 15, q = lane >> 4;
    const bf16_t* MG = (const bf16_t*)(ws + O_MG); bf16_t* ME = (bf16_t*)(ws + O_MERGED);
    for (int t = vb; t < (NTOK / 128) * 8; t += nvb) {
        const int tm = t >> 3, tn = t & 7, m0 = tm * 128, n0 = tn * 128;
        f32x4 acc[2][4][4];
        gemm_tile<2>(smem, g, m0, n0, acc);
        const int mb = m0 + wm * 64, nb = n0 + wn * 64;
#pragma unroll
        for (int i = 0; i < 4; ++i)
#pragma unroll
            for (int j = 0; j < 4; ++j) { const f32x4 a = acc[0][i][j], c = acc[1][i][j]; const int m = mb + 16 * i + fr, n = nb + 16 * j + 4 * q;
                const uint2 g0 = *(const uint2*)(MG + (size_t)m * 2048 + n), g1 = *(const uint2*)(MG + (size_t)m * 2048 + 1024 + n);
                uint2 o;
                o.x = pk2(bf2f((bf16_t)(g0.x & 0xffff)) * a[0] + bf2f((bf16_t)(g1.x & 0xffff)) * c[0], bf2f((bf16_t)(g0.x >> 16)) * a[1] + bf2f((bf16_t)(g1.x >> 16)) * c[1]);
                o.y = pk2(bf2f((bf16_t)(g0.y & 0xffff)) * a[2] + bf2f((bf16_t)(g1.y & 0xffff)) * c[2], bf2f((bf16_t)(g0.y >> 16)) * a[3] + bf2f((bf16_t)(g1.y >> 16)) * c[3]);
                *(uint2*)(ME + (size_t)m * 1024 + n) = o; }
    }
}

__device__ __forceinline__ void outproj_phase(const Ptrs& P, char* smem, int vb, int nvb) {
    unsigned char* ws = P.ws;
    GemmDesc g[1] = {{(const bf16_t*)(ws + O_MERGED), (const bf16_t*)(ws + O_WT_OUT), 1024, 1024, 1024, 0}};
    const int lane = threadIdx.x & 63, wave = threadIdx.x >> 6, wm = wave >> 1, wn = wave & 1, fr = lane & 15, q = lane >> 4;
    const float* x = P.in[0]; float* out = P.out; bf16_t* X1B = (bf16_t*)(ws + O_X1B); float* SSQ = (float*)(ws + O_SSQ);
    for (int t = vb; t < (NTOK / 128) * 8; t += nvb) {
        const int tm = t >> 3, tn = t & 7, m0 = tm * 128, n0 = tn * 128;
        f32x4 acc[1][4][4];
        gemm_tile<1>(smem, g, m0, n0, acc);
        const int mb = m0 + wm * 64, nb = n0 + wn * 64;
#pragma unroll
        for (int i = 0; i < 4; ++i) {
            const int m = mb + 16 * i + fr; f32x4 r[4];
#pragma unroll
            for (int j = 0; j < 4; ++j) { const size_t off = (size_t)m * 1024 + nb + 16 * j + 4 * q; const float4 xv = *(const float4*)(x + off);
                f32x4 v = acc[0][i][j]; v[0] += xv.x; v[1] += xv.y; v[2] += xv.z; v[3] += xv.w; r[j] = v;
                *(float4*)(out + off) = make_float4(v[0], v[1], v[2], v[3]);
                uint2 o; o.x = pk2(v[0], v[1]); o.y = pk2(v[2], v[3]); *(uint2*)(X1B + off) = o; }
            const float s = row_ssq64(r);
            if (q == 0) atomicAdd(SSQ + m, s);
        }
    }
}

__device__ __forceinline__ void up_phase(const Ptrs& P, char* smem, int vb, int nvb) {
    unsigned char* ws = P.ws;
    GemmDesc g[1] = {{(const bf16_t*)(ws + O_X1B), (const bf16_t*)(ws + O_WT_UP), 1024, 1024, 1024, 0}};
    const int lane = threadIdx.x & 63, wave = threadIdx.x >> 6, wm = wave >> 1, wn = wave & 1, fr = lane & 15, q = lane >> 4;
    bf16_t* FF = (bf16_t*)(ws + O_FF); const float* SSQ = (const float*)(ws + O_SSQ);
    for (int t = vb; t < (NTOK / 128) * 32; t += nvb) {
        const int tm = t >> 5, tn = t & 31, m0 = tm * 128, n0 = tn * 128;
        f32x4 acc[1][4][4];
        gemm_tile<1>(smem, g, m0, n0, acc);
        const int mb = m0 + wm * 64, nb = n0 + wn * 64;
#pragma unroll
        for (int i = 0; i < 4; ++i) {
            const int m = mb + 16 * i + fr; const float rstd = rsqrtf(SSQ[m] * (1.0f / DM) + EPS);
#pragma unroll
            for (int j = 0; j < 4; ++j) { f32x4 v = acc[0][i][j];
#pragma unroll
                for (int r = 0; r < 4; ++r) { const float a = fmaxf(v[r], 0.f) * rstd; v[r] = a * a; }
                uint2 o; o.x = pk2(v[0], v[1]); o.y = pk2(v[2], v[3]);
                *(uint2*)(FF + (size_t)m * DFF + nb + 16 * j + 4 * q) = o; }
        }
    }
}

__device__ __forceinline__ void down_phase(const Ptrs& P, char* smem, int vb, int nvb) {
    unsigned char* ws = P.ws;
    GemmDesc g[1] = {{(const bf16_t*)(ws + O_FF), (const bf16_t*)(ws + O_WT_DOWN), DFF, DFF, DFF, 0}};
    const int lane = threadIdx.x & 63, wave = threadIdx.x >> 6, wm = wave >> 1, wn = wave & 1, fr = lane & 15, q = lane >> 4;
    float* out = P.out;
    for (int t = vb; t < (NTOK / 128) * 8; t += nvb) {
        const int tm = t >> 3, tn = t & 7, m0 = tm * 128, n0 = tn * 128;
        f32x4 acc[1][4][4];
        gemm_tile<1>(smem, g, m0, n0, acc);
        const int mb = m0 + wm * 64, nb = n0 + wn * 64;
#pragma unroll
        for (int i = 0; i < 4; ++i)
#pragma unroll
            for (int j = 0; j < 4; ++j) { const size_t off = (size_t)(mb + 16 * i + fr) * 1024 + nb + 16 * j + 4 * q; const float4 xv = *(const float4*)(out + off);
                const f32x4 v = acc[0][i][j]; *(float4*)(out + off) = make_float4(v[0] + xv.x, v[1] + xv.y, v[2] + xv.z, v[3] + xv.w); }
    }
}

constexpr int SMEM_BYTES = 52 * 1024;
#define KDEF(name, call) __global__ void __launch_bounds__(256) name(Ptrs P, TrTable tt) { extern __shared__ __attribute__((aligned(16))) char smem[]; (void)tt; call; }
KDEF(k_transpose, transpose_phase(tt, smem, blockIdx.x, gridDim.x))
KDEF(k_consts, consts_phase(P, blockIdx.x, gridDim.x))
KDEF(k_rms1, rmsnorm1_phase(P, blockIdx.x, gridDim.x))
KDEF(k_inproj, inproj_phase(P, smem, blockIdx.x, gridDim.x))
KDEF(k_compress, compress_phase(P, smem, blockIdx.x, gridDim.x))
KDEF(k_s5ends, s5_phase<true>(P, smem, blockIdx.x, gridDim.x))
KDEF(k_s5main, s5_phase<false>(P, smem, blockIdx.x, gridDim.x))
KDEF(k_attn, attn_ref_phase(P, smem, blockIdx.x, gridDim.x))
KDEF(k_glu, glu_phase(P, smem, blockIdx.x, gridDim.x))
KDEF(k_merge, merge_phase(P, smem, blockIdx.x, gridDim.x))
KDEF(k_outproj, outproj_phase(P, smem, blockIdx.x, gridDim.x))
KDEF(k_up, up_phase(P, smem, blockIdx.x, gridDim.x))
KDEF(k_down, down_phase(P, smem, blockIdx.x, gridDim.x))


__global__ void __launch_bounds__(256) k_mega(Ptrs P, TrTable tt) {
    extern __shared__ __attribute__((aligned(16))) char smem[];
    cg::grid_group grid = cg::this_grid();
    const int vb = blockIdx.x, nvb = gridDim.x;
    transpose_phase(tt, smem, vb, nvb);
    consts_phase(P, vb, nvb);
    rmsnorm1_phase(P, vb, nvb);
    grid.sync();
    inproj_phase(P, smem, vb, nvb);
    grid.sync();
    compress_phase(P, smem, vb, nvb);
    s5_phase<true>(P, smem, nvb - 1 - vb, nvb);
    grid.sync();
    attn_ref_phase(P, smem, vb, nvb);
    s5_phase<false>(P, smem, vb, nvb);
    grid.sync();
    glu_phase(P, smem, vb, nvb);
    grid.sync();
    merge_phase(P, smem, vb, nvb);
    grid.sync();
    outproj_phase(P, smem, vb, nvb);
    grid.sync();
    up_phase(P, smem, vb, nvb);
    grid.sync();
    down_phase(P, smem, vb, nvb);
}

static void add_tr(TrTable& tt, int& n, const float* src, bf16_t* dst, const float* kscale, int K, int N, int ldsrc, int mode) {
    TrDesc& d = tt.d[n]; d.src = src; d.dst = dst; d.kscale = kscale; d.K = K; d.N = N; d.ldsrc = ldsrc; d.mode = mode; d.tiles_n = N / 64; d.tile0 = tt.total;
    tt.total += (K / 64) * (N / 64); ++n;
}

extern "C" void kernel_launch(void* const* d_in, const int* in_sizes, int n_in, void* d_out, int out_size, void* d_ws, size_t ws_size, hipStream_t stream) {
    if (n_in != 27 || ws_size < WS_END) { fprintf(stderr, "kernel_launch: unexpected n_in %d or ws_size %zu (need %zu)\n", n_in, ws_size, (size_t)WS_END); return; }
    Ptrs P{};
    for (int i = 0; i < 27; ++i) P.in[i] = (const float*)d_in[i];
    P.out = (float*)d_out; P.ws = (unsigned char*)d_ws;
    unsigned char* ws = P.ws;
    TrTable tt{}; int n = 0;
    add_tr(tt, n, P.in[2], (bf16_t*)(ws + O_WT_IN), nullptr, 1024, NIN, 3864, 1);
    add_tr(tt, n, P.in[11], (bf16_t*)(ws + O_WT_GLU), nullptr, 512, 512, 512, 0);
    add_tr(tt, n, P.in[21], (bf16_t*)(ws + O_WT_PS), nullptr, 512, 1024, 1024, 0);
    add_tr(tt, n, P.in[22], (bf16_t*)(ws + O_WT_PN), nullptr, 512, 1024, 1024, 0);
    add_tr(tt, n, P.in[23], (bf16_t*)(ws + O_WT_OUT), nullptr, 1024, 1024, 1024, 0);
    add_tr(tt, n, P.in[25], (bf16_t*)(ws + O_WT_UP), P.in[24], 1024, 4096, 4096, 0);
    add_tr(tt, n, P.in[26], (bf16_t*)(ws + O_WT_DOWN), nullptr, 4096, 1024, 1024, 0);
    add_tr(tt, n, P.in[15], (bf16_t*)(ws + O_WT_CK1), nullptr, 2048, 128, 128, 0);
    add_tr(tt, n, P.in[17], (bf16_t*)(ws + O_WT_CV1), nullptr, 2048, 128, 128, 0);
    add_tr(tt, n, P.in[16], (bf16_t*)(ws + O_WT_CK2), nullptr, 128, 64, 64, 0);
    add_tr(tt, n, P.in[18], (bf16_t*)(ws + O_WT_CV2), nullptr, 128, 64, 64, 0);
#if MULTI_LAUNCH
    const int G = 1024;
#define LAUNCH(k, grid) hipLaunchKernelGGL(k, dim3(grid), dim3(256), SMEM_BYTES, stream, P, tt)
    LAUNCH(k_transpose, G);
    LAUNCH(k_consts, 64);
    LAUNCH(k_rms1, G);
    LAUNCH(k_inproj, G);
    LAUNCH(k_compress, 64);
    LAUNCH(k_s5ends, G);
    LAUNCH(k_attn, 2048);
    LAUNCH(k_s5main, G);
    LAUNCH(k_glu, G);
    LAUNCH(k_merge, G);
    LAUNCH(k_outproj, G);
    LAUNCH(k_up, G);
    LAUNCH(k_down, G);
#else
    static int grid_blocks = 0;
    if (!grid_blocks) {
        int dev = 0, cus = 0, per_cu = 0;
        hipGetDevice(&dev);
        hipDeviceGetAttribute(&cus, hipDeviceAttributeMultiprocessorCount, dev);
        hipOccupancyMaxActiveBlocksPerMultiprocessor(&per_cu, k_mega, 256, SMEM_BYTES);
        if (per_cu < 1) { fprintf(stderr, "kernel_launch: occupancy query returned %d\n", per_cu); per_cu = 1; }
        if (per_cu > 2) per_cu = 2;
        grid_blocks = cus * per_cu;
    }
    void* args[] = {(void*)&P, (void*)&tt};
    hipError_t e = hipLaunchCooperativeKernel((void*)k_mega, dim3(grid_blocks), dim3(256), args, SMEM_BYTES, stream);
    if (e != hipSuccess) fprintf(stderr, "cooperative launch failed: %s (grid %d)\n", hipGetErrorString(e), grid_blocks);
#endif
}
```

```cpp
#include <hip/hip_runtime.h>
#include <hip/hip_cooperative_groups.h>
namespace cg = cooperative_groups;
#ifndef MULTI_LAUNCH
#define MULTI_LAUNCH 0
#endif
#include <cstdio>
#include <cstdint>

typedef unsigned short bf16_t;
typedef short bf16x8 __attribute__((ext_vector_type(8)));
typedef float f32x4 __attribute__((ext_vector_type(4)));
typedef unsigned u32x4 __attribute__((ext_vector_type(4)));

constexpr int NB = 4, SEQ = 8192, DM = 1024, NTOK = NB * SEQ;
constexpr int NIN = 3968;
constexpr int DFF = 4096;
constexpr int CHUNK = 128, NCHUNK = SEQ / CHUNK;
constexpr float EPS = 1e-6f;

constexpr size_t MiB = 1024 * 1024;
constexpr size_t al256(size_t x) { return (x + 255) & ~(size_t)255; }
constexpr size_t O_WT_IN = 0;
constexpr size_t O_WT_GLU = O_WT_IN + (size_t)NIN * 1024 * 2;
constexpr size_t O_WT_PS = O_WT_GLU + 512 * 512 * 2;
constexpr size_t O_WT_PN = O_WT_PS + 1024 * 512 * 2;
constexpr size_t O_WT_OUT = O_WT_PN + 1024 * 512 * 2;
constexpr size_t O_WT_UP = O_WT_OUT + 1024 * 1024 * 2;
constexpr size_t O_WT_DOWN = O_WT_UP + (size_t)4096 * 1024 * 2;
constexpr size_t O_WT_CK1 = O_WT_DOWN + (size_t)4096 * 1024 * 2;
constexpr size_t O_WT_CV1 = O_WT_CK1 + 128 * 2048 * 2;
constexpr size_t O_WT_CK2 = O_WT_CV1 + 128 * 2048 * 2;
constexpr size_t O_WT_CV2 = O_WT_CK2 + 64 * 128 * 2;
constexpr size_t O_B1K = O_WT_CV2 + 64 * 128 * 2;
constexpr size_t O_B1V = O_B1K + 512;
constexpr size_t O_ABAR = O_B1V + 512;
constexpr size_t O_AL = O_ABAR + 32 * 64 * 2 * 4;
constexpr size_t O_BBT = O_AL + 32 * 64 * 2 * 4;
constexpr size_t O_CT = O_BBT + 32 * 128 * 16 * 2;
constexpr size_t O_ENDS = O_CT + 32 * 16 * 128 * 2;
constexpr size_t O_SSQ = O_ENDS + (size_t)NB * NCHUNK * 32 * 64 * 2 * 4;
constexpr size_t O_GATES = O_SSQ + (size_t)NTOK * 4;
constexpr size_t O_KC = O_GATES + (size_t)NTOK * 24 * 4;
constexpr size_t O_VC = O_KC + 8 * 512 * 64 * 2;
constexpr size_t O_VCT = O_VC + 8 * 512 * 64 * 2;
constexpr size_t O_M2 = O_VCT + 8 * 512 * 64 * 2;
constexpr size_t O_REGA = al256(O_M2 + 4096);
constexpr size_t O_XN = O_REGA;
constexpr size_t O_YSSM = O_XN;
constexpr size_t O_YNSA = O_XN + 32 * MiB;
constexpr size_t O_U = O_XN + 64 * MiB;
constexpr size_t O_QN = O_U + 32 * MiB;
constexpr size_t O_KCIN = O_QN + 32 * MiB;
constexpr size_t O_VCIN = O_KCIN + 8 * MiB;
constexpr size_t O_KS = O_VCIN + 8 * MiB;
constexpr size_t O_VS = O_KS + 8 * MiB;
constexpr size_t O_KW = O_VS + 8 * MiB;
constexpr size_t O_VW = O_KW + 8 * MiB;
constexpr size_t O_YG = O_VW + 8 * MiB;
constexpr size_t O_VST = O_YG + 32 * MiB;
constexpr size_t O_VWT = O_VST + 8 * MiB;
constexpr size_t O_FF = O_REGA;
constexpr size_t O_REGB = O_REGA + 256 * MiB;
constexpr size_t O_MG = O_REGB;
constexpr size_t O_X1B = O_REGB;
constexpr size_t O_MERGED = O_REGB + 128 * MiB;
constexpr size_t WS_END = O_MERGED + 64 * MiB;
static_assert(O_VWT + 8 * MiB <= O_REGB, "region A overflow");

__device__ __forceinline__ float bf2f(bf16_t h) { return __uint_as_float(((unsigned)h) << 16); }
__device__ __forceinline__ bf16_t f2bf(float f) { unsigned u = __float_as_uint(f); u += 0x7fffu + ((u >> 16) & 1u); return (bf16_t)(u >> 16); }
__device__ __forceinline__ unsigned pk2(float lo, float hi) { unsigned r; asm("v_cvt_pk_bf16_f32 %0, %1, %2" : "=v"(r) : "v"(lo), "v"(hi)); return r; }
__device__ __forceinline__ float sigmoidf_(float x) { return 1.0f / (1.0f + __expf(-x)); }
__device__ __forceinline__ float gelu_tanh(float x) { const float u = 0.7978845608028654f * (x + 0.044715f * x * x * x); return 0.5f * x * (1.0f + tanhf(u)); }
__device__ __forceinline__ float wave_sum(float v) {
#pragma unroll
    for (int o = 1; o < 64; o <<= 1) v += __shfl_xor(v, o);
    return v;
}
__device__ __forceinline__ float wave_max(float v) {
#pragma unroll
    for (int o = 1; o < 64; o <<= 1) v = fmaxf(v, __shfl_xor(v, o));
    return v;
}

struct Ptrs {
    const float* in[27];
    float* out;
    unsigned char* ws;
};

struct TrDesc { const float* src; bf16_t* dst; const float* kscale; int K, N, ldsrc, mode, tiles_n, tile0; };
constexpr int NTR = 11;
struct TrTable { TrDesc d[NTR]; int total; int pad; };

__device__ __forceinline__ int in_col(int n) {
    if (n < 1792) return n;
    if (n < 3840) return n + 24;
    if (n < 3864) return n - 3840 + 1792;
    return -1;
}

__device__ __forceinline__ void transpose_phase(const TrTable& tt, char* smem, int vb, int nvb) {
    float* tile = (float*)smem;
    const int tid = threadIdx.x;
    for (int it = vb; it < tt.total; it += nvb) {
        int di = 0;
#pragma unroll
        for (int i = 1; i < NTR; ++i) if (it >= tt.d[i].tile0) di = i;
        const TrDesc& d = tt.d[di];
        const int lt = it - d.tile0, tn = lt % d.tiles_n, tk = lt / d.tiles_n, k0 = tk * 64, n0 = tn * 64;
#pragma unroll 4
        for (int i = 0; i < 16; ++i) {
            const int kk = (tid >> 6) + 4 * i, nn = tid & 63;
            int col = n0 + nn; if (d.mode == 1) col = in_col(col);
            float v = 0.f;
            if (col >= 0) v = d.src[(size_t)(k0 + kk) * d.ldsrc + col];
            if (d.kscale) v *= d.kscale[k0 + kk];
            tile[kk * 65 + nn] = v;
        }
        __syncthreads();
#pragma unroll 4
        for (int i = 0; i < 16; ++i) {
            const int nn = (tid >> 6) + 4 * i, kk = tid & 63;
            d.dst[(size_t)(n0 + nn) * d.K + k0 + kk] = f2bf(tile[kk * 65 + nn]);
        }
        __syncthreads();
    }
}

__device__ __forceinline__ void consts_phase(const Ptrs& P, int vb, int nvb) {
    const int gt = vb * 256 + threadIdx.x, ngt = nvb * 256;
    unsigned char* ws = P.ws;
    for (int i = gt; i < 32 * 64; i += ngt) {
        const int g = i >> 6, p = i & 63;
        const double ar = (double)P.in[3][i], ai = (double)P.in[4][i], dt = exp((double)P.in[5][g]);
        const double mag = exp(ar * dt), abr = mag * cos(ai * dt), abi = mag * sin(ai * dt);
        const double den = ar * ar + ai * ai, nr = abr - 1.0;
        const double fr = (nr * ar + abi * ai) / den, fi = (abi * ar - nr * ai) / den;
        float* ABAR = (float*)(ws + O_ABAR); float* AL = (float*)(ws + O_AL);
        ABAR[i * 2] = (float)abr; ABAR[i * 2 + 1] = (float)abi;
        double pr = abr, pi = abi;
        for (int s = 0; s < 7; ++s) { const double nr2 = pr * pr - pi * pi, ni2 = 2.0 * pr * pi; pr = nr2; pi = ni2; }
        AL[i * 2] = (float)pr; AL[i * 2 + 1] = (float)pi;
        bf16_t* BBT = (bf16_t*)(ws + O_BBT);
        for (int c = 0; c < 16; ++c) {
            const double br = (double)P.in[6][(size_t)i * 16 + c], bi = (double)P.in[7][(size_t)i * 16 + c];
            BBT[((size_t)g * 128 + p) * 16 + c] = f2bf((float)(fr * br - fi * bi));
            BBT[((size_t)g * 128 + 64 + p) * 16 + c] = f2bf((float)(fr * bi + fi * br));
        }
        bf16_t* CT = (bf16_t*)(ws + O_CT);
        for (int c = 0; c < 16; ++c) {
            CT[((size_t)g * 16 + c) * 128 + p] = f2bf(P.in[8][((size_t)g * 16 + c) * 64 + p]);
            CT[((size_t)g * 16 + c) * 128 + 64 + p] = f2bf(-P.in[9][((size_t)g * 16 + c) * 64 + p]);
        }
    }
    for (int i = gt; i < 256; i += ngt) {
        const int n = i & 127; const bool isv = i >= 128;
        const float* pe = P.in[isv ? 14 : 13]; const float* w1 = P.in[isv ? 17 : 15];
        float s = 0.f;
        for (int k = 0; k < 2048; ++k) s += pe[k] * w1[(size_t)k * 128 + n];
        ((float*)(ws + (isv ? O_B1V : O_B1K)))[n] = s;
    }
    if (gt < 3) {
        float gq = 0.f, gk = 0.f;
        for (int d = 0; d < 64; ++d) { gq = fmaxf(gq, fabsf(P.in[19][d])); gk = fmaxf(gk, fabsf(P.in[20][gt * 64 + d])); }
        ((float*)(ws + O_M2))[gt] = 64.0f * 0.18033688011112042f * gq * gk;
    }
    float* SSQ = (float*)(ws + O_SSQ);
    for (int i = gt; i < NTOK; i += ngt) SSQ[i] = 0.f;
}

__device__ __forceinline__ void rmsnorm1_phase(const Ptrs& P, int vb, int nvb) {
    const int lane = threadIdx.x & 63, gw = vb * 4 + (threadIdx.x >> 6), ngw = nvb * 4;
    const float* x = P.in[0]; const float* g = P.in[1]; bf16_t* XN = (bf16_t*)(P.ws + O_XN);
    for (int row = gw; row < NTOK; row += ngw) {
        const float4* xr = (const float4*)(x + (size_t)row * DM);
        float4 v[4]; float ss = 0.f;
#pragma unroll
        for (int j = 0; j < 4; ++j) { v[j] = xr[j * 64 + lane]; ss += v[j].x * v[j].x + v[j].y * v[j].y + v[j].z * v[j].z + v[j].w * v[j].w; }
        ss = wave_sum(ss);
        const float rstd = rsqrtf(ss * (1.0f / DM) + EPS);
#pragma unroll
        for (int j = 0; j < 4; ++j) {
            const float4 gg = ((const float4*)g)[j * 64 + lane];
            uint2 o; o.x = pk2(v[j].x * rstd * gg.x, v[j].y * rstd * gg.y); o.y = pk2(v[j].z * rstd * gg.z, v[j].w * rstd * gg.w);
            ((uint2*)(XN + (size_t)row * DM))[j * 64 + lane] = o;
        }
    }
}

struct GemmDesc { const bf16_t* A; const bf16_t* Bt; int lda, ldb, K, pad; };
constexpr int LSTR = 72;
constexpr int GEMM_LDS = 2 * 128 * LSTR * 2;

template <int NP>
__device__ __forceinline__ void gemm_tile(char* smem, const GemmDesc* g, int m0, int n0, f32x4 (&acc)[NP][4][4]) {
    bf16_t* As = (bf16_t*)smem; bf16_t* Bs = As + 128 * LSTR;
    const int tid = threadIdx.x, lane = tid & 63, wave = tid >> 6, wm = wave >> 1, wn = wave & 1, fr = lane & 15, q = lane >> 4;
    const int sc = tid & 7, sr = tid >> 3;
#pragma unroll
    for (int p = 0; p < NP; ++p)
#pragma unroll
        for (int i = 0; i < 4; ++i)
#pragma unroll
            for (int j = 0; j < 4; ++j) acc[p][i][j] = (f32x4){0.f, 0.f, 0.f, 0.f};
#pragma unroll
    for (int p = 0; p < NP; ++p) {
        const bf16_t* Ag = g[p].A + (size_t)m0 * g[p].lda + sc * 8;
        const bf16_t* Bg = g[p].Bt + (size_t)n0 * g[p].ldb + sc * 8;
        const int lda = g[p].lda, ldb = g[p].ldb, nk = g[p].K / 64;
        u32x4 ra[4], rb[4];
#pragma unroll
        for (int i = 0; i < 4; ++i) { ra[i] = *(const u32x4*)(Ag + (size_t)(sr + 32 * i) * lda); rb[i] = *(const u32x4*)(Bg + (size_t)(sr + 32 * i) * ldb); }
        for (int kt = 0; kt < nk; ++kt) {
            __syncthreads();
#pragma unroll
            for (int i = 0; i < 4; ++i) { *(u32x4*)(As + (sr + 32 * i) * LSTR + sc * 8) = ra[i]; *(u32x4*)(Bs + (sr + 32 * i) * LSTR + sc * 8) = rb[i]; }
            __syncthreads();
            if (kt + 1 < nk) {
#pragma unroll
                for (int i = 0; i < 4; ++i) { ra[i] = *(const u32x4*)(Ag + (size_t)(sr + 32 * i) * lda + (kt + 1) * 64); rb[i] = *(const u32x4*)(Bg + (size_t)(sr + 32 * i) * ldb + (kt + 1) * 64); }
            }
#pragma unroll
            for (int ks = 0; ks < 2; ++ks) {
                bf16x8 a[4], b[4];
#pragma unroll
                for (int i = 0; i < 4; ++i) a[i] = *(const bf16x8*)(As + (wm * 64 + 16 * i + fr) * LSTR + ks * 32 + 8 * q);
#pragma unroll
                for (int j = 0; j < 4; ++j) b[j] = *(const bf16x8*)(Bs + (wn * 64 + 16 * j + fr) * LSTR + ks * 32 + 8 * q);
#pragma unroll
                for (int i = 0; i < 4; ++i)
#pragma unroll
                    for (int j = 0; j < 4; ++j) acc[p][i][j] = __builtin_amdgcn_mfma_f32_16x16x32_bf16(b[j], a[i], acc[p][i][j], 0, 0, 0);
            }
        }
    }
    __syncthreads();
}

__device__ __forceinline__ float row_ssq64(const f32x4 (&a)[4]) {
    float s = 0.f;
#pragma unroll
    for (int j = 0; j < 4; ++j) s += a[j][0] * a[j][0] + a[j][1] * a[j][1] + a[j][2] * a[j][2] + a[j][3] * a[j][3];
    s += __shfl_xor(s, 16); s += __shfl_xor(s, 32);
    return s;
}

__device__ __forceinline__ void inproj_phase(const Ptrs& P, char* smem, int vb, int nvb) {
    unsigned char* ws = P.ws;
    GemmDesc g[1] = {{(const bf16_t*)(ws + O_XN), (const bf16_t*)(ws + O_WT_IN), DM, DM, DM, 0}};
    constexpr int TN = NIN / 128, TM = NTOK / 128;
    const int lane = threadIdx.x & 63, wave = threadIdx.x >> 6, wm = wave >> 1, wn = wave & 1, fr = lane & 15, q = lane >> 4;
    for (int t = vb; t < TM * TN; t += nvb) {
        const int tm = t / TN, tn = t % TN, m0 = tm * 128, n0 = tn * 128;
        f32x4 acc[1][4][4];
        gemm_tile<1>(smem, g, m0, n0, acc);
        const int mb = m0 + wm * 64, nb = n0 + wn * 64;
        if (nb < 512) {
            bf16_t* U = (bf16_t*)(ws + O_U);
#pragma unroll
            for (int i = 0; i < 4; ++i)
#pragma unroll
                for (int j = 0; j < 4; ++j) { const f32x4 v = acc[0][i][j]; uint2 o; o.x = pk2(v[0], v[1]); o.y = pk2(v[2], v[3]);
                    *(uint2*)(U + (size_t)(mb + 16 * i + fr) * 512 + nb + 16 * j + 4 * q) = o; }
        } else if (nb < 1024) {
            bf16_t* QN = (bf16_t*)(ws + O_QN); const float* gq = P.in[19];
#pragma unroll
            for (int i = 0; i < 4; ++i) {
                const float rstd = rsqrtf(row_ssq64(acc[0][i]) * (1.0f / 64) + EPS);
#pragma unroll
                for (int j = 0; j < 4; ++j) { const f32x4 v = acc[0][i][j]; const float4 gg = *(const float4*)(gq + 16 * j + 4 * q);
                    const float rs = rstd * 0.18033688011112042f;
                    uint2 o; o.x = pk2(v[0] * rs * gg.x, v[1] * rs * gg.y); o.y = pk2(v[2] * rs * gg.z, v[3] * rs * gg.w);
                    *(uint2*)(QN + (size_t)(mb + 16 * i + fr) * 512 + (nb - 512) + 16 * j + 4 * q) = o; }
            }
        } else if (nb < 1792) {
            const int idx = (nb - 1024) >> 6, br = idx >> 2, isv = (idx >> 1) & 1, gg_ = idx & 1;
            bf16_t* dst = (bf16_t*)(ws + O_KCIN + (size_t)(br * 2 + isv) * 8 * MiB);
            const bool donorm = (br > 0) && !isv; const float* gk = P.in[20] + br * 64;
#pragma unroll
            for (int i = 0; i < 4; ++i) {
                const int m = mb + 16 * i + fr, b = m >> 13, s = m & 8191;
                float rstd = 1.f; if (donorm) rstd = rsqrtf(row_ssq64(acc[0][i]) * (1.0f / 64) + EPS);
#pragma unroll
                for (int j = 0; j < 4; ++j) { f32x4 v = acc[0][i][j];
                    if (donorm) { const float4 gg = *(const float4*)(gk + 16 * j + 4 * q); v[0] *= rstd * gg.x; v[1] *= rstd * gg.y; v[2] *= rstd * gg.z; v[3] *= rstd * gg.w; }
                    uint2 o; o.x = pk2(v[0], v[1]); o.y = pk2(v[2], v[3]);
                    *(uint2*)(dst + ((size_t)(b * 2 + gg_) * SEQ + s) * 64 + 16 * j + 4 * q) = o;
                    if (isv && br > 0) { bf16_t* dT = (bf16_t*)(ws + (br == 1 ? O_VST : O_VWT)) + ((size_t)(b * 2 + gg_) * 64 + 16 * j + 4 * q) * SEQ + s;
                        dT[0] = (bf16_t)(o.x & 0xffff); dT[SEQ] = (bf16_t)(o.x >> 16); dT[2 * SEQ] = (bf16_t)(o.y & 0xffff); dT[3 * SEQ] = (bf16_t)(o.y >> 16); } }
            }
        } else if (nb < 3840) {
            bf16_t* MG = (bf16_t*)(ws + O_MG);
#pragma unroll
            for (int i = 0; i < 4; ++i)
#pragma unroll
                for (int j = 0; j < 4; ++j) { const f32x4 v = acc[0][i][j]; uint2 o; o.x = pk2(sigmoidf_(v[0]), sigmoidf_(v[1])); o.y = pk2(sigmoidf_(v[2]), sigmoidf_(v[3]));
                    *(uint2*)(MG + (size_t)(mb + 16 * i + fr) * 2048 + (nb - 1792) + 16 * j + 4 * q) = o; }
        } else if (nb == 3840) {
            float* G = (float*)(ws + O_GATES);
#pragma unroll
            for (int i = 0; i < 4; ++i)
#pragma unroll
                for (int j = 0; j < 2; ++j) { const int c = 16 * j + 4 * q;
                    if (c < 24) { const f32x4 v = acc[0][i][j]; float4 o = {sigmoidf_(v[0]), sigmoidf_(v[1]), sigmoidf_(v[2]), sigmoidf_(v[3])};
                        *(float4*)(G + (size_t)(mb + 16 * i + fr) * 24 + c) = o; } }
        }
    }
}

__device__ __forceinline__ void compress_phase(const Ptrs& P, char* smem, int vb, int nvb) {
    unsigned char* ws = P.ws;
    const int lane = threadIdx.x & 63, wave = threadIdx.x >> 6, wm = wave >> 1, wn = wave & 1, fr = lane & 15, q = lane >> 4;
    bf16_t* H = (bf16_t*)smem;
    constexpr int HS = 136;
    for (int t = vb; t < 64; t += nvb) {
        const int isv = t >> 5, tm = t & 31, m0 = tm * 128;
        GemmDesc g[1] = {{(const bf16_t*)(ws + (isv ? O_VCIN : O_KCIN)), (const bf16_t*)(ws + (isv ? O_WT_CV1 : O_WT_CK1)), 1024, 2048, 2048, 0}};
        f32x4 acc[1][4][4];
        gemm_tile<1>(smem, g, m0, 0, acc);
        const float* b1 = (const float*)(ws + (isv ? O_B1V : O_B1K));
#pragma unroll
        for (int i = 0; i < 4; ++i)
#pragma unroll
            for (int j = 0; j < 4; ++j) { const f32x4 v = acc[0][i][j]; const int n = wn * 64 + 16 * j + 4 * q; const float4 bb = *(const float4*)(b1 + n);
                uint2 o; o.x = pk2(gelu_tanh(v[0] + bb.x), gelu_tanh(v[1] + bb.y)); o.y = pk2(gelu_tanh(v[2] + bb.z), gelu_tanh(v[3] + bb.w));
                *(uint2*)(H + (wm * 64 + 16 * i + fr) * HS + n) = o; }
        __syncthreads();
        const bf16_t* W2t = (const bf16_t*)(ws + (isv ? O_WT_CV2 : O_WT_CK2));
        f32x4 o2[2][4];
#pragma unroll
        for (int i = 0; i < 2; ++i)
#pragma unroll
            for (int j = 0; j < 4; ++j) o2[i][j] = (f32x4){0.f, 0.f, 0.f, 0.f};
#pragma unroll
        for (int ks = 0; ks < 4; ++ks) {
            bf16x8 a[2], b[4];
#pragma unroll
            for (int i = 0; i < 2; ++i) a[i] = *(const bf16x8*)(H + (wave * 32 + 16 * i + fr) * HS + ks * 32 + 8 * q);
#pragma unroll
            for (int j = 0; j < 4; ++j) b[j] = *(const bf16x8*)(W2t + (size_t)(16 * j + fr) * 128 + ks * 32 + 8 * q);
#pragma unroll
            for (int i = 0; i < 2; ++i)
#pragma unroll
                for (int j = 0; j < 4; ++j) o2[i][j] = __builtin_amdgcn_mfma_f32_16x16x32_bf16(b[j], a[i], o2[i][j], 0, 0, 0);
        }
        bf16_t* dst = (bf16_t*)(ws + (isv ? O_VC : O_KC));
        const float* gk = P.in[20];
#pragma unroll
        for (int i = 0; i < 2; ++i) {
            float rstd = 1.f; if (!isv) rstd = rsqrtf(row_ssq64(o2[i]) * (1.0f / 64) + EPS);
            const int R = m0 + wave * 32 + 16 * i + fr;
#pragma unroll
            for (int j = 0; j < 4; ++j) { f32x4 v = o2[i][j];
                if (!isv) { const float4 gg = *(const float4*)(gk + 16 * j + 4 * q); v[0] *= rstd * gg.x; v[1] *= rstd * gg.y; v[2] *= rstd * gg.z; v[3] *= rstd * gg.w; }
                uint2 o; o.x = pk2(v[0], v[1]); o.y = pk2(v[2], v[3]);
                *(uint2*)(dst + (size_t)R * 64 + 16 * j + 4 * q) = o;
                if (isv) { bf16_t* dT = (bf16_t*)(ws + O_VCT) + ((size_t)(R >> 9) * 64 + 16 * j + 4 * q) * 512 + (R & 511);
                    dT[0] = (bf16_t)(o.x & 0xffff); dT[512] = (bf16_t)(o.x >> 16); dT[1024] = (bf16_t)(o.y & 0xffff); dT[1536] = (bf16_t)(o.y >> 16); } }
        }
        __syncthreads();
    }
}

constexpr int S5_BU_STR = 132, S5_XB_STR = 136;
constexpr int S5_WAVE_LDS = 16 * S5_BU_STR * 4 + 16 * S5_XB_STR * 2;
template <bool ENDS_ONLY>
__device__ __forceinline__ void s5_phase(const Ptrs& P, char* smem, int vb, int nvb) {
    unsigned char* ws = P.ws;
    const int lane = threadIdx.x & 63, wave = threadIdx.x >> 6, fr = lane & 15, q = lane >> 4;
    float* BU = (float*)(smem + wave * S5_WAVE_LDS);
    bf16_t* XB = (bf16_t*)(smem + wave * S5_WAVE_LDS + 16 * S5_BU_STR * 4);
    const bf16_t* U = (const bf16_t*)(ws + O_U);
    const float* ABAR = (const float*)(ws + O_ABAR); const float* AL = (const float*)(ws + O_AL);
    float* ENDS = (float*)(ws + O_ENDS);
    const int gw = vb * 4 + wave, ngw = nvb * 4;
    for (int it = gw; it < NB * NCHUNK * 32; it += ngw) {
        const int g = it & 31, c = (it >> 5) & (NCHUNK - 1), b = it >> 11;
        const float ar = ABAR[(g * 64 + lane) * 2], ai = ABAR[(g * 64 + lane) * 2 + 1];
        bf16x8 bb[8];
#pragma unroll
        for (int nt = 0; nt < 8; ++nt) {
            bb[nt] = (bf16x8){0, 0, 0, 0, 0, 0, 0, 0};
            if (q < 2) bb[nt] = *(const bf16x8*)((const bf16_t*)(ws + O_BBT) + ((size_t)g * 128 + 16 * nt + fr) * 16 + 8 * q);
        }
        bf16x8 ct[4];
        if (!ENDS_ONLY) {
#pragma unroll
            for (int ks = 0; ks < 4; ++ks) ct[ks] = *(const bf16x8*)((const bf16_t*)(ws + O_CT) + ((size_t)g * 16 + fr) * 128 + ks * 32 + 8 * q);
        }
        float xr = 0.f, xi = 0.f;
        if (!ENDS_ONLY) {
            const float alr = AL[(g * 64 + lane) * 2], ali = AL[(g * 64 + lane) * 2 + 1];
            for (int cp = 0; cp < c; ++cp) {
                const float2 e = *(const float2*)(ENDS + (((size_t)(b * NCHUNK + cp) * 32 + g) * 64 + lane) * 2);
                const float nr = alr * xr - ali * xi + e.x, ni = alr * xi + ali * xr + e.y; xr = nr; xi = ni;
            }
        }
        const size_t tok0 = (size_t)b * SEQ + (size_t)c * CHUNK;
        for (int sub = 0; sub < CHUNK / 16; ++sub) {
            const size_t tk = tok0 + sub * 16;
            bf16x8 uf = (bf16x8){0, 0, 0, 0, 0, 0, 0, 0};
            if (q < 2) uf = *(const bf16x8*)(U + (tk + fr) * 512 + g * 16 + 8 * q);
#pragma unroll
            for (int nt = 0; nt < 8; ++nt) {
                f32x4 d = __builtin_amdgcn_mfma_f32_16x16x32_bf16(bb[nt], uf, (f32x4){0.f, 0.f, 0.f, 0.f}, 0, 0, 0);
                *(f32x4*)(BU + fr * S5_BU_STR + 16 * nt + 4 * q) = d;
            }
            asm volatile("s_waitcnt lgkmcnt(0)" ::: "memory");
#pragma unroll 4
            for (int s = 0; s < 16; ++s) {
                const float br = BU[s * S5_BU_STR + lane], bi = BU[s * S5_BU_STR + 64 + lane];
                const float nr = ar * xr - ai * xi + br, ni = ar * xi + ai * xr + bi; xr = nr; xi = ni;
                if (!ENDS_ONLY) { XB[s * S5_XB_STR + lane] = f2bf(xr); XB[s * S5_XB_STR + 64 + lane] = f2bf(xi); }
            }
            asm volatile("s_waitcnt lgkmcnt(0)" ::: "memory");
            if (!ENDS_ONLY) {
                f32x4 y = (f32x4){0.f, 0.f, 0.f, 0.f};
#pragma unroll
                for (int ks = 0; ks < 4; ++ks) {
                    const bf16x8 xf = *(const bf16x8*)(XB + fr * S5_XB_STR + ks * 32 + 8 * q);
                    y = __builtin_amdgcn_mfma_f32_16x16x32_bf16(ct[ks], xf, y, 0, 0, 0);
                }
                const uint2 uu = *(const uint2*)(U + (tk + fr) * 512 + g * 16 + 4 * q);
                const float4 dd = *(const float4*)(P.in[10] + g * 16 + 4 * q);
                const float y0 = gelu_tanh(y[0] + dd.x * bf2f((bf16_t)(uu.x & 0xffff))), y1 = gelu_tanh(y[1] + dd.y * bf2f((bf16_t)(uu.x >> 16)));
                const float y2 = gelu_tanh(y[2] + dd.z * bf2f((bf16_t)(uu.y & 0xffff))), y3 = gelu_tanh(y[3] + dd.w * bf2f((bf16_t)(uu.y >> 16)));
                uint2 o; o.x = pk2(y0, y1); o.y = pk2(y2, y3);
                *(uint2*)((bf16_t*)(ws + O_YG) + (tk + fr) * 512 + g * 16 + 4 * q) = o;
                asm volatile("s_waitcnt lgkmcnt(0)" ::: "memory");
            }
        }
        if (ENDS_ONLY) *(float2*)(ENDS + (((size_t)(b * NCHUNK + c) * 32 + g) * 64 + lane) * 2) = make_float2(xr, xi);
    }
}

constexpr int ATT_LDS = (4 * 64 + 4 * 512 + 128 + 4 * 1024) * 4;
__device__ __forceinline__ float dot64(const float (&qv)[64], const bf16_t* krow) {
    float s = 0.f;
#pragma unroll
    for (int c = 0; c < 8; ++c) {
        const uint4 w = *(const uint4*)(krow + c * 8);
        s += qv[c * 8 + 0] * __uint_as_float(w.x << 16) + qv[c * 8 + 1] * __uint_as_float(w.x & 0xffff0000u);
        s += qv[c * 8 + 2] * __uint_as_float(w.y << 16) + qv[c * 8 + 3] * __uint_as_float(w.y & 0xffff0000u);
        s += qv[c * 8 + 4] * __uint_as_float(w.z << 16) + qv[c * 8 + 5] * __uint_as_float(w.z & 0xffff0000u);
        s += qv[c * 8 + 6] * __uint_as_float(w.w << 16) + qv[c * 8 + 7] * __uint_as_float(w.w & 0xffff0000u);
    }
    return s;
}
__device__ __forceinline__ void attn_ref_phase(const Ptrs& P, char* smem, int vb, int nvb) {
    unsigned char* ws = P.ws;
    const int tid = threadIdx.x, lane = tid & 63, w = tid >> 6;
    float* qs = (float*)smem;
    float* pc = qs + 256;
    float* imp = pc + 2048;
    float* pw = imp + 128;
    int* sel_s = (int*)(pw + 4096);
    const bf16_t* QN = (const bf16_t*)(ws + O_QN);
    const float NEG = -1e30f;
    for (int it = vb; it < NB * 2 * SEQ; it += nvb) {
        const int t = it & (SEQ - 1), g = (it >> 13) & 1, b = it >> 14, bg = b * 2 + g;
        const size_t tok = (size_t)b * SEQ + t;
        const int h = g * 4 + w;
        const float slope = exp2f(-(float)(h + 1));
        __syncthreads();
        qs[w * 64 + lane] = bf2f(QN[tok * 512 + h * 64 + lane]);
        __syncthreads();
        float qv[64];
#pragma unroll
        for (int d = 0; d < 64; ++d) qv[d] = qs[w * 64 + d];
        const int n_vis = (t >= 31) ? ((t - 31) / 16 + 1) : 0;
        const bf16_t* KC = (const bf16_t*)(ws + O_KC) + (size_t)bg * 512 * 64;
        const bf16_t* VC = (const bf16_t*)(ws + O_VC) + (size_t)bg * 512 * 64;
        float sc[8]; float mx = NEG;
#pragma unroll
        for (int i = 0; i < 8; ++i) { const int j = lane + 64 * i; sc[i] = NEG;
            if (j < n_vis) { sc[i] = dot64(qv, KC + (size_t)j * 64) * 0.6931471805599453f - slope * (float)(t - (16 * j + 31)); mx = fmaxf(mx, sc[i]); } }
        mx = wave_max(mx);
        float sum = 0.f;
#pragma unroll
        for (int i = 0; i < 8; ++i) { const int j = lane + 64 * i; sc[i] = (j < n_vis) ? __expf(sc[i] - mx) : 0.f; sum += sc[i]; }
        sum = wave_sum(sum);
        const float inv = (n_vis > 0) ? 1.0f / sum : 0.f;
#pragma unroll
        for (int i = 0; i < 8; ++i) pc[w * 512 + lane + 64 * i] = sc[i] * inv;
        __syncthreads();
        float o_cmp = 0.f;
        for (int j = 0; j < n_vis; ++j) o_cmp += pc[w * 512 + j] * bf2f(VC[(size_t)j * 64 + lane]);
        const int cur = t >> 6;
        if (tid < 128) {
            const int blk = tid; float v = 0.f;
#pragma unroll
            for (int hh = 0; hh < 4; ++hh) { v += pc[hh * 512 + 4 * blk] + pc[hh * 512 + 4 * blk + 1] + pc[hh * 512 + 4 * blk + 2] + pc[hh * 512 + 4 * blk + 3]; if (blk > 0) v += pc[hh * 512 + 4 * blk - 1]; }
            const bool valid = blk <= cur, forced = (blk == 0) || (blk == cur) || (blk == cur - 1);
            imp[blk] = valid ? (v + (forced ? 1e4f : 0.f)) : NEG;
        }
        __syncthreads();
        float v0 = imp[lane], v1 = imp[lane + 64];
        int sel[16];
#pragma unroll
        for (int r = 0; r < 16; ++r) {
            float bv; int bi;
            if (v0 >= v1) { bv = v0; bi = lane; } else { bv = v1; bi = lane + 64; }
#pragma unroll
            for (int o = 1; o < 64; o <<= 1) { const float ov = __shfl_xor(bv, o); const int oi = __shfl_xor(bi, o); if (ov > bv || (ov == bv && oi < bi)) { bv = ov; bi = oi; } }
            sel[r] = bi; if (lane == 0) sel_s[w * 16 + r] = bi;
            if (bi == lane) v0 = -3e38f; if (bi == lane + 64) v1 = -3e38f;
        }
        const bf16_t* KS = (const bf16_t*)(ws + O_KS) + (size_t)bg * SEQ * 64;
        const bf16_t* VS = (const bf16_t*)(ws + O_VS) + (size_t)bg * SEQ * 64;
        float ss[16]; mx = NEG;
#pragma unroll
        for (int r = 0; r < 16; ++r) { const int pos = sel[r] * 64 + lane; ss[r] = NEG;
            if (pos <= t) { ss[r] = dot64(qv, KS + (size_t)pos * 64) * 0.6931471805599453f - slope * (float)(t - pos); mx = fmaxf(mx, ss[r]); } }
        mx = wave_max(mx); sum = 0.f;
#pragma unroll
        for (int r = 0; r < 16; ++r) { const int pos = sel[r] * 64 + lane; ss[r] = (pos <= t) ? __expf(ss[r] - mx) : 0.f; sum += ss[r]; }
        sum = wave_sum(sum);
        { const float iv = 1.0f / sum;
#pragma unroll
          for (int r = 0; r < 16; ++r) pw[w * 1024 + r * 64 + lane] = ss[r] * iv; }
        __syncthreads();
        float o_slc = 0.f;
#pragma unroll 1
        for (int r = 0; r < 16; ++r) { const int blk = sel_s[w * 16 + r]; if (blk > cur) continue; const bf16_t* vb_ = VS + (size_t)blk * 64 * 64 + lane;
            for (int kk = 0; kk < 64; ++kk) o_slc += pw[w * 1024 + r * 64 + kk] * bf2f(vb_[(size_t)kk * 64]); }
        __syncthreads();
        const bf16_t* KW = (const bf16_t*)(ws + O_KW) + (size_t)bg * SEQ * 64;
        const bf16_t* VW = (const bf16_t*)(ws + O_VW) + (size_t)bg * SEQ * 64;
        float sw[8]; mx = NEG;
#pragma unroll
        for (int i = 0; i < 8; ++i) { const int pos = t - 511 + lane + 64 * i; sw[i] = NEG;
            if (pos >= 0) { sw[i] = dot64(qv, KW + (size_t)pos * 64) * 0.6931471805599453f - slope * (float)(t - pos); mx = fmaxf(mx, sw[i]); } }
        mx = wave_max(mx); sum = 0.f;
#pragma unroll
        for (int i = 0; i < 8; ++i) { const int pos = t - 511 + lane + 64 * i; sw[i] = (pos >= 0) ? __expf(sw[i] - mx) : 0.f; sum += sw[i]; }
        sum = wave_sum(sum);
        { const float iv = 1.0f / sum;
#pragma unroll
          for (int i = 0; i < 8; ++i) pw[w * 1024 + lane + 64 * i] = sw[i] * iv; }
        __syncthreads();
        float o_win = 0.f;
        { const int i0 = (t >= 511) ? 0 : (511 - t);
          for (int i = i0; i < 512; ++i) o_win += pw[w * 1024 + i] * bf2f(VW[(size_t)(t - 511 + i) * 64 + lane]); }
        const float* G = (const float*)(ws + O_GATES) + tok * 24;
        const float y = G[h] * o_cmp + G[8 + h] * o_slc + G[16 + h] * o_win;
        ((bf16_t*)(ws + O_YNSA))[tok * 512 + h * 64 + lane] = f2bf(y);
    }
}

constexpr int KSTR = 72;
constexpr int KV_TILE = 64 * KSTR * 2;
constexpr int IMP_STR = 132;
template <int NW> struct AttL {
    static constexpr int K0 = 0, V0 = 2 * KV_TILE, IMP = 4 * KV_TILE, SELM = IMP + NW * 16 * IMP_STR * 4, UNI = SELM + NW * 16 * 16, TOTAL = UNI + 64;
};
struct AttSrc { const bf16_t* k; const bf16_t* v; int vld; };

template <int NW>
__device__ __forceinline__ void att_load(const AttSrc& s, bool withv, u32x4 (&kr)[8 / NW], u32x4 (&vr)[8 / NW]) {
    const int tid = threadIdx.x;
#pragma unroll
    for (int i = 0; i < 8 / NW; ++i) {
        const int e = tid + i * NW * 64, row = e >> 3, ch = e & 7;
        kr[i] = *(const u32x4*)(s.k + (size_t)row * 64 + ch * 8);
        if (withv) vr[i] = *(const u32x4*)(s.v + (size_t)row * s.vld + ch * 8);
    }
}
template <int NW>
__device__ __forceinline__ void att_store(char* smem, int buf, bool withv, const u32x4 (&kr)[8 / NW], const u32x4 (&vr)[8 / NW]) {
    const int tid = threadIdx.x;
    bf16_t* Ks = (bf16_t*)(smem + AttL<NW>::K0 + buf * KV_TILE); bf16_t* Vs = (bf16_t*)(smem + AttL<NW>::V0 + buf * KV_TILE);
#pragma unroll
    for (int i = 0; i < 8 / NW; ++i) {
        const int e = tid + i * NW * 64, row = e >> 3, ch = e & 7;
        *(u32x4*)(Ks + row * KSTR + ch * 8) = kr[i];
        if (withv) *(u32x4*)(Vs + row * KSTR + ch * 8) = vr[i];
    }
}

template <int MODE>
__device__ __forceinline__ void att_block(const bf16_t* Ks, const bf16_t* Vs, const bf16x8 (&qf)[4][2], f32x4 (&acc)[4][4], float (&l)[4],
                                          const float (&invl)[4], const float (&g0)[4], const float (&base0)[4], const int (&hi0)[4], int wlo, bool need_mask,
                                          unsigned rtmask, float slope2, float kstep, float* imp_w, int blk0, int fr, int q) {
    const float NEGB = -1e30f;
#pragma unroll
    for (int kt = 0; kt < 2; ++kt) {
        bf16x8 kf[2][2];
#pragma unroll
        for (int ab = 0; ab < 2; ++ab)
#pragma unroll
            for (int ks = 0; ks < 2; ++ks) kf[ab][ks] = *(const bf16x8*)(Ks + (32 * kt + 16 * ab + fr) * KSTR + 32 * ks + 8 * q);
        bf16x8 vf[4];
        if (MODE != 0) {
#pragma unroll
            for (int dt = 0; dt < 4; ++dt) {
                typedef unsigned u32x2 __attribute__((ext_vector_type(2)));
                const u32x2 lo = *(const u32x2*)(Vs + (16 * dt + fr) * KSTR + 32 * kt + 4 * q), hi = *(const u32x2*)(Vs + (16 * dt + fr) * KSTR + 32 * kt + 16 + 4 * q);
                const u32x4 vv = {lo[0], lo[1], hi[0], hi[1]};
                vf[dt] = __builtin_bit_cast(bf16x8, vv);
            }
        }
#pragma unroll
        for (int rt = 0; rt < 4; ++rt) {
            if (!((rtmask >> rt) & 1u)) continue;
            const float bl = base0[rt] + slope2 * kstep * (float)(32 * kt + 4 * q);
            f32x4 S[2];
#pragma unroll
            for (int ab = 0; ab < 2; ++ab) {
#pragma unroll
                for (int r = 0; r < 4; ++r) S[ab][r] = bl + slope2 * kstep * (float)(16 * ab + r);
                S[ab] = __builtin_amdgcn_mfma_f32_16x16x32_bf16(kf[ab][0], qf[rt][0], S[ab], 0, 0, 0);
                S[ab] = __builtin_amdgcn_mfma_f32_16x16x32_bf16(kf[ab][1], qf[rt][1], S[ab], 0, 0, 0);
            }
            if (need_mask) {
                const int hi = hi0[rt] - (32 * kt + 4 * q), lo = hi - wlo;
#pragma unroll
                for (int ab = 0; ab < 2; ++ab)
#pragma unroll
                    for (int r = 0; r < 4; ++r) { const int c = 16 * ab + r; if (c > hi || c < lo) S[ab][r] = NEGB; }
            }
            float ps = 0.f;
#pragma unroll
            for (int ab = 0; ab < 2; ++ab)
#pragma unroll
                for (int r = 0; r < 4; ++r) { S[ab][r] = __builtin_amdgcn_exp2f(S[ab][r]); ps += S[ab][r]; }
            if (MODE == 0) { l[rt] += ps; continue; }
            if (MODE == 2) l[rt] += ps;
            if (MODE == 1) {
                const float il = invl[rt];
#pragma unroll
                for (int ab = 0; ab < 2; ++ab) {
                    S[ab] = S[ab] * il;
                    float cs = (S[ab][0] + S[ab][1]) + (S[ab][2] + S[ab][3]), last = S[ab][3];
                    cs += __shfl_xor(cs, 1); cs += __shfl_xor(cs, 2); last += __shfl_xor(last, 1); last += __shfl_xor(last, 2);
                    const int blk = blk0 + 8 * kt + 4 * ab + q;
                    if ((fr & 3) == 0) { float* ip = imp_w + (4 * rt + (fr >> 2)) * IMP_STR + blk; atomicAdd(ip, cs); if (blk + 1 < 128) atomicAdd(ip + 1, last); }
                    S[ab] = S[ab] * g0[rt];
                }
            }
            const u32x4 pu = {pk2(S[0][0], S[0][1]), pk2(S[0][2], S[0][3]), pk2(S[1][0], S[1][1]), pk2(S[1][2], S[1][3])};
            const bf16x8 pf = __builtin_bit_cast(bf16x8, pu);
#pragma unroll
            for (int dt = 0; dt < 4; ++dt) acc[rt][dt] = __builtin_amdgcn_mfma_f32_16x16x32_bf16(vf[dt], pf, acc[rt][dt], 0, 0, 0);
        }
    }
}

template <int NW>
__device__ __forceinline__ void attn_mfma_phase(const Ptrs& P, char* smem, int vb, int nvb) {
    typedef AttL<NW> L;
    unsigned char* ws = P.ws;
    const int tid = threadIdx.x, lane = tid & 63, wave = __builtin_amdgcn_readfirstlane(tid >> 6), fr = lane & 15, q = lane >> 4;
    constexpr int TQ = 16 * NW, NQT = SEQ / TQ, NCH = 8 / NW;
    float* imp_w = (float*)(smem + L::IMP) + wave * 16 * IMP_STR;
    unsigned* selm_w = (unsigned*)(smem + L::SELM) + wave * 64;
    unsigned* uni = (unsigned*)(smem + L::UNI);
    const float* M2 = (const float*)(ws + O_M2);
    const float LOG2E = 1.4426950408889634f;
    for (int it = vb; it < NB * 2 * NQT; it += nvb) {
        const int qt = NQT - 1 - (it / (NB * 2)), bg = it % (NB * 2), b = bg >> 1, g = bg & 1;
        const int qs = qt * TQ, t0 = qs + 16 * wave;
        const int head = fr & 3, h = g * 4 + head;
        const float slope2 = exp2f(-(float)(h + 1)) * LOG2E;
        const bf16_t* QN = (const bf16_t*)(ws + O_QN);
        bf16x8 qf[4][2]; int tpos[4];
#pragma unroll
        for (int rt = 0; rt < 4; ++rt) {
            tpos[rt] = t0 + 4 * rt + (fr >> 2);
            const size_t tok = (size_t)b * SEQ + tpos[rt];
#pragma unroll
            for (int ks = 0; ks < 2; ++ks) qf[rt][ks] = *(const bf16x8*)(QN + tok * 512 + h * 64 + 32 * ks + 8 * q);
        }
        for (int i = lane; i < 16 * IMP_STR; i += 64) imp_w[i] = 0.f;
        if (tid < 4) uni[tid] = 0u;
        f32x4 Y[4][4], O[4][4];
#pragma unroll
        for (int rt = 0; rt < 4; ++rt)
#pragma unroll
            for (int dt = 0; dt < 4; ++dt) { Y[rt][dt] = (f32x4){0.f, 0.f, 0.f, 0.f}; O[rt][dt] = (f32x4){0.f, 0.f, 0.f, 0.f}; }
        float l[4] = {0.f, 0.f, 0.f, 0.f}, invl[4] = {0.f, 0.f, 0.f, 0.f}, g0[4], base0[4]; int hi0[4];
        const float* G = (const float*)(ws + O_GATES);
#pragma unroll
        for (int rt = 0; rt < 4; ++rt) g0[rt] = G[((size_t)b * SEQ + tpos[rt]) * 24 + h];
        u32x4 kr[NCH], vr[NCH];
        __syncthreads();
        {
            const int jm_tile = (qs + TQ - 1 - 31) >> 4;
            const int nkb = (jm_tile >> 6) + 1;
            const int jm_lo = (t0 - 31) >> 4, jm_hi = (t0 + 15 - 31) >> 4;
            const float m2 = M2[0];
            const bf16_t* KC = (const bf16_t*)(ws + O_KC) + (size_t)bg * 512 * 64;
            const bf16_t* VCT = (const bf16_t*)(ws + O_VCT) + (size_t)bg * 64 * 512;
            int jmax[4];
#pragma unroll
            for (int rt = 0; rt < 4; ++rt) jmax[rt] = (tpos[rt] - 31) >> 4;
#pragma unroll 1
            for (int pass = 0; pass < 2; ++pass) {
                { AttSrc s0{KC, VCT, 512}; att_load<NW>(s0, true, kr, vr); att_store<NW>(smem, 0, true, kr, vr); }
                __syncthreads();
#pragma unroll 1
                for (int kb = 0; kb < nkb; ++kb) {
                    if (kb + 1 < nkb) { AttSrc s1{KC + (size_t)(kb + 1) * 64 * 64, VCT + (kb + 1) * 64, 512}; att_load<NW>(s1, true, kr, vr); }
                    if (64 * kb <= jm_hi) {
                        const bool need_mask = (64 * kb + 63 > jm_lo);
#pragma unroll
                        for (int rt = 0; rt < 4; ++rt) { base0[rt] = -m2 - slope2 * (float)(tpos[rt] - 31 - 1024 * kb); hi0[rt] = jmax[rt] - 64 * kb; }
                        const bf16_t* Ks = (const bf16_t*)(smem + L::K0 + (kb & 1) * KV_TILE); const bf16_t* Vs = (const bf16_t*)(smem + L::V0 + (kb & 1) * KV_TILE);
                        if (pass == 0) att_block<0>(Ks, Vs, qf, Y, l, invl, g0, base0, hi0, 1 << 28, need_mask, 0xFu, slope2, 16.f, imp_w, 16 * kb, fr, q);
                        else att_block<1>(Ks, Vs, qf, Y, l, invl, g0, base0, hi0, 1 << 28, need_mask, 0xFu, slope2, 16.f, imp_w, 16 * kb, fr, q);
                    }
                    if (kb + 1 < nkb) att_store<NW>(smem, (kb + 1) & 1, true, kr, vr);
                    __syncthreads();
                }
                if (pass == 0) {
#pragma unroll
                    for (int rt = 0; rt < 4; ++rt) { float s = l[rt]; s += __shfl_xor(s, 16); s += __shfl_xor(s, 32); invl[rt] = s > 0.f ? 1.0f / s : 0.f; l[rt] = 0.f; }
                }
            }
        }
        {
            asm volatile("s_waitcnt lgkmcnt(0)" ::: "memory");
            const int tl = lane >> 2, part = lane & 3, t = t0 + tl, cur = t >> 6;
            float* my = imp_w + tl * IMP_STR + 32 * part;
#pragma unroll 4
            for (int i = 0; i < 32; ++i) { const int blk = 32 * part + i; const float v = my[i];
                const bool valid = blk <= cur, forced = (blk == 0) || (blk == cur) || (blk == cur - 1);
                my[i] = valid ? (v + (forced ? 1e4f : 0.f)) : -1e30f; }
            asm volatile("s_waitcnt lgkmcnt(0)" ::: "memory");
            unsigned m0 = 0u, m1 = 0u, m2_ = 0u, m3 = 0u;
#pragma unroll 1
            for (int r = 0; r < 16; ++r) {
                float bv = -3.4e38f; int bi = 0;
#pragma unroll
                for (int i4 = 0; i4 < 8; ++i4) { const f32x4 v = *(const f32x4*)(my + 4 * i4);
#pragma unroll
                    for (int c = 0; c < 4; ++c) if (v[c] > bv) { bv = v[c]; bi = 32 * part + 4 * i4 + c; } }
#pragma unroll
                for (int o = 1; o < 4; o <<= 1) { const float ov = __shfl_xor(bv, o); const int oi = __shfl_xor(bi, o); if (ov > bv || (ov == bv && oi < bi)) { bv = ov; bi = oi; } }
                if ((bi >> 5) == part) imp_w[tl * IMP_STR + bi] = -3.0e38f;
                const unsigned bit = 1u << (bi & 31); const int wd = bi >> 5;
                m0 |= (wd == 0) ? bit : 0u; m1 |= (wd == 1) ? bit : 0u; m2_ |= (wd == 2) ? bit : 0u; m3 |= (wd == 3) ? bit : 0u;
                asm volatile("s_waitcnt lgkmcnt(0)" ::: "memory");
            }
            if (part == 0) { selm_w[tl * 4 + 0] = m0; selm_w[tl * 4 + 1] = m1; selm_w[tl * 4 + 2] = m2_; selm_w[tl * 4 + 3] = m3; }
#pragma unroll
            for (int o = 4; o < 64; o <<= 1) { m0 |= __shfl_xor(m0, o); m1 |= __shfl_xor(m1, o); m2_ |= __shfl_xor(m2_, o); m3 |= __shfl_xor(m3, o); }
            if (lane == 0) { atomicOr(uni + 0, m0); atomicOr(uni + 1, m1); atomicOr(uni + 2, m2_); atomicOr(uni + 3, m3); }
            __syncthreads();
            unsigned wu[4] = {(unsigned)__builtin_amdgcn_readfirstlane(m0), (unsigned)__builtin_amdgcn_readfirstlane(m1), (unsigned)__builtin_amdgcn_readfirstlane(m2_), (unsigned)__builtin_amdgcn_readfirstlane(m3)};
            unsigned bu[4] = {(unsigned)__builtin_amdgcn_readfirstlane(uni[0]), (unsigned)__builtin_amdgcn_readfirstlane(uni[1]), (unsigned)__builtin_amdgcn_readfirstlane(uni[2]), (unsigned)__builtin_amdgcn_readfirstlane(uni[3])};
            const float m2s = M2[1];
            const bf16_t* KS = (const bf16_t*)(ws + O_KS) + (size_t)bg * SEQ * 64;
            const bf16_t* VST = (const bf16_t*)(ws + O_VST) + (size_t)bg * 64 * SEQ;
            int nsel = __popc(bu[0]) + __popc(bu[1]) + __popc(bu[2]) + __popc(bu[3]);
            int cw = 0; unsigned cbits = bu[0];
#define NEXT_BLK(dst) do { while (cbits == 0u) { ++cw; cbits = (cw == 1) ? bu[1] : (cw == 2) ? bu[2] : bu[3]; } const int bpos_ = __ffs(cbits) - 1; cbits &= cbits - 1u; dst = cw * 32 + bpos_; } while (0)
            int blk_cur = 0, blk_nxt = 0;
            if (nsel > 0) {
                NEXT_BLK(blk_cur);
                { AttSrc s0{KS + (size_t)blk_cur * 64 * 64, VST + blk_cur * 64, SEQ}; att_load<NW>(s0, true, kr, vr); att_store<NW>(smem, 0, true, kr, vr); }
                __syncthreads();
#pragma unroll 1
                for (int i = 0; i < nsel; ++i) {
                    if (i + 1 < nsel) { NEXT_BLK(blk_nxt); AttSrc s1{KS + (size_t)blk_nxt * 64 * 64, VST + blk_nxt * 64, SEQ}; att_load<NW>(s1, true, kr, vr); }
                    const int blk = blk_cur, kb0 = 64 * blk;
                    const unsigned wword = (blk < 32) ? wu[0] : (blk < 64) ? wu[1] : (blk < 96) ? wu[2] : wu[3];
                    if (((wword >> (blk & 31)) & 1u) && kb0 <= t0 + 15) {
                        const bool need_mask = (kb0 + 63 > t0);
                        unsigned rtmask = 0u;
#pragma unroll
                        for (int rt = 0; rt < 4; ++rt) {
                            const unsigned w_ = selm_w[(4 * rt + (fr >> 2)) * 4 + (blk >> 5)];
                            const bool sel = (w_ >> (blk & 31)) & 1u;
                            base0[rt] = sel ? (-m2s - slope2 * (float)(tpos[rt] - kb0)) : -1e30f;
                            hi0[rt] = tpos[rt] - kb0;
                            if (__ballot(sel) != 0ull) rtmask |= 1u << rt;
                        }
                        rtmask = __builtin_amdgcn_readfirstlane(rtmask);
                        const bf16_t* Ks = (const bf16_t*)(smem + L::K0 + (i & 1) * KV_TILE); const bf16_t* Vs = (const bf16_t*)(smem + L::V0 + (i & 1) * KV_TILE);
                        att_block<2>(Ks, Vs, qf, O, l, invl, g0, base0, hi0, 1 << 28, need_mask, rtmask, slope2, 1.f, imp_w, 0, fr, q);
                    }
                    if (i + 1 < nsel) att_store<NW>(smem, (i + 1) & 1, true, kr, vr);
                    blk_cur = blk_nxt;
                    __syncthreads();
                }
            }
#pragma unroll
            for (int rt = 0; rt < 4; ++rt) {
                float s = l[rt]; s += __shfl_xor(s, 16); s += __shfl_xor(s, 32);
                const float cf = (s > 0.f) ? G[((size_t)b * SEQ + tpos[rt]) * 24 + 8 + h] / s : 0.f; l[rt] = 0.f;
#pragma unroll
                for (int dt = 0; dt < 4; ++dt) { Y[rt][dt] = Y[rt][dt] + O[rt][dt] * cf; O[rt][dt] = (f32x4){0.f, 0.f, 0.f, 0.f}; }
            }
        }
        {
            const float m2w = M2[2];
            const bf16_t* KW = (const bf16_t*)(ws + O_KW) + (size_t)bg * SEQ * 64;
            const bf16_t* VWT = (const bf16_t*)(ws + O_VWT) + (size_t)bg * 64 * SEQ;
            const int wlast = (qs + TQ - 1) >> 6; int wfirst = (qs - 511) >> 6; if (wfirst < 0) wfirst = 0;
            const int nwb = wlast - wfirst + 1;
            { AttSrc s0{KW + (size_t)wfirst * 64 * 64, VWT + wfirst * 64, SEQ}; att_load<NW>(s0, true, kr, vr); att_store<NW>(smem, 0, true, kr, vr); }
            __syncthreads();
#pragma unroll 1
            for (int i = 0; i < nwb; ++i) {
                const int wb = wfirst + i, kb0 = 64 * wb;
                if (i + 1 < nwb) { AttSrc s1{KW + (size_t)(wb + 1) * 64 * 64, VWT + (wb + 1) * 64, SEQ}; att_load<NW>(s1, true, kr, vr); }
                if (kb0 <= t0 + 15 && kb0 + 63 >= t0 - 511) {
                    const bool need_mask = !(kb0 + 63 <= t0 && kb0 >= t0 + 15 - 511);
#pragma unroll
                    for (int rt = 0; rt < 4; ++rt) { base0[rt] = -m2w - slope2 * (float)(tpos[rt] - kb0); hi0[rt] = tpos[rt] - kb0; }
                    const bf16_t* Ks = (const bf16_t*)(smem + L::K0 + (i & 1) * KV_TILE); const bf16_t* Vs = (const bf16_t*)(smem + L::V0 + (i & 1) * KV_TILE);
                    att_block<2>(Ks, Vs, qf, O, l, invl, g0, base0, hi0, 511, need_mask, 0xFu, slope2, 1.f, imp_w, 0, fr, q);
                }
                if (i + 1 < nwb) att_store<NW>(smem, (i + 1) & 1, true, kr, vr);
                __syncthreads();
            }
        }
        bf16_t* YN = (bf16_t*)(ws + O_YNSA);
#pragma unroll
        for (int rt = 0; rt < 4; ++rt) {
            float s = l[rt]; s += __shfl_xor(s, 16); s += __shfl_xor(s, 32);
            const size_t tok = (size_t)b * SEQ + tpos[rt];
            const float cf = (s > 0.f) ? G[tok * 24 + 16 + h] / s : 0.f;
#pragma unroll
            for (int dt = 0; dt < 4; ++dt) { const f32x4 y = Y[rt][dt] + O[rt][dt] * cf; uint2 o; o.x = pk2(y[0], y[1]); o.y = pk2(y[2], y[3]);
                *(uint2*)(YN + tok * 512 + h * 64 + 16 * dt + 4 * q) = o; }
        }
        __syncthreads();
    }
}

__device__ __forceinline__ void glu_phase(const Ptrs& P, char* smem, int vb, int nvb) {
    unsigned char* ws = P.ws;
    GemmDesc g[1] = {{(const bf16_t*)(ws + O_YG), (const bf16_t*)(ws + O_WT_GLU), 512, 512, 512, 0}};
    const int lane = threadIdx.x & 63, wave = threadIdx.x >> 6, wm = wave >> 1, wn = wave & 1, fr = lane & 15, q = lane >> 4;
    const bf16_t* YG = (const bf16_t*)(ws + O_YG); bf16_t* YS = (bf16_t*)(ws + O_YSSM); const float* bg = P.in[12];
    for (int t = vb; t < (NTOK / 128) * 4; t += nvb) {
        const int tm = t >> 2, tn = t & 3, m0 = tm * 128, n0 = tn * 128;
        f32x4 acc[1][4][4];
        gemm_tile<1>(smem, g, m0, n0, acc);
        const int mb = m0 + wm * 64, nb = n0 + wn * 64;
#pragma unroll
        for (int i = 0; i < 4; ++i)
#pragma unroll
            for (int j = 0; j < 4; ++j) { const f32x4 v = acc[0][i][j]; const size_t off = (size_t)(mb + 16 * i + fr) * 512 + nb + 16 * j + 4 * q;
                const uint2 yy = *(const uint2*)(YG + off); const float4 bb = *(const float4*)(bg + nb + 16 * j + 4 * q);
                uint2 o; o.x = pk2(bf2f((bf16_t)(yy.x & 0xffff)) * sigmoidf_(v[0] + bb.x), bf2f((bf16_t)(yy.x >> 16)) * sigmoidf_(v[1] + bb.y));
                o.y = pk2(bf2f((bf16_t)(yy.y & 0xffff)) * sigmoidf_(v[2] + bb.z), bf2f((bf16_t)(yy.y >> 16)) * sigmoidf_(v[3] + bb.w));
                *(uint2*)(YS + off) = o; }
    }
}

__device__ __forceinline__ void merge_phase(const Ptrs& P, char* smem, int vb, int nvb) {
    unsigned char* ws = P.ws;
    GemmDesc g[2] = {{(const bf16_t*)(ws + O_YSSM), (const bf16_t*)(ws + O_WT_PS), 512, 512, 512, 0}, {(const bf16_t*)(ws + O_YNSA), (const bf16_t*)(ws + O_WT_PN), 512, 512, 512, 0}};
    const int lane = threadIdx.x & 63, wave = threadIdx.x >> 6, wm = wave >> 1, wn = wave & 1, fr = lane & 15, q = lane >> 4;
    const bf16_t* MG = (const bf16_t*)(ws + O_MG); bf16_t* ME = (bf16_t*)(ws + O_MERGED);
    for (int t = vb; t < (NTOK / 128) * 8; t += nvb) {
        const int tm = t >> 3, tn = t & 7, m0 = tm * 128, n0 = tn * 128;
        f32x4 acc[2][4][4];
        gemm_tile<2>(smem, g, m0, n0, acc);
        const int mb = m0 + wm * 64, nb = n0 + wn * 64;
#pragma unroll
        for (int i = 0; i < 4; ++i)
#pragma unroll
            for (int j = 0; j < 4; ++j) { const f32x4 a = acc[0][i][j], c = acc[1][i][j]; const int m = mb + 16 * i + fr, n = nb + 16 * j + 4 * q;
                const uint2 g0 = *(const uint2*)(MG + (size_t)m * 2048 + n), g1 = *(const uint2*)(MG + (size_t)m * 2048 + 1024 + n);
                uint2 o;
                o.x = pk2(bf2f((bf16_t)(g0.x & 0xffff)) * a[0] + bf2f((bf16_t)(g1.x & 0xffff)) * c[0], bf2f((bf16_t)(g0.x >> 16)) * a[1] + bf2f((bf16_t)(g1.x >> 16)) * c[1]);
                o.y = pk2(bf2f((bf16_t)(g0.y & 0xffff)) * a[2] + bf2f((bf16_t)(g1.y & 0xffff)) * c[2], bf2f((bf16_t)(g0.y >> 16)) * a[3] + bf2f((bf16_t)(g1.y >> 16)) * c[3]);
                *(uint2*)(ME + (size_t)m * 1024 + n) = o; }
    }
}

__device__ __forceinline__ void outproj_phase(const Ptrs& P, char* smem, int vb, int nvb) {
    unsigned char* ws = P.ws;
    GemmDesc g[1] = {{(const bf16_t*)(ws + O_MERGED), (const bf16_t*)(ws + O_WT_OUT), 1024, 1024, 1024, 0}};
    const int lane = threadIdx.x & 63, wave = threadIdx.x >> 6, wm = wave >> 1, wn = wave & 1, fr = lane & 15, q = lane >> 4;
    const float* x = P.in[0]; float* out = P.out; bf16_t* X1B = (bf16_t*)(ws + O_X1B); float* SSQ = (float*)(ws + O_SSQ);
    for (int t = vb; t < (NTOK / 128) * 8; t += nvb) {
        const int tm = t >> 3, tn = t & 7, m0 = tm * 128, n0 = tn * 128;
        f32x4 acc[1][4][4];
        gemm_tile<1>(smem, g, m0, n0, acc);
        const int mb = m0 + wm * 64, nb = n0 + wn * 64;
#pragma unroll
        for (int i = 0; i < 4; ++i) {
            const int m = mb + 16 * i + fr; f32x4 r[4];
#pragma unroll
            for (int j = 0; j < 4; ++j) { const size_t off = (size_t)m * 1024 + nb + 16 * j + 4 * q; const float4 xv = *(const float4*)(x + off);
                f32x4 v = acc[0][i][j]; v[0] += xv.x; v[1] += xv.y; v[2] += xv.z; v[3] += xv.w; r[j] = v;
                *(float4*)(out + off) = make_float4(v[0], v[1], v[2], v[3]);
                uint2 o; o.x = pk2(v[0], v[1]); o.y = pk2(v[2], v[3]); *(uint2*)(X1B + off) = o; }
            const float s = row_ssq64(r);
            if (q == 0) atomicAdd(SSQ + m, s);
        }
    }
}

__device__ __forceinline__ void up_phase(const Ptrs& P, char* smem, int vb, int nvb) {
    unsigned char* ws = P.ws;
    GemmDesc g[1] = {{(const bf16_t*)(ws + O_X1B), (const bf16_t*)(ws + O_WT_UP), 1024, 1024, 1024, 0}};
    const int lane = threadIdx.x & 63, wave = threadIdx.x >> 6, wm = wave >> 1, wn = wave & 1, fr = lane & 15, q = lane >> 4;
    bf16_t* FF = (bf16_t*)(ws + O_FF); const float* SSQ = (const float*)(ws + O_SSQ);
    for (int t = vb; t < (NTOK / 128) * 32; t += nvb) {
        const int tm = t >> 5, tn = t & 31, m0 = tm * 128, n0 = tn * 128;
        f32x4 acc[1][4][4];
        gemm_tile<1>(smem, g, m0, n0, acc);
        const int mb = m0 + wm * 64, nb = n0 + wn * 64;
#pragma unroll
        for (int i = 0; i < 4; ++i) {
            const int m = mb + 16 * i + fr; const float rstd = rsqrtf(SSQ[m] * (1.0f / DM) + EPS);
#pragma unroll
            for (int j = 0; j < 4; ++j) { f32x4 v = acc[0][i][j];
#pragma unroll
                for (int r = 0; r < 4; ++r) { const float a = fmaxf(v[r], 0.f) * rstd; v[r] = a * a; }
                uint2 o; o.x = pk2(v[0], v[1]); o.y = pk2(v[2], v[3]);
                *(uint2*)(FF + (size_t)m * DFF + nb + 16 * j + 4 * q) = o; }
        }
    }
}

__device__ __forceinline__ void down_phase(const Ptrs& P, char* smem, int vb, int nvb) {
    unsigned char* ws = P.ws;
    GemmDesc g[1] = {{(const bf16_t*)(ws + O_FF), (const bf16_t*)(ws + O_WT_DOWN), DFF, DFF, DFF, 0}};
    const int lane = threadIdx.x & 63, wave = threadIdx.x >> 6, wm = wave >> 1, wn = wave & 1, fr = lane & 15, q = lane >> 4;
    float* out = P.out;
    for (int t = vb; t < (NTOK / 128) * 8; t += nvb) {
        const int tm = t >> 3, tn = t & 7, m0 = tm * 128, n0 = tn * 128;
        f32x4 acc[1][4][4];
        gemm_tile<1>(smem, g, m0, n0, acc);
        const int mb = m0 + wm * 64, nb = n0 + wn * 64;
#pragma unroll
        for (int i = 0; i < 4; ++i)
#pragma unroll
            for (int j = 0; j < 4; ++j) { const size_t off = (size_t)(mb + 16 * i + fr) * 1024 + nb + 16 * j + 4 * q; const float4 xv = *(const float4*)(out + off);
                const f32x4 v = acc[0][i][j]; *(float4*)(out + off) = make_float4(v[0] + xv.x, v[1] + xv.y, v[2] + xv.z, v[3] + xv.w); }
    }
}

constexpr int SMEM_BYTES = 72 * 1024;
static_assert(AttL<4>::TOTAL <= SMEM_BYTES, "attention LDS");
#ifndef ATTN_REF
#define ATTN_REF 0
#endif
#define KDEF(name, call) __global__ void __launch_bounds__(256) name(Ptrs P, TrTable tt) { extern __shared__ __attribute__((aligned(16))) char smem[]; (void)tt; call; }
KDEF(k_transpose, transpose_phase(tt, smem, blockIdx.x, gridDim.x))
KDEF(k_consts, consts_phase(P, blockIdx.x, gridDim.x))
KDEF(k_rms1, rmsnorm1_phase(P, blockIdx.x, gridDim.x))
KDEF(k_inproj, inproj_phase(P, smem, blockIdx.x, gridDim.x))
KDEF(k_compress, compress_phase(P, smem, blockIdx.x, gridDim.x))
KDEF(k_s5ends, s5_phase<true>(P, smem, blockIdx.x, gridDim.x))
KDEF(k_s5main, s5_phase<false>(P, smem, blockIdx.x, gridDim.x))
#if ATTN_REF
KDEF(k_attn, attn_ref_phase(P, smem, blockIdx.x, gridDim.x))
#else
KDEF(k_attn, attn_mfma_phase<4>(P, smem, blockIdx.x, gridDim.x))
#endif
KDEF(k_glu, glu_phase(P, smem, blockIdx.x, gridDim.x))
KDEF(k_merge, merge_phase(P, smem, blockIdx.x, gridDim.x))
KDEF(k_outproj, outproj_phase(P, smem, blockIdx.x, gridDim.x))
KDEF(k_up, up_phase(P, smem, blockIdx.x, gridDim.x))
KDEF(k_down, down_phase(P, smem, blockIdx.x, gridDim.x))


__global__ void __launch_bounds__(256) k_mega(Ptrs P, TrTable tt) {
    extern __shared__ __attribute__((aligned(16))) char smem[];
    cg::grid_group grid = cg::this_grid();
    const int vb = blockIdx.x, nvb = gridDim.x;
    transpose_phase(tt, smem, vb, nvb);
    consts_phase(P, vb, nvb);
    rmsnorm1_phase(P, vb, nvb);
    grid.sync();
    inproj_phase(P, smem, vb, nvb);
    grid.sync();
    compress_phase(P, smem, vb, nvb);
    s5_phase<true>(P, smem, nvb - 1 - vb, nvb);
    grid.sync();
#if ATTN_REF
    attn_ref_phase(P, smem, vb, nvb);
#else
    attn_mfma_phase<4>(P, smem, vb, nvb);
#endif
    s5_phase<false>(P, smem, vb, nvb);
    grid.sync();
    glu_phase(P, smem, vb, nvb);
    grid.sync();
    merge_phase(P, smem, vb, nvb);
    grid.sync();
    outproj_phase(P, smem, vb, nvb);
    grid.sync();
    up_phase(P, smem, vb, nvb);
    grid.sync();
    down_phase(P, smem, vb, nvb);
}

static void add_tr(TrTable& tt, int& n, const float* src, bf16_t* dst, const float* kscale, int K, int N, int ldsrc, int mode) {
    TrDesc& d = tt.d[n]; d.src = src; d.dst = dst; d.kscale = kscale; d.K = K; d.N = N; d.ldsrc = ldsrc; d.mode = mode; d.tiles_n = N / 64; d.tile0 = tt.total;
    tt.total += (K / 64) * (N / 64); ++n;
}

extern "C" void kernel_launch(void* const* d_in, const int* in_sizes, int n_in, void* d_out, int out_size, void* d_ws, size_t ws_size, hipStream_t stream) {
    if (n_in != 27 || ws_size < WS_END) { fprintf(stderr, "kernel_launch: unexpected n_in %d or ws_size %zu (need %zu)\n", n_in, ws_size, (size_t)WS_END); return; }
    Ptrs P{};
    for (int i = 0; i < 27; ++i) P.in[i] = (const float*)d_in[i];
    P.out = (float*)d_out; P.ws = (unsigned char*)d_ws;
    unsigned char* ws = P.ws;
    TrTable tt{}; int n = 0;
    add_tr(tt, n, P.in[2], (bf16_t*)(ws + O_WT_IN), nullptr, 1024, NIN, 3864, 1);
    add_tr(tt, n, P.in[11], (bf16_t*)(ws + O_WT_GLU), nullptr, 512, 512, 512, 0);
    add_tr(tt, n, P.in[21], (bf16_t*)(ws + O_WT_PS), nullptr, 512, 1024, 1024, 0);
    add_tr(tt, n, P.in[22], (bf16_t*)(ws + O_WT_PN), nullptr, 512, 1024, 1024, 0);
    add_tr(tt, n, P.in[23], (bf16_t*)(ws + O_WT_OUT), nullptr, 1024, 1024, 1024, 0);
    add_tr(tt, n, P.in[25], (bf16_t*)(ws + O_WT_UP), P.in[24], 1024, 4096, 4096, 0);
    add_tr(tt, n, P.in[26], (bf16_t*)(ws + O_WT_DOWN), nullptr, 4096, 1024, 1024, 0);
    add_tr(tt, n, P.in[15], (bf16_t*)(ws + O_WT_CK1), nullptr, 2048, 128, 128, 0);
    add_tr(tt, n, P.in[17], (bf16_t*)(ws + O_WT_CV1), nullptr, 2048, 128, 128, 0);
    add_tr(tt, n, P.in[16], (bf16_t*)(ws + O_WT_CK2), nullptr, 128, 64, 64, 0);
    add_tr(tt, n, P.in[18], (bf16_t*)(ws + O_WT_CV2), nullptr, 128, 64, 64, 0);
#if MULTI_LAUNCH
    const int G = 1024;
#define LAUNCH(k, grid) hipLaunchKernelGGL(k, dim3(grid), dim3(256), SMEM_BYTES, stream, P, tt)
    LAUNCH(k_transpose, G);
    LAUNCH(k_consts, 64);
    LAUNCH(k_rms1, G);
    LAUNCH(k_inproj, G);
    LAUNCH(k_compress, 64);
    LAUNCH(k_s5ends, G);
    LAUNCH(k_attn, 2048);
    LAUNCH(k_s5main, G);
    LAUNCH(k_glu, G);
    LAUNCH(k_merge, G);
    LAUNCH(k_outproj, G);
    LAUNCH(k_up, G);
    LAUNCH(k_down, G);
#else
    static int grid_blocks = 0;
    if (!grid_blocks) {
        int dev = 0, cus = 0, per_cu = 0;
        (void)hipGetDevice(&dev);
        (void)hipDeviceGetAttribute(&cus, hipDeviceAttributeMultiprocessorCount, dev);
        (void)hipFuncSetAttribute((const void*)k_mega, hipFuncAttributeMaxDynamicSharedMemorySize, SMEM_BYTES);
        (void)hipOccupancyMaxActiveBlocksPerMultiprocessor(&per_cu, k_mega, 256, SMEM_BYTES);
        if (per_cu < 1) { fprintf(stderr, "kernel_launch: occupancy query returned %d\n", per_cu); per_cu = 1; }
        if (per_cu > 2) per_cu = 2;
        grid_blocks = cus * per_cu;
    }
    void* args[] = {(void*)&P, (void*)&tt};
    hipError_t e = hipLaunchCooperativeKernel((void*)k_mega, dim3(grid_blocks), dim3(256), args, SMEM_BYTES, stream);
    if (e != hipSuccess) fprintf(stderr, "cooperative launch failed: %s (grid %d)\n", hipGetErrorString(e), grid_blocks);
#endif
}
```

```cpp
#include <hip/hip_runtime.h>
#include <hip/hip_cooperative_groups.h>
namespace cg = cooperative_groups;
#ifndef MULTI_LAUNCH
#define MULTI_LAUNCH 0
#endif
#include <cstdio>
#include <cstdint>

typedef unsigned short bf16_t;
typedef short bf16x8 __attribute__((ext_vector_type(8)));
typedef float f32x4 __attribute__((ext_vector_type(4)));
typedef unsigned u32x4 __attribute__((ext_vector_type(4)));

constexpr int NB = 4, SEQ = 8192, DM = 1024, NTOK = NB * SEQ;
constexpr int NIN = 3968;
constexpr int DFF = 4096;
constexpr int CHUNK = 128, NCHUNK = SEQ / CHUNK;
constexpr float EPS = 1e-6f;

constexpr size_t MiB = 1024 * 1024;
constexpr size_t al256(size_t x) { return (x + 255) & ~(size_t)255; }
constexpr size_t O_WT_IN = 0;
constexpr size_t O_WT_GLU = O_WT_IN + (size_t)NIN * 1024 * 2;
constexpr size_t O_WT_PS = O_WT_GLU + 512 * 512 * 2;
constexpr size_t O_WT_PN = O_WT_PS + 1024 * 512 * 2;
constexpr size_t O_WT_OUT = O_WT_PN + 1024 * 512 * 2;
constexpr size_t O_WT_UP = O_WT_OUT + 1024 * 1024 * 2;
constexpr size_t O_WT_DOWN = O_WT_UP + (size_t)4096 * 1024 * 2;
constexpr size_t O_WT_CK1 = O_WT_DOWN + (size_t)4096 * 1024 * 2;
constexpr size_t O_WT_CV1 = O_WT_CK1 + 128 * 2048 * 2;
constexpr size_t O_WT_CK2 = O_WT_CV1 + 128 * 2048 * 2;
constexpr size_t O_WT_CV2 = O_WT_CK2 + 64 * 128 * 2;
constexpr size_t O_B1K = O_WT_CV2 + 64 * 128 * 2;
constexpr size_t O_B1V = O_B1K + 512;
constexpr size_t O_ABAR = O_B1V + 512;
constexpr size_t O_AL = O_ABAR + 32 * 64 * 2 * 4;
constexpr size_t O_BBT = O_AL + 32 * 64 * 2 * 4;
constexpr size_t O_CT = O_BBT + 32 * 128 * 16 * 2;
constexpr size_t O_ENDS = O_CT + 32 * 16 * 128 * 2;
constexpr size_t O_SSQ = O_ENDS + (size_t)NB * NCHUNK * 32 * 64 * 2 * 4;
constexpr size_t O_GATES = O_SSQ + (size_t)NTOK * 4;
constexpr size_t O_KC = O_GATES + (size_t)NTOK * 24 * 4;
constexpr size_t O_VC = O_KC + 8 * 512 * 64 * 2;
constexpr size_t O_VCT = O_VC + 8 * 512 * 64 * 2;
constexpr size_t O_M2 = O_VCT + 8 * 512 * 64 * 2;
constexpr size_t O_REGA = al256(O_M2 + 4096);
constexpr size_t O_XN = O_REGA;
constexpr size_t O_YSSM = O_XN;
constexpr size_t O_YNSA = O_XN + 32 * MiB;
constexpr size_t O_U = O_XN + 64 * MiB;
constexpr size_t O_QN = O_U + 32 * MiB;
constexpr size_t O_KCIN = O_QN + 32 * MiB;
constexpr size_t O_VCIN = O_KCIN + 8 * MiB;
constexpr size_t O_KS = O_VCIN + 8 * MiB;
constexpr size_t O_VS = O_KS + 8 * MiB;
constexpr size_t O_KW = O_VS + 8 * MiB;
constexpr size_t O_VW = O_KW + 8 * MiB;
constexpr size_t O_YG = O_VW + 8 * MiB;
constexpr size_t O_VST = O_YG + 32 * MiB;
constexpr size_t O_VWT = O_VST + 8 * MiB;
constexpr size_t O_FF = O_REGA;
constexpr size_t O_REGB = O_REGA + 256 * MiB;
constexpr size_t O_MG = O_REGB;
constexpr size_t O_X1B = O_REGB;
constexpr size_t O_MERGED = O_REGB + 128 * MiB;
constexpr size_t WS_END = O_MERGED + 64 * MiB;
static_assert(O_VWT + 8 * MiB <= O_REGB, "region A overflow");

__device__ __forceinline__ float bf2f(bf16_t h) { return __uint_as_float(((unsigned)h) << 16); }
__device__ __forceinline__ bf16_t f2bf(float f) { unsigned u = __float_as_uint(f); u += 0x7fffu + ((u >> 16) & 1u); return (bf16_t)(u >> 16); }
typedef __bf16 bf16x2_t __attribute__((ext_vector_type(2)));
typedef float f32x2_t __attribute__((ext_vector_type(2)));
__device__ __forceinline__ unsigned pk2(float lo, float hi) { const f32x2_t f = {lo, hi}; const bf16x2_t v = __builtin_convertvector(f, bf16x2_t); return __builtin_bit_cast(unsigned, v); }
__device__ __forceinline__ float sigmoidf_(float x) { return 1.0f / (1.0f + __expf(-x)); }
__device__ __forceinline__ float gelu_tanh(float x) { const float u = 0.7978845608028654f * (x + 0.044715f * x * x * x); return 0.5f * x * (1.0f + tanhf(u)); }
__device__ __forceinline__ float wave_sum(float v) {
#pragma unroll
    for (int o = 1; o < 64; o <<= 1) v += __shfl_xor(v, o);
    return v;
}
__device__ __forceinline__ float wave_max(float v) {
#pragma unroll
    for (int o = 1; o < 64; o <<= 1) v = fmaxf(v, __shfl_xor(v, o));
    return v;
}

struct Ptrs {
    const float* in[27];
    float* out;
    unsigned char* ws;
};

struct TrDesc { const float* src; bf16_t* dst; const float* kscale; int K, N, ldsrc, mode, tiles_n, tile0; };
constexpr int NTR = 11;
struct TrTable { TrDesc d[NTR]; int total; int pad; };

__device__ __forceinline__ int in_col(int n) {
    if (n < 1792) return n;
    if (n < 3840) return n + 24;
    if (n < 3864) return n - 3840 + 1792;
    return -1;
}

__device__ __forceinline__ void transpose_phase(const TrTable& tt, char* smem, int vb, int nvb) {
    float* tile = (float*)smem;
    const int tid = threadIdx.x;
    for (int it = vb; it < tt.total; it += nvb) {
        int di = 0;
#pragma unroll
        for (int i = 1; i < NTR; ++i) if (it >= tt.d[i].tile0) di = i;
        const TrDesc& d = tt.d[di];
        const int lt = it - d.tile0, tn = lt % d.tiles_n, tk = lt / d.tiles_n, k0 = tk * 64, n0 = tn * 64;
#pragma unroll 4
        for (int i = 0; i < 16; ++i) {
            const int kk = (tid >> 6) + 4 * i, nn = tid & 63;
            int col = n0 + nn; if (d.mode == 1) col = in_col(col);
            float v = 0.f;
            if (col >= 0) v = d.src[(size_t)(k0 + kk) * d.ldsrc + col];
            if (d.kscale) v *= d.kscale[k0 + kk];
            tile[kk * 65 + nn] = v;
        }
        __syncthreads();
#pragma unroll 4
        for (int i = 0; i < 16; ++i) {
            const int nn = (tid >> 6) + 4 * i, kk = tid & 63;
            d.dst[(size_t)(n0 + nn) * d.K + k0 + kk] = f2bf(tile[kk * 65 + nn]);
        }
        __syncthreads();
    }
}

__device__ __forceinline__ void consts_phase(const Ptrs& P, int vb, int nvb) {
    const int gt = vb * 256 + threadIdx.x, ngt = nvb * 256;
    unsigned char* ws = P.ws;
    for (int i = gt; i < 32 * 64; i += ngt) {
        const int g = i >> 6, p = i & 63;
        const double ar = (double)P.in[3][i], ai = (double)P.in[4][i], dt = exp((double)P.in[5][g]);
        const double mag = exp(ar * dt), abr = mag * cos(ai * dt), abi = mag * sin(ai * dt);
        const double den = ar * ar + ai * ai, nr = abr - 1.0;
        const double fr = (nr * ar + abi * ai) / den, fi = (abi * ar - nr * ai) / den;
        float* ABAR = (float*)(ws + O_ABAR); float* AL = (float*)(ws + O_AL);
        ABAR[i * 2] = (float)abr; ABAR[i * 2 + 1] = (float)abi;
        double pr = abr, pi = abi;
        for (int s = 0; s < 7; ++s) { const double nr2 = pr * pr - pi * pi, ni2 = 2.0 * pr * pi; pr = nr2; pi = ni2; }
        AL[i * 2] = (float)pr; AL[i * 2 + 1] = (float)pi;
        bf16_t* BBT = (bf16_t*)(ws + O_BBT);
        for (int c = 0; c < 16; ++c) {
            const double br = (double)P.in[6][(size_t)i * 16 + c], bi = (double)P.in[7][(size_t)i * 16 + c];
            BBT[((size_t)g * 128 + p) * 16 + c] = f2bf((float)(fr * br - fi * bi));
            BBT[((size_t)g * 128 + 64 + p) * 16 + c] = f2bf((float)(fr * bi + fi * br));
        }
        bf16_t* CT = (bf16_t*)(ws + O_CT);
        for (int c = 0; c < 16; ++c) {
            CT[((size_t)g * 16 + c) * 128 + p] = f2bf(P.in[8][((size_t)g * 16 + c) * 64 + p]);
            CT[((size_t)g * 16 + c) * 128 + 64 + p] = f2bf(-P.in[9][((size_t)g * 16 + c) * 64 + p]);
        }
    }
    for (int i = gt; i < 256; i += ngt) {
        const int n = i & 127; const bool isv = i >= 128;
        const float* pe = P.in[isv ? 14 : 13]; const float* w1 = P.in[isv ? 17 : 15];
        float s = 0.f;
        for (int k = 0; k < 2048; ++k) s += pe[k] * w1[(size_t)k * 128 + n];
        ((float*)(ws + (isv ? O_B1V : O_B1K)))[n] = s;
    }
    if (gt < 3) {
        float gq = 0.f, gk = 0.f;
        for (int d = 0; d < 64; ++d) { gq = fmaxf(gq, fabsf(P.in[19][d])); gk = fmaxf(gk, fabsf(P.in[20][gt * 64 + d])); }
        ((float*)(ws + O_M2))[gt] = 64.0f * 0.18033688011112042f * gq * gk;
    }
    if (gt == 5) *(unsigned*)(ws + O_M2 + 64) = 0u;
    float* SSQ = (float*)(ws + O_SSQ);
    for (int i = gt; i < NTOK; i += ngt) SSQ[i] = 0.f;
}

__device__ __forceinline__ void rmsnorm1_phase(const Ptrs& P, int vb, int nvb) {
    const int lane = threadIdx.x & 63, gw = vb * 4 + (threadIdx.x >> 6), ngw = nvb * 4;
    const float* x = P.in[0]; const float* g = P.in[1]; bf16_t* XN = (bf16_t*)(P.ws + O_XN);
    for (int row = gw; row < NTOK; row += ngw) {
        const float4* xr = (const float4*)(x + (size_t)row * DM);
        float4 v[4]; float ss = 0.f;
#pragma unroll
        for (int j = 0; j < 4; ++j) { v[j] = xr[j * 64 + lane]; ss += v[j].x * v[j].x + v[j].y * v[j].y + v[j].z * v[j].z + v[j].w * v[j].w; }
        ss = wave_sum(ss);
        const float rstd = rsqrtf(ss * (1.0f / DM) + EPS);
#pragma unroll
        for (int j = 0; j < 4; ++j) {
            const float4 gg = ((const float4*)g)[j * 64 + lane];
            uint2 o; o.x = pk2(v[j].x * rstd * gg.x, v[j].y * rstd * gg.y); o.y = pk2(v[j].z * rstd * gg.z, v[j].w * rstd * gg.w);
            ((uint2*)(XN + (size_t)row * DM))[j * 64 + lane] = o;
        }
    }
}

struct GemmDesc { const bf16_t* A; const bf16_t* Bt; int lda, ldb, K, pad; };
constexpr int LSTR = 72;
constexpr int GEMM_LDS = 2 * 128 * LSTR * 2;

template <int NP>
__device__ __forceinline__ void gemm_tile(char* smem, const GemmDesc* g, int m0, int n0, f32x4 (&acc)[NP][4][4]) {
    bf16_t* As = (bf16_t*)smem; bf16_t* Bs = As + 128 * LSTR;
    const int tid = threadIdx.x, lane = tid & 63, wave = tid >> 6, wm = wave >> 1, wn = wave & 1, fr = lane & 15, q = lane >> 4;
    const int sc = tid & 7, sr = tid >> 3;
#pragma unroll
    for (int p = 0; p < NP; ++p)
#pragma unroll
        for (int i = 0; i < 4; ++i)
#pragma unroll
            for (int j = 0; j < 4; ++j) acc[p][i][j] = (f32x4){0.f, 0.f, 0.f, 0.f};
#pragma unroll
    for (int p = 0; p < NP; ++p) {
        const bf16_t* Ag = g[p].A + (size_t)m0 * g[p].lda + sc * 8;
        const bf16_t* Bg = g[p].Bt + (size_t)n0 * g[p].ldb + sc * 8;
        const int lda = g[p].lda, ldb = g[p].ldb, nk = g[p].K / 64;
        u32x4 ra[4], rb[4];
#pragma unroll
        for (int i = 0; i < 4; ++i) { ra[i] = *(const u32x4*)(Ag + (size_t)(sr + 32 * i) * lda); rb[i] = *(const u32x4*)(Bg + (size_t)(sr + 32 * i) * ldb); }
        for (int kt = 0; kt < nk; ++kt) {
            __syncthreads();
#pragma unroll
            for (int i = 0; i < 4; ++i) { *(u32x4*)(As + (sr + 32 * i) * LSTR + sc * 8) = ra[i]; *(u32x4*)(Bs + (sr + 32 * i) * LSTR + sc * 8) = rb[i]; }
            __syncthreads();
            if (kt + 1 < nk) {
#pragma unroll
                for (int i = 0; i < 4; ++i) { ra[i] = *(const u32x4*)(Ag + (size_t)(sr + 32 * i) * lda + (kt + 1) * 64); rb[i] = *(const u32x4*)(Bg + (size_t)(sr + 32 * i) * ldb + (kt + 1) * 64); }
            }
#pragma unroll
            for (int ks = 0; ks < 2; ++ks) {
                bf16x8 a[4], b[4];
#pragma unroll
                for (int i = 0; i < 4; ++i) a[i] = *(const bf16x8*)(As + (wm * 64 + 16 * i + fr) * LSTR + ks * 32 + 8 * q);
#pragma unroll
                for (int j = 0; j < 4; ++j) b[j] = *(const bf16x8*)(Bs + (wn * 64 + 16 * j + fr) * LSTR + ks * 32 + 8 * q);
#pragma unroll
                for (int i = 0; i < 4; ++i)
#pragma unroll
                    for (int j = 0; j < 4; ++j) acc[p][i][j] = __builtin_amdgcn_mfma_f32_16x16x32_bf16(b[j], a[i], acc[p][i][j], 0, 0, 0);
            }
        }
    }
    __syncthreads();
}

__device__ __forceinline__ float row_ssq64(const f32x4 (&a)[4]) {
    float s = 0.f;
#pragma unroll
    for (int j = 0; j < 4; ++j) s += a[j][0] * a[j][0] + a[j][1] * a[j][1] + a[j][2] * a[j][2] + a[j][3] * a[j][3];
    s += __shfl_xor(s, 16); s += __shfl_xor(s, 32);
    return s;
}

__device__ __forceinline__ void inproj_phase(const Ptrs& P, char* smem, int vb, int nvb) {
    unsigned char* ws = P.ws;
    GemmDesc g[1] = {{(const bf16_t*)(ws + O_XN), (const bf16_t*)(ws + O_WT_IN), DM, DM, DM, 0}};
    constexpr int TN = NIN / 128, TM = NTOK / 128;
    const int lane = threadIdx.x & 63, wave = threadIdx.x >> 6, wm = wave >> 1, wn = wave & 1, fr = lane & 15, q = lane >> 4;
    for (int t = vb; t < TM * TN; t += nvb) {
        const int tm = t / TN, tn = t % TN, m0 = tm * 128, n0 = tn * 128;
        f32x4 acc[1][4][4];
        gemm_tile<1>(smem, g, m0, n0, acc);
        const int mb = m0 + wm * 64, nb = n0 + wn * 64;
        if (nb < 512) {
            bf16_t* U = (bf16_t*)(ws + O_U);
#pragma unroll
            for (int i = 0; i < 4; ++i)
#pragma unroll
                for (int j = 0; j < 4; ++j) { const f32x4 v = acc[0][i][j]; uint2 o; o.x = pk2(v[0], v[1]); o.y = pk2(v[2], v[3]);
                    *(uint2*)(U + (size_t)(mb + 16 * i + fr) * 512 + nb + 16 * j + 4 * q) = o; }
        } else if (nb < 1024) {
            bf16_t* QN = (bf16_t*)(ws + O_QN); const float* gq = P.in[19];
#pragma unroll
            for (int i = 0; i < 4; ++i) {
                const float rstd = rsqrtf(row_ssq64(acc[0][i]) * (1.0f / 64) + EPS);
#pragma unroll
                for (int j = 0; j < 4; ++j) { const f32x4 v = acc[0][i][j]; const float4 gg = *(const float4*)(gq + 16 * j + 4 * q);
                    const float rs = rstd * 0.18033688011112042f;
                    uint2 o; o.x = pk2(v[0] * rs * gg.x, v[1] * rs * gg.y); o.y = pk2(v[2] * rs * gg.z, v[3] * rs * gg.w);
                    *(uint2*)(QN + (size_t)(mb + 16 * i + fr) * 512 + (nb - 512) + 16 * j + 4 * q) = o; }
            }
        } else if (nb < 1792) {
            const int idx = (nb - 1024) >> 6, br = idx >> 2, isv = (idx >> 1) & 1, gg_ = idx & 1;
            bf16_t* dst = (bf16_t*)(ws + O_KCIN + (size_t)(br * 2 + isv) * 8 * MiB);
            const bool donorm = (br > 0) && !isv; const float* gk = P.in[20] + br * 64;
#pragma unroll
            for (int i = 0; i < 4; ++i) {
                const int m = mb + 16 * i + fr, b = m >> 13, s = m & 8191;
                float rstd = 1.f; if (donorm) rstd = rsqrtf(row_ssq64(acc[0][i]) * (1.0f / 64) + EPS);
#pragma unroll
                for (int j = 0; j < 4; ++j) { f32x4 v = acc[0][i][j];
                    if (donorm) { const float4 gg = *(const float4*)(gk + 16 * j + 4 * q); v[0] *= rstd * gg.x; v[1] *= rstd * gg.y; v[2] *= rstd * gg.z; v[3] *= rstd * gg.w; }
                    uint2 o; o.x = pk2(v[0], v[1]); o.y = pk2(v[2], v[3]);
                    *(uint2*)(dst + ((size_t)(b * 2 + gg_) * SEQ + s) * 64 + 16 * j + 4 * q) = o;
                    if (isv && br > 0) { bf16_t* dT = (bf16_t*)(ws + (br == 1 ? O_VST : O_VWT)) + ((size_t)(b * 2 + gg_) * 64 + 16 * j + 4 * q) * SEQ + s;
                        dT[0] = (bf16_t)(o.x & 0xffff); dT[SEQ] = (bf16_t)(o.x >> 16); dT[2 * SEQ] = (bf16_t)(o.y & 0xffff); dT[3 * SEQ] = (bf16_t)(o.y >> 16); } }
            }
        } else if (nb < 3840) {
            bf16_t* MG = (bf16_t*)(ws + O_MG);
#pragma unroll
            for (int i = 0; i < 4; ++i)
#pragma unroll
                for (int j = 0; j < 4; ++j) { const f32x4 v = acc[0][i][j]; uint2 o; o.x = pk2(sigmoidf_(v[0]), sigmoidf_(v[1])); o.y = pk2(sigmoidf_(v[2]), sigmoidf_(v[3]));
                    *(uint2*)(MG + (size_t)(mb + 16 * i + fr) * 2048 + (nb - 1792) + 16 * j + 4 * q) = o; }
        } else if (nb == 3840) {
            float* G = (float*)(ws + O_GATES);
#pragma unroll
            for (int i = 0; i < 4; ++i)
#pragma unroll
                for (int j = 0; j < 2; ++j) { const int c = 16 * j + 4 * q;
                    if (c < 24) { const f32x4 v = acc[0][i][j]; float4 o = {sigmoidf_(v[0]), sigmoidf_(v[1]), sigmoidf_(v[2]), sigmoidf_(v[3])};
                        *(float4*)(G + (size_t)(mb + 16 * i + fr) * 24 + c) = o; } }
        }
    }
}

__device__ __forceinline__ void compress_phase(const Ptrs& P, char* smem, int vb, int nvb) {
    unsigned char* ws = P.ws;
    const int lane = threadIdx.x & 63, wave = threadIdx.x >> 6, wm = wave >> 1, wn = wave & 1, fr = lane & 15, q = lane >> 4;
    bf16_t* H = (bf16_t*)smem;
    constexpr int HS = 136;
    for (int t = vb; t < 64; t += nvb) {
        const int isv = t >> 5, tm = t & 31, m0 = tm * 128;
        GemmDesc g[1] = {{(const bf16_t*)(ws + (isv ? O_VCIN : O_KCIN)), (const bf16_t*)(ws + (isv ? O_WT_CV1 : O_WT_CK1)), 1024, 2048, 2048, 0}};
        f32x4 acc[1][4][4];
        gemm_tile<1>(smem, g, m0, 0, acc);
        const float* b1 = (const float*)(ws + (isv ? O_B1V : O_B1K));
#pragma unroll
        for (int i = 0; i < 4; ++i)
#pragma unroll
            for (int j = 0; j < 4; ++j) { const f32x4 v = acc[0][i][j]; const int n = wn * 64 + 16 * j + 4 * q; const float4 bb = *(const float4*)(b1 + n);
                uint2 o; o.x = pk2(gelu_tanh(v[0] + bb.x), gelu_tanh(v[1] + bb.y)); o.y = pk2(gelu_tanh(v[2] + bb.z), gelu_tanh(v[3] + bb.w));
                *(uint2*)(H + (wm * 64 + 16 * i + fr) * HS + n) = o; }
        __syncthreads();
        const bf16_t* W2t = (const bf16_t*)(ws + (isv ? O_WT_CV2 : O_WT_CK2));
        f32x4 o2[2][4];
#pragma unroll
        for (int i = 0; i < 2; ++i)
#pragma unroll
            for (int j = 0; j < 4; ++j) o2[i][j] = (f32x4){0.f, 0.f, 0.f, 0.f};
#pragma unroll
        for (int ks = 0; ks < 4; ++ks) {
            bf16x8 a[2], b[4];
#pragma unroll
            for (int i = 0; i < 2; ++i) a[i] = *(const bf16x8*)(H + (wave * 32 + 16 * i + fr) * HS + ks * 32 + 8 * q);
#pragma unroll
            for (int j = 0; j < 4; ++j) b[j] = *(const bf16x8*)(W2t + (size_t)(16 * j + fr) * 128 + ks * 32 + 8 * q);
#pragma unroll
            for (int i = 0; i < 2; ++i)
#pragma unroll
                for (int j = 0; j < 4; ++j) o2[i][j] = __builtin_amdgcn_mfma_f32_16x16x32_bf16(b[j], a[i], o2[i][j], 0, 0, 0);
        }
        bf16_t* dst = (bf16_t*)(ws + (isv ? O_VC : O_KC));
        const float* gk = P.in[20];
#pragma unroll
        for (int i = 0; i < 2; ++i) {
            float rstd = 1.f; if (!isv) rstd = rsqrtf(row_ssq64(o2[i]) * (1.0f / 64) + EPS);
            const int R = m0 + wave * 32 + 16 * i + fr;
#pragma unroll
            for (int j = 0; j < 4; ++j) { f32x4 v = o2[i][j];
                if (!isv) { const float4 gg = *(const float4*)(gk + 16 * j + 4 * q); v[0] *= rstd * gg.x; v[1] *= rstd * gg.y; v[2] *= rstd * gg.z; v[3] *= rstd * gg.w; }
                uint2 o; o.x = pk2(v[0], v[1]); o.y = pk2(v[2], v[3]);
                *(uint2*)(dst + (size_t)R * 64 + 16 * j + 4 * q) = o;
                if (isv) { bf16_t* dT = (bf16_t*)(ws + O_VCT) + ((size_t)(R >> 9) * 64 + 16 * j + 4 * q) * 512 + (R & 511);
                    dT[0] = (bf16_t)(o.x & 0xffff); dT[512] = (bf16_t)(o.x >> 16); dT[1024] = (bf16_t)(o.y & 0xffff); dT[1536] = (bf16_t)(o.y >> 16); } }
        }
        __syncthreads();
    }
}

constexpr int S5_BU_STR = 132, S5_XB_STR = 136;
constexpr int S5_WAVE_LDS = 16 * S5_BU_STR * 4 + 16 * S5_XB_STR * 2;
template <bool ENDS_ONLY>
__device__ __forceinline__ void s5_phase(const Ptrs& P, char* smem, int vb, int nvb) {
    unsigned char* ws = P.ws;
    const int lane = threadIdx.x & 63, wave = threadIdx.x >> 6, fr = lane & 15, q = lane >> 4;
    float* BU = (float*)(smem + wave * S5_WAVE_LDS);
    bf16_t* XB = (bf16_t*)(smem + wave * S5_WAVE_LDS + 16 * S5_BU_STR * 4);
    const bf16_t* U = (const bf16_t*)(ws + O_U);
    const float* ABAR = (const float*)(ws + O_ABAR); const float* AL = (const float*)(ws + O_AL);
    float* ENDS = (float*)(ws + O_ENDS);
    const int gw = vb * 4 + wave, ngw = nvb * 4;
    for (int it = gw; it < NB * NCHUNK * 32; it += ngw) {
        const int g = it & 31, c = (it >> 5) & (NCHUNK - 1), b = it >> 11;
        const float ar = ABAR[(g * 64 + lane) * 2], ai = ABAR[(g * 64 + lane) * 2 + 1];
        bf16x8 bb[8];
#pragma unroll
        for (int nt = 0; nt < 8; ++nt) {
            bb[nt] = (bf16x8){0, 0, 0, 0, 0, 0, 0, 0};
            if (q < 2) bb[nt] = *(const bf16x8*)((const bf16_t*)(ws + O_BBT) + ((size_t)g * 128 + 16 * nt + fr) * 16 + 8 * q);
        }
        bf16x8 ct[4];
        if (!ENDS_ONLY) {
#pragma unroll
            for (int ks = 0; ks < 4; ++ks) ct[ks] = *(const bf16x8*)((const bf16_t*)(ws + O_CT) + ((size_t)g * 16 + fr) * 128 + ks * 32 + 8 * q);
        }
        float xr = 0.f, xi = 0.f;
        if (!ENDS_ONLY) {
            const float alr = AL[(g * 64 + lane) * 2], ali = AL[(g * 64 + lane) * 2 + 1];
            for (int cp = 0; cp < c; ++cp) {
                const float2 e = *(const float2*)(ENDS + (((size_t)(b * NCHUNK + cp) * 32 + g) * 64 + lane) * 2);
                const float nr = alr * xr - ali * xi + e.x, ni = alr * xi + ali * xr + e.y; xr = nr; xi = ni;
            }
        }
        const size_t tok0 = (size_t)b * SEQ + (size_t)c * CHUNK;
        for (int sub = 0; sub < CHUNK / 16; ++sub) {
            const size_t tk = tok0 + sub * 16;
            bf16x8 uf = (bf16x8){0, 0, 0, 0, 0, 0, 0, 0};
            if (q < 2) uf = *(const bf16x8*)(U + (tk + fr) * 512 + g * 16 + 8 * q);
#pragma unroll
            for (int nt = 0; nt < 8; ++nt) {
                f32x4 d = __builtin_amdgcn_mfma_f32_16x16x32_bf16(bb[nt], uf, (f32x4){0.f, 0.f, 0.f, 0.f}, 0, 0, 0);
                *(f32x4*)(BU + fr * S5_BU_STR + 16 * nt + 4 * q) = d;
            }
            asm volatile("s_waitcnt lgkmcnt(0)" ::: "memory");
#pragma unroll 4
            for (int s = 0; s < 16; ++s) {
                const float br = BU[s * S5_BU_STR + lane], bi = BU[s * S5_BU_STR + 64 + lane];
                const float nr = ar * xr - ai * xi + br, ni = ar * xi + ai * xr + bi; xr = nr; xi = ni;
                if (!ENDS_ONLY) { XB[s * S5_XB_STR + lane] = f2bf(xr); XB[s * S5_XB_STR + 64 + lane] = f2bf(xi); }
            }
            asm volatile("s_waitcnt lgkmcnt(0)" ::: "memory");
            if (!ENDS_ONLY) {
                f32x4 y = (f32x4){0.f, 0.f, 0.f, 0.f};
#pragma unroll
                for (int ks = 0; ks < 4; ++ks) {
                    const bf16x8 xf = *(const bf16x8*)(XB + fr * S5_XB_STR + ks * 32 + 8 * q);
                    y = __builtin_amdgcn_mfma_f32_16x16x32_bf16(ct[ks], xf, y, 0, 0, 0);
                }
                const uint2 uu = *(const uint2*)(U + (tk + fr) * 512 + g * 16 + 4 * q);
                const float4 dd = *(const float4*)(P.in[10] + g * 16 + 4 * q);
                const float y0 = gelu_tanh(y[0] + dd.x * bf2f((bf16_t)(uu.x & 0xffff))), y1 = gelu_tanh(y[1] + dd.y * bf2f((bf16_t)(uu.x >> 16)));
                const float y2 = gelu_tanh(y[2] + dd.z * bf2f((bf16_t)(uu.y & 0xffff))), y3 = gelu_tanh(y[3] + dd.w * bf2f((bf16_t)(uu.y >> 16)));
                uint2 o; o.x = pk2(y0, y1); o.y = pk2(y2, y3);
                *(uint2*)((bf16_t*)(ws + O_YG) + (tk + fr) * 512 + g * 16 + 4 * q) = o;
                asm volatile("s_waitcnt lgkmcnt(0)" ::: "memory");
            }
        }
        if (ENDS_ONLY) *(float2*)(ENDS + (((size_t)(b * NCHUNK + c) * 32 + g) * 64 + lane) * 2) = make_float2(xr, xi);
    }
}

constexpr int ATT_LDS = (4 * 64 + 4 * 512 + 128 + 4 * 1024) * 4;
__device__ __forceinline__ float dot64(const float (&qv)[64], const bf16_t* krow) {
    float s = 0.f;
#pragma unroll
    for (int c = 0; c < 8; ++c) {
        const uint4 w = *(const uint4*)(krow + c * 8);
        s += qv[c * 8 + 0] * __uint_as_float(w.x << 16) + qv[c * 8 + 1] * __uint_as_float(w.x & 0xffff0000u);
        s += qv[c * 8 + 2] * __uint_as_float(w.y << 16) + qv[c * 8 + 3] * __uint_as_float(w.y & 0xffff0000u);
        s += qv[c * 8 + 4] * __uint_as_float(w.z << 16) + qv[c * 8 + 5] * __uint_as_float(w.z & 0xffff0000u);
        s += qv[c * 8 + 6] * __uint_as_float(w.w << 16) + qv[c * 8 + 7] * __uint_as_float(w.w & 0xffff0000u);
    }
    return s;
}
__device__ __forceinline__ void attn_ref_phase(const Ptrs& P, char* smem, int vb, int nvb) {
    unsigned char* ws = P.ws;
    const int tid = threadIdx.x, lane = tid & 63, w = tid >> 6;
    float* qs = (float*)smem;
    float* pc = qs + 256;
    float* imp = pc + 2048;
    float* pw = imp + 128;
    int* sel_s = (int*)(pw + 4096);
    const bf16_t* QN = (const bf16_t*)(ws + O_QN);
    const float NEG = -1e30f;
    for (int it = vb; it < NB * 2 * SEQ; it += nvb) {
        const int t = it & (SEQ - 1), g = (it >> 13) & 1, b = it >> 14, bg = b * 2 + g;
        const size_t tok = (size_t)b * SEQ + t;
        const int h = g * 4 + w;
        const float slope = exp2f(-(float)(h + 1));
        __syncthreads();
        qs[w * 64 + lane] = bf2f(QN[tok * 512 + h * 64 + lane]);
        __syncthreads();
        float qv[64];
#pragma unroll
        for (int d = 0; d < 64; ++d) qv[d] = qs[w * 64 + d];
        const int n_vis = (t >= 31) ? ((t - 31) / 16 + 1) : 0;
        const bf16_t* KC = (const bf16_t*)(ws + O_KC) + (size_t)bg * 512 * 64;
        const bf16_t* VC = (const bf16_t*)(ws + O_VC) + (size_t)bg * 512 * 64;
        float sc[8]; float mx = NEG;
#pragma unroll
        for (int i = 0; i < 8; ++i) { const int j = lane + 64 * i; sc[i] = NEG;
            if (j < n_vis) { sc[i] = dot64(qv, KC + (size_t)j * 64) * 0.6931471805599453f - slope * (float)(t - (16 * j + 31)); mx = fmaxf(mx, sc[i]); } }
        mx = wave_max(mx);
        float sum = 0.f;
#pragma unroll
        for (int i = 0; i < 8; ++i) { const int j = lane + 64 * i; sc[i] = (j < n_vis) ? __expf(sc[i] - mx) : 0.f; sum += sc[i]; }
        sum = wave_sum(sum);
        const float inv = (n_vis > 0) ? 1.0f / sum : 0.f;
#pragma unroll
        for (int i = 0; i < 8; ++i) pc[w * 512 + lane + 64 * i] = sc[i] * inv;
        __syncthreads();
        float o_cmp = 0.f;
        for (int j = 0; j < n_vis; ++j) o_cmp += pc[w * 512 + j] * bf2f(VC[(size_t)j * 64 + lane]);
        const int cur = t >> 6;
        if (tid < 128) {
            const int blk = tid; float v = 0.f;
#pragma unroll
            for (int hh = 0; hh < 4; ++hh) { v += pc[hh * 512 + 4 * blk] + pc[hh * 512 + 4 * blk + 1] + pc[hh * 512 + 4 * blk + 2] + pc[hh * 512 + 4 * blk + 3]; if (blk > 0) v += pc[hh * 512 + 4 * blk - 1]; }
            const bool valid = blk <= cur, forced = (blk == 0) || (blk == cur) || (blk == cur - 1);
            imp[blk] = valid ? (v + (forced ? 1e4f : 0.f)) : NEG;
        }
        __syncthreads();
        float v0 = imp[lane], v1 = imp[lane + 64];
        int sel[16];
#pragma unroll
        for (int r = 0; r < 16; ++r) {
            float bv; int bi;
            if (v0 >= v1) { bv = v0; bi = lane; } else { bv = v1; bi = lane + 64; }
#pragma unroll
            for (int o = 1; o < 64; o <<= 1) { const float ov = __shfl_xor(bv, o); const int oi = __shfl_xor(bi, o); if (ov > bv || (ov == bv && oi < bi)) { bv = ov; bi = oi; } }
            sel[r] = bi; if (lane == 0) sel_s[w * 16 + r] = bi;
            if (bi == lane) v0 = -3e38f; if (bi == lane + 64) v1 = -3e38f;
        }
        const bf16_t* KS = (const bf16_t*)(ws + O_KS) + (size_t)bg * SEQ * 64;
        const bf16_t* VS = (const bf16_t*)(ws + O_VS) + (size_t)bg * SEQ * 64;
        float ss[16]; mx = NEG;
#pragma unroll
        for (int r = 0; r < 16; ++r) { const int pos = sel[r] * 64 + lane; ss[r] = NEG;
            if (pos <= t) { ss[r] = dot64(qv, KS + (size_t)pos * 64) * 0.6931471805599453f - slope * (float)(t - pos); mx = fmaxf(mx, ss[r]); } }
        mx = wave_max(mx); sum = 0.f;
#pragma unroll
        for (int r = 0; r < 16; ++r) { const int pos = sel[r] * 64 + lane; ss[r] = (pos <= t) ? __expf(ss[r] - mx) : 0.f; sum += ss[r]; }
        sum = wave_sum(sum);
        { const float iv = 1.0f / sum;
#pragma unroll
          for (int r = 0; r < 16; ++r) pw[w * 1024 + r * 64 + lane] = ss[r] * iv; }
        __syncthreads();
        float o_slc = 0.f;
#pragma unroll 1
        for (int r = 0; r < 16; ++r) { const int blk = sel_s[w * 16 + r]; if (blk > cur) continue; const bf16_t* vb_ = VS + (size_t)blk * 64 * 64 + lane;
            for (int kk = 0; kk < 64; ++kk) o_slc += pw[w * 1024 + r * 64 + kk] * bf2f(vb_[(size_t)kk * 64]); }
        __syncthreads();
        const bf16_t* KW = (const bf16_t*)(ws + O_KW) + (size_t)bg * SEQ * 64;
        const bf16_t* VW = (const bf16_t*)(ws + O_VW) + (size_t)bg * SEQ * 64;
        float sw[8]; mx = NEG;
#pragma unroll
        for (int i = 0; i < 8; ++i) { const int pos = t - 511 + lane + 64 * i; sw[i] = NEG;
            if (pos >= 0) { sw[i] = dot64(qv, KW + (size_t)pos * 64) * 0.6931471805599453f - slope * (float)(t - pos); mx = fmaxf(mx, sw[i]); } }
        mx = wave_max(mx); sum = 0.f;
#pragma unroll
        for (int i = 0; i < 8; ++i) { const int pos = t - 511 + lane + 64 * i; sw[i] = (pos >= 0) ? __expf(sw[i] - mx) : 0.f; sum += sw[i]; }
        sum = wave_sum(sum);
        { const float iv = 1.0f / sum;
#pragma unroll
          for (int i = 0; i < 8; ++i) pw[w * 1024 + lane + 64 * i] = sw[i] * iv; }
        __syncthreads();
        float o_win = 0.f;
        { const int i0 = (t >= 511) ? 0 : (511 - t);
          for (int i = i0; i < 512; ++i) o_win += pw[w * 1024 + i] * bf2f(VW[(size_t)(t - 511 + i) * 64 + lane]); }
        const float* G = (const float*)(ws + O_GATES) + tok * 24;
        const float y = G[h] * o_cmp + G[8 + h] * o_slc + G[16 + h] * o_win;
        ((bf16_t*)(ws + O_YNSA))[tok * 512 + h * 64 + lane] = f2bf(y);
    }
}

constexpr int KSTR = 72;
constexpr int KV_TILE = 64 * KSTR * 2;
constexpr int IMP_STR = 132;
template <int NW> struct AttL {
    static constexpr int K0 = 0, V0 = 2 * KV_TILE, IMP = 4 * KV_TILE, SELM = IMP + NW * 16 * IMP_STR * 4, UNI = SELM + NW * 16 * 16, TOTAL = UNI + 64;
};
struct AttSrc { const bf16_t* k; const bf16_t* v; int vld; };

template <int NW>
__device__ __forceinline__ void att_load(const AttSrc& s, bool withv, u32x4 (&kr)[8 / NW], u32x4 (&vr)[8 / NW]) {
    const int tid = threadIdx.x;
#pragma unroll
    for (int i = 0; i < 8 / NW; ++i) {
        const int e = tid + i * NW * 64, row = e >> 3, ch = e & 7;
        kr[i] = *(const u32x4*)(s.k + (size_t)row * 64 + ch * 8);
        if (withv) vr[i] = *(const u32x4*)(s.v + (size_t)row * s.vld + ch * 8);
    }
}
template <int NW>
__device__ __forceinline__ void att_store(char* smem, int buf, bool withv, const u32x4 (&kr)[8 / NW], const u32x4 (&vr)[8 / NW]) {
    const int tid = threadIdx.x;
    bf16_t* Ks = (bf16_t*)(smem + AttL<NW>::K0 + buf * KV_TILE); bf16_t* Vs = (bf16_t*)(smem + AttL<NW>::V0 + buf * KV_TILE);
#pragma unroll
    for (int i = 0; i < 8 / NW; ++i) {
        const int e = tid + i * NW * 64, row = e >> 3, ch = e & 7;
        *(u32x4*)(Ks + row * KSTR + ch * 8) = kr[i];
        if (withv) *(u32x4*)(Vs + row * KSTR + ch * 8) = vr[i];
    }
}

template <int MODE>
__device__ __forceinline__ void att_block(const bf16_t* Ks, const bf16_t* Vs, const bf16x8 (&qf)[4][2], f32x4 (&acc)[4][4], float (&l)[4],
                                          const float (&invl)[4], const float (&g0)[4], const float (&base0)[4], const int (&hi0)[4], int wlo, bool need_mask,
                                          unsigned rtmask, float slope2, float kstep, float* imp_w, int blk0, int fr, int q) {
    const float NEGB = -1e30f;
#pragma unroll
    for (int kt = 0; kt < 2; ++kt) {
        bf16x8 kf[2][2];
#pragma unroll
        for (int ab = 0; ab < 2; ++ab)
#pragma unroll
            for (int ks = 0; ks < 2; ++ks) kf[ab][ks] = *(const bf16x8*)(Ks + (32 * kt + 16 * ab + fr) * KSTR + 32 * ks + 8 * q);
        bf16x8 vf[4];
        if (MODE != 0) {
#pragma unroll
            for (int dt = 0; dt < 4; ++dt) {
                typedef unsigned u32x2 __attribute__((ext_vector_type(2)));
                const u32x2 lo = *(const u32x2*)(Vs + (16 * dt + fr) * KSTR + 32 * kt + 4 * q), hi = *(const u32x2*)(Vs + (16 * dt + fr) * KSTR + 32 * kt + 16 + 4 * q);
                const u32x4 vv = {lo[0], lo[1], hi[0], hi[1]};
                vf[dt] = __builtin_bit_cast(bf16x8, vv);
            }
        }
#pragma unroll
        for (int rt = 0; rt < 4; ++rt) {
            if (!((rtmask >> rt) & 1u)) continue;
            const float bl = base0[rt] + slope2 * kstep * (float)(32 * kt + 4 * q);
            f32x4 S[2];
#pragma unroll
            for (int ab = 0; ab < 2; ++ab) {
#pragma unroll
                for (int r = 0; r < 4; ++r) S[ab][r] = bl + slope2 * kstep * (float)(16 * ab + r);
                S[ab] = __builtin_amdgcn_mfma_f32_16x16x32_bf16(kf[ab][0], qf[rt][0], S[ab], 0, 0, 0);
                S[ab] = __builtin_amdgcn_mfma_f32_16x16x32_bf16(kf[ab][1], qf[rt][1], S[ab], 0, 0, 0);
            }
            if (need_mask) {
                const int hi = hi0[rt] - (32 * kt + 4 * q), lo = hi - wlo;
#pragma unroll
                for (int ab = 0; ab < 2; ++ab)
#pragma unroll
                    for (int r = 0; r < 4; ++r) { const int c = 16 * ab + r; if (c > hi || c < lo) S[ab][r] = NEGB; }
            }
            float ps = 0.f;
#pragma unroll
            for (int ab = 0; ab < 2; ++ab)
#pragma unroll
                for (int r = 0; r < 4; ++r) { S[ab][r] = __builtin_amdgcn_exp2f(S[ab][r]); ps += S[ab][r]; }
            if (MODE == 0) { l[rt] += ps; continue; }
            if (MODE == 2) l[rt] += ps;
            if (MODE == 1) {
                const float il = invl[rt];
#pragma unroll
                for (int ab = 0; ab < 2; ++ab) {
                    S[ab] = S[ab] * il;
                    float cs = (S[ab][0] + S[ab][1]) + (S[ab][2] + S[ab][3]), last = S[ab][3];
                    cs += __shfl_xor(cs, 1); cs += __shfl_xor(cs, 2); last += __shfl_xor(last, 1); last += __shfl_xor(last, 2);
                    const int blk = blk0 + 8 * kt + 4 * ab + q;
                    if ((fr & 3) == 0) { float* ip = imp_w + (4 * rt + (fr >> 2)) * IMP_STR + blk; atomicAdd(ip, cs); if (blk + 1 < 128) atomicAdd(ip + 1, last); }
                    S[ab] = S[ab] * g0[rt];
                }
            }
            const u32x4 pu = {pk2(S[0][0], S[0][1]), pk2(S[0][2], S[0][3]), pk2(S[1][0], S[1][1]), pk2(S[1][2], S[1][3])};
            const bf16x8 pf = __builtin_bit_cast(bf16x8, pu);
#pragma unroll
            for (int dt = 0; dt < 4; ++dt) acc[rt][dt] = __builtin_amdgcn_mfma_f32_16x16x32_bf16(vf[dt], pf, acc[rt][dt], 0, 0, 0);
        }
    }
}

template <int NW>
__device__ __forceinline__ void attn_mfma_phase(const Ptrs& P, char* smem, int vb, int nvb, size_t yoff = O_YNSA, int parts = 7) {
    typedef AttL<NW> L;
    unsigned char* ws = P.ws;
    const int tid = threadIdx.x, lane = tid & 63, wave = __builtin_amdgcn_readfirstlane(tid >> 6), fr = lane & 15, q = lane >> 4;
    constexpr int TQ = 16 * NW, NQT = SEQ / TQ, NCH = 8 / NW;
    float* imp_w = (float*)(smem + L::IMP) + wave * 16 * IMP_STR;
    unsigned* selm_w = (unsigned*)(smem + L::SELM) + wave * 64;
    unsigned* uni = (unsigned*)(smem + L::UNI);
    const float* M2 = (const float*)(ws + O_M2);
    const float LOG2E = 1.4426950408889634f;
    for (int it = vb; it < NB * 2 * NQT; it += nvb) {
        const int qt = NQT - 1 - (it / (NB * 2)), bg = it % (NB * 2), b = bg >> 1, g = bg & 1;
        const int qs = qt * TQ, t0 = qs + 16 * wave;
        const int head = fr & 3, h = g * 4 + head;
        const float slope2 = exp2f(-(float)(h + 1)) * LOG2E;
        const bf16_t* QN = (const bf16_t*)(ws + O_QN);
        bf16x8 qf[4][2]; int tpos[4];
#pragma unroll
        for (int rt = 0; rt < 4; ++rt) {
            tpos[rt] = t0 + 4 * rt + (fr >> 2);
            const size_t tok = (size_t)b * SEQ + tpos[rt];
#pragma unroll
            for (int ks = 0; ks < 2; ++ks) qf[rt][ks] = *(const bf16x8*)(QN + tok * 512 + h * 64 + 32 * ks + 8 * q);
        }
        for (int i = lane; i < 16 * IMP_STR; i += 64) imp_w[i] = 0.f;
        if (tid < 4) uni[tid] = 0u;
        f32x4 Y[4][4], O[4][4];
#pragma unroll
        for (int rt = 0; rt < 4; ++rt)
#pragma unroll
            for (int dt = 0; dt < 4; ++dt) { Y[rt][dt] = (f32x4){0.f, 0.f, 0.f, 0.f}; O[rt][dt] = (f32x4){0.f, 0.f, 0.f, 0.f}; }
        float l[4] = {0.f, 0.f, 0.f, 0.f}, invl[4] = {0.f, 0.f, 0.f, 0.f}, g0[4], base0[4]; int hi0[4];
        const float* G = (const float*)(ws + O_GATES);
#pragma unroll
        for (int rt = 0; rt < 4; ++rt) g0[rt] = G[((size_t)b * SEQ + tpos[rt]) * 24 + h];
        u32x4 kr[NCH], vr[NCH];
        __syncthreads();
        if (parts & 1) {
            const int jm_tile = (qs + TQ - 1 - 31) >> 4;
            const int nkb = (jm_tile >> 6) + 1;
            const int jm_lo = (t0 - 31) >> 4, jm_hi = (t0 + 15 - 31) >> 4;
            const float m2 = M2[0];
            const bf16_t* KC = (const bf16_t*)(ws + O_KC) + (size_t)bg * 512 * 64;
            const bf16_t* VCT = (const bf16_t*)(ws + O_VCT) + (size_t)bg * 64 * 512;
            int jmax[4];
#pragma unroll
            for (int rt = 0; rt < 4; ++rt) jmax[rt] = (tpos[rt] - 31) >> 4;
#pragma unroll 1
            for (int pass = 0; pass < 2; ++pass) {
                { AttSrc s0{KC, VCT, 512}; att_load<NW>(s0, true, kr, vr); att_store<NW>(smem, 0, true, kr, vr); }
                __syncthreads();
#pragma unroll 1
                for (int kb = 0; kb < nkb; ++kb) {
                    if (kb + 1 < nkb) { AttSrc s1{KC + (size_t)(kb + 1) * 64 * 64, VCT + (kb + 1) * 64, 512}; att_load<NW>(s1, true, kr, vr); }
                    if (64 * kb <= jm_hi) {
                        const bool need_mask = (64 * kb + 63 > jm_lo);
#pragma unroll
                        for (int rt = 0; rt < 4; ++rt) { base0[rt] = -m2 - slope2 * (float)(tpos[rt] - 31 - 1024 * kb); hi0[rt] = jmax[rt] - 64 * kb; }
                        const bf16_t* Ks = (const bf16_t*)(smem + L::K0 + (kb & 1) * KV_TILE); const bf16_t* Vs = (const bf16_t*)(smem + L::V0 + (kb & 1) * KV_TILE);
                        if (pass == 0) att_block<0>(Ks, Vs, qf, Y, l, invl, g0, base0, hi0, 1 << 28, need_mask, 0xFu, slope2, 16.f, imp_w, 16 * kb, fr, q);
                        else att_block<1>(Ks, Vs, qf, Y, l, invl, g0, base0, hi0, 1 << 28, need_mask, 0xFu, slope2, 16.f, imp_w, 16 * kb, fr, q);
                    }
                    if (kb + 1 < nkb) att_store<NW>(smem, (kb + 1) & 1, true, kr, vr);
                    __syncthreads();
                }
                if (pass == 0) {
#pragma unroll
                    for (int rt = 0; rt < 4; ++rt) { float s = l[rt]; s += __shfl_xor(s, 16); s += __shfl_xor(s, 32); invl[rt] = s > 0.f ? 1.0f / s : 0.f; l[rt] = 0.f; }
                }
            }
        }
        if (parts & 2) {
            asm volatile("s_waitcnt lgkmcnt(0)" ::: "memory");
            const int tl = lane >> 2, part = lane & 3, t = t0 + tl, cur = t >> 6;
            float* my = imp_w + tl * IMP_STR + 32 * part;
#pragma unroll 4
            for (int i = 0; i < 32; ++i) { const int blk = 32 * part + i; const float v = my[i];
                const bool valid = blk <= cur, forced = (blk == 0) || (blk == cur) || (blk == cur - 1);
                my[i] = valid ? (v + (forced ? 1e4f : 0.f)) : -1e30f; }
            asm volatile("s_waitcnt lgkmcnt(0)" ::: "memory");
            unsigned m0 = 0u, m1 = 0u, m2_ = 0u, m3 = 0u;
#pragma unroll 1
            for (int r = 0; r < 16; ++r) {
                float bv = -3.4e38f; int bi = 0;
#pragma unroll
                for (int i4 = 0; i4 < 8; ++i4) { const f32x4 v = *(const f32x4*)(my + 4 * i4);
#pragma unroll
                    for (int c = 0; c < 4; ++c) if (v[c] > bv) { bv = v[c]; bi = 32 * part + 4 * i4 + c; } }
#pragma unroll
                for (int o = 1; o < 4; o <<= 1) { const float ov = __shfl_xor(bv, o); const int oi = __shfl_xor(bi, o); if (ov > bv || (ov == bv && oi < bi)) { bv = ov; bi = oi; } }
                if ((bi >> 5) == part) imp_w[tl * IMP_STR + bi] = -3.0e38f;
                const unsigned bit = 1u << (bi & 31); const int wd = bi >> 5;
                m0 |= (wd == 0) ? bit : 0u; m1 |= (wd == 1) ? bit : 0u; m2_ |= (wd == 2) ? bit : 0u; m3 |= (wd == 3) ? bit : 0u;
                asm volatile("s_waitcnt lgkmcnt(0)" ::: "memory");
            }
            if (part == 0) { selm_w[tl * 4 + 0] = m0; selm_w[tl * 4 + 1] = m1; selm_w[tl * 4 + 2] = m2_; selm_w[tl * 4 + 3] = m3; }
#pragma unroll
            for (int o = 4; o < 64; o <<= 1) { m0 |= __shfl_xor(m0, o); m1 |= __shfl_xor(m1, o); m2_ |= __shfl_xor(m2_, o); m3 |= __shfl_xor(m3, o); }
            if (lane == 0) { atomicOr(uni + 0, m0); atomicOr(uni + 1, m1); atomicOr(uni + 2, m2_); atomicOr(uni + 3, m3); }
            __syncthreads();
            unsigned wu[4] = {(unsigned)__builtin_amdgcn_readfirstlane(m0), (unsigned)__builtin_amdgcn_readfirstlane(m1), (unsigned)__builtin_amdgcn_readfirstlane(m2_), (unsigned)__builtin_amdgcn_readfirstlane(m3)};
            unsigned bu[4] = {(unsigned)__builtin_amdgcn_readfirstlane(uni[0]), (unsigned)__builtin_amdgcn_readfirstlane(uni[1]), (unsigned)__builtin_amdgcn_readfirstlane(uni[2]), (unsigned)__builtin_amdgcn_readfirstlane(uni[3])};
            const float m2s = M2[1];
            const bf16_t* KS = (const bf16_t*)(ws + O_KS) + (size_t)bg * SEQ * 64;
            const bf16_t* VST = (const bf16_t*)(ws + O_VST) + (size_t)bg * 64 * SEQ;
            int nsel = __popc(bu[0]) + __popc(bu[1]) + __popc(bu[2]) + __popc(bu[3]);
            int cw = 0; unsigned cbits = bu[0];
#define NEXT_BLK(dst) do { while (cbits == 0u) { ++cw; cbits = (cw == 1) ? bu[1] : (cw == 2) ? bu[2] : bu[3]; } const int bpos_ = __ffs(cbits) - 1; cbits &= cbits - 1u; dst = cw * 32 + bpos_; } while (0)
            int blk_cur = 0, blk_nxt = 0;
            if (nsel > 0) {
                NEXT_BLK(blk_cur);
                { AttSrc s0{KS + (size_t)blk_cur * 64 * 64, VST + blk_cur * 64, SEQ}; att_load<NW>(s0, true, kr, vr); att_store<NW>(smem, 0, true, kr, vr); }
                __syncthreads();
#pragma unroll 1
                for (int i = 0; i < nsel; ++i) {
                    if (i + 1 < nsel) { NEXT_BLK(blk_nxt); AttSrc s1{KS + (size_t)blk_nxt * 64 * 64, VST + blk_nxt * 64, SEQ}; att_load<NW>(s1, true, kr, vr); }
                    const int blk = blk_cur, kb0 = 64 * blk;
                    const unsigned wword = (blk < 32) ? wu[0] : (blk < 64) ? wu[1] : (blk < 96) ? wu[2] : wu[3];
                    if (((wword >> (blk & 31)) & 1u) && kb0 <= t0 + 15) {
                        const bool need_mask = (kb0 + 63 > t0);
                        unsigned rtmask = 0u;
#pragma unroll
                        for (int rt = 0; rt < 4; ++rt) {
                            const unsigned w_ = selm_w[(4 * rt + (fr >> 2)) * 4 + (blk >> 5)];
                            const bool sel = (w_ >> (blk & 31)) & 1u;
                            base0[rt] = sel ? (-m2s - slope2 * (float)(tpos[rt] - kb0)) : -1e30f;
                            hi0[rt] = tpos[rt] - kb0;
                            if (__ballot(sel) != 0ull) rtmask |= 1u << rt;
                        }
                        rtmask = __builtin_amdgcn_readfirstlane(rtmask);
                        const bf16_t* Ks = (const bf16_t*)(smem + L::K0 + (i & 1) * KV_TILE); const bf16_t* Vs = (const bf16_t*)(smem + L::V0 + (i & 1) * KV_TILE);
                        att_block<2>(Ks, Vs, qf, O, l, invl, g0, base0, hi0, 1 << 28, need_mask, rtmask, slope2, 1.f, imp_w, 0, fr, q);
                    }
                    if (i + 1 < nsel) att_store<NW>(smem, (i + 1) & 1, true, kr, vr);
                    blk_cur = blk_nxt;
                    __syncthreads();
                }
            }
#pragma unroll
            for (int rt = 0; rt < 4; ++rt) {
                float s = l[rt]; s += __shfl_xor(s, 16); s += __shfl_xor(s, 32);
                const float cf = (s > 0.f) ? G[((size_t)b * SEQ + tpos[rt]) * 24 + 8 + h] / s : 0.f; l[rt] = 0.f;
#pragma unroll
                for (int dt = 0; dt < 4; ++dt) { Y[rt][dt] = Y[rt][dt] + O[rt][dt] * cf; O[rt][dt] = (f32x4){0.f, 0.f, 0.f, 0.f}; }
            }
        }
        if (parts & 4) {
            const float m2w = M2[2];
            const bf16_t* KW = (const bf16_t*)(ws + O_KW) + (size_t)bg * SEQ * 64;
            const bf16_t* VWT = (const bf16_t*)(ws + O_VWT) + (size_t)bg * 64 * SEQ;
            const int wlast = (qs + TQ - 1) >> 6; int wfirst = (qs - 511) >> 6; if (wfirst < 0) wfirst = 0;
            const int nwb = wlast - wfirst + 1;
            { AttSrc s0{KW + (size_t)wfirst * 64 * 64, VWT + wfirst * 64, SEQ}; att_load<NW>(s0, true, kr, vr); att_store<NW>(smem, 0, true, kr, vr); }
            __syncthreads();
#pragma unroll 1
            for (int i = 0; i < nwb; ++i) {
                const int wb = wfirst + i, kb0 = 64 * wb;
                if (i + 1 < nwb) { AttSrc s1{KW + (size_t)(wb + 1) * 64 * 64, VWT + (wb + 1) * 64, SEQ}; att_load<NW>(s1, true, kr, vr); }
                if (kb0 <= t0 + 15 && kb0 + 63 >= t0 - 511) {
                    const bool need_mask = !(kb0 + 63 <= t0 && kb0 >= t0 + 15 - 511);
#pragma unroll
                    for (int rt = 0; rt < 4; ++rt) { base0[rt] = -m2w - slope2 * (float)(tpos[rt] - kb0); hi0[rt] = tpos[rt] - kb0; }
                    const bf16_t* Ks = (const bf16_t*)(smem + L::K0 + (i & 1) * KV_TILE); const bf16_t* Vs = (const bf16_t*)(smem + L::V0 + (i & 1) * KV_TILE);
                    att_block<2>(Ks, Vs, qf, O, l, invl, g0, base0, hi0, 511, need_mask, 0xFu, slope2, 1.f, imp_w, 0, fr, q);
                }
                if (i + 1 < nwb) att_store<NW>(smem, (i + 1) & 1, true, kr, vr);
                __syncthreads();
            }
        }
        bf16_t* YN = (bf16_t*)(ws + yoff);
#pragma unroll
        for (int rt = 0; rt < 4; ++rt) {
            float s = l[rt]; s += __shfl_xor(s, 16); s += __shfl_xor(s, 32);
            const size_t tok = (size_t)b * SEQ + tpos[rt];
            const float cf = (s > 0.f) ? G[tok * 24 + 16 + h] / s : 0.f;
#pragma unroll
            for (int dt = 0; dt < 4; ++dt) { const f32x4 y = Y[rt][dt] + O[rt][dt] * cf; uint2 o; o.x = pk2(y[0], y[1]); o.y = pk2(y[2], y[3]);
                *(uint2*)(YN + tok * 512 + h * 64 + 16 * dt + 4 * q) = o; }
        }
        __syncthreads();
    }
}

__device__ __forceinline__ void glu_phase(const Ptrs& P, char* smem, int vb, int nvb) {
    unsigned char* ws = P.ws;
    GemmDesc g[1] = {{(const bf16_t*)(ws + O_YG), (const bf16_t*)(ws + O_WT_GLU), 512, 512, 512, 0}};
    const int lane = threadIdx.x & 63, wave = threadIdx.x >> 6, wm = wave >> 1, wn = wave & 1, fr = lane & 15, q = lane >> 4;
    const bf16_t* YG = (const bf16_t*)(ws + O_YG); bf16_t* YS = (bf16_t*)(ws + O_YSSM); const float* bg = P.in[12];
    for (int t = vb; t < (NTOK / 128) * 4; t += nvb) {
        const int tm = t >> 2, tn = t & 3, m0 = tm * 128, n0 = tn * 128;
        f32x4 acc[1][4][4];
        gemm_tile<1>(smem, g, m0, n0, acc);
        const int mb = m0 + wm * 64, nb = n0 + wn * 64;
#pragma unroll
        for (int i = 0; i < 4; ++i)
#pragma unroll
            for (int j = 0; j < 4; ++j) { const f32x4 v = acc[0][i][j]; const size_t off = (size_t)(mb + 16 * i + fr) * 512 + nb + 16 * j + 4 * q;
                const uint2 yy = *(const uint2*)(YG + off); const float4 bb = *(const float4*)(bg + nb + 16 * j + 4 * q);
                uint2 o; o.x = pk2(bf2f((bf16_t)(yy.x & 0xffff)) * sigmoidf_(v[0] + bb.x), bf2f((bf16_t)(yy.x >> 16)) * sigmoidf_(v[1] + bb.y));
                o.y = pk2(bf2f((bf16_t)(yy.y & 0xffff)) * sigmoidf_(v[2] + bb.z), bf2f((bf16_t)(yy.y >> 16)) * sigmoidf_(v[3] + bb.w));
                *(uint2*)(YS + off) = o; }
    }
}

__device__ __forceinline__ void merge_phase(const Ptrs& P, char* smem, int vb, int nvb) {
    unsigned char* ws = P.ws;
    GemmDesc g[2] = {{(const bf16_t*)(ws + O_YSSM), (const bf16_t*)(ws + O_WT_PS), 512, 512, 512, 0}, {(const bf16_t*)(ws + O_YNSA), (const bf16_t*)(ws + O_WT_PN), 512, 512, 512, 0}};
    const int lane = threadIdx.x & 63, wave = threadIdx.x >> 6, wm = wave >> 1, wn = wave & 1, fr = lane & 15, q = lane >> 4;
    const bf16_t* MG = (const bf16_t*)(ws + O_MG); bf16_t* ME = (bf16_t*)(ws + O_MERGED);
    for (int t = vb; t < (NTOK / 128) * 8; t += nvb) {
        const int tm = t >> 3, tn = t & 7, m0 = tm * 128, n0 = tn * 128;
        f32x4 acc[2][4][4];
        gemm_tile<2>(smem, g, m0, n0, acc);
        const int mb = m0 + wm * 64, nb = n0 + wn * 64;
#pragma unroll
        for (int i = 0; i < 4; ++i)
#pragma unroll
            for (int j = 0; j < 4; ++j) { const f32x4 a = acc[0][i][j], c = acc[1][i][j]; const int m = mb + 16 * i + fr, n = nb + 16 * j + 4 * q;
                const uint2 g0 = *(const uint2*)(MG + (size_t)m * 2048 + n), g1 = *(const uint2*)(MG + (size_t)m * 2048 + 1024 + n);
                uint2 o;
                o.x = pk2(bf2f((bf16_t)(g0.x & 0xffff)) * a[0] + bf2f((bf16_t)(g1.x & 0xffff)) * c[0], bf2f((bf16_t)(g0.x >> 16)) * a[1] + bf2f((bf16_t)(g1.x >> 16)) * c[1]);
                o.y = pk2(bf2f((bf16_t)(g0.y & 0xffff)) * a[2] + bf2f((bf16_t)(g1.y & 0xffff)) * c[2], bf2f((bf16_t)(g0.y >> 16)) * a[3] + bf2f((bf16_t)(g1.y >> 16)) * c[3]);
                *(uint2*)(ME + (size_t)m * 1024 + n) = o; }
    }
}

__device__ __forceinline__ void outproj_phase(const Ptrs& P, char* smem, int vb, int nvb) {
    unsigned char* ws = P.ws;
    GemmDesc g[1] = {{(const bf16_t*)(ws + O_MERGED), (const bf16_t*)(ws + O_WT_OUT), 1024, 1024, 1024, 0}};
    const int lane = threadIdx.x & 63, wave = threadIdx.x >> 6, wm = wave >> 1, wn = wave & 1, fr = lane & 15, q = lane >> 4;
    const float* x = P.in[0]; float* out = P.out; bf16_t* X1B = (bf16_t*)(ws + O_X1B); float* SSQ = (float*)(ws + O_SSQ);
    for (int t = vb; t < (NTOK / 128) * 8; t += nvb) {
        const int tm = t >> 3, tn = t & 7, m0 = tm * 128, n0 = tn * 128;
        f32x4 acc[1][4][4];
        gemm_tile<1>(smem, g, m0, n0, acc);
        const int mb = m0 + wm * 64, nb = n0 + wn * 64;
#pragma unroll
        for (int i = 0; i < 4; ++i) {
            const int m = mb + 16 * i + fr; f32x4 r[4];
#pragma unroll
            for (int j = 0; j < 4; ++j) { const size_t off = (size_t)m * 1024 + nb + 16 * j + 4 * q; const float4 xv = *(const float4*)(x + off);
                f32x4 v = acc[0][i][j]; v[0] += xv.x; v[1] += xv.y; v[2] += xv.z; v[3] += xv.w; r[j] = v;
                *(float4*)(out + off) = make_float4(v[0], v[1], v[2], v[3]);
                uint2 o; o.x = pk2(v[0], v[1]); o.y = pk2(v[2], v[3]); *(uint2*)(X1B + off) = o; }
            const float s = row_ssq64(r);
            if (q == 0) atomicAdd(SSQ + m, s);
        }
    }
}

__device__ __forceinline__ void up_phase(const Ptrs& P, char* smem, int vb, int nvb) {
    unsigned char* ws = P.ws;
    GemmDesc g[1] = {{(const bf16_t*)(ws + O_X1B), (const bf16_t*)(ws + O_WT_UP), 1024, 1024, 1024, 0}};
    const int lane = threadIdx.x & 63, wave = threadIdx.x >> 6, wm = wave >> 1, wn = wave & 1, fr = lane & 15, q = lane >> 4;
    bf16_t* FF = (bf16_t*)(ws + O_FF); const float* SSQ = (const float*)(ws + O_SSQ);
    for (int t = vb; t < (NTOK / 128) * 32; t += nvb) {
        const int tm = t >> 5, tn = t & 31, m0 = tm * 128, n0 = tn * 128;
        f32x4 acc[1][4][4];
        gemm_tile<1>(smem, g, m0, n0, acc);
        const int mb = m0 + wm * 64, nb = n0 + wn * 64;
#pragma unroll
        for (int i = 0; i < 4; ++i) {
            const int m = mb + 16 * i + fr; const float rstd = rsqrtf(SSQ[m] * (1.0f / DM) + EPS);
#pragma unroll
            for (int j = 0; j < 4; ++j) { f32x4 v = acc[0][i][j];
#pragma unroll
                for (int r = 0; r < 4; ++r) { const float a = fmaxf(v[r], 0.f) * rstd; v[r] = a * a; }
                uint2 o; o.x = pk2(v[0], v[1]); o.y = pk2(v[2], v[3]);
                *(uint2*)(FF + (size_t)m * DFF + nb + 16 * j + 4 * q) = o; }
        }
    }
}

__device__ __forceinline__ void down_phase(const Ptrs& P, char* smem, int vb, int nvb) {
    unsigned char* ws = P.ws;
    GemmDesc g[1] = {{(const bf16_t*)(ws + O_FF), (const bf16_t*)(ws + O_WT_DOWN), DFF, DFF, DFF, 0}};
    const int lane = threadIdx.x & 63, wave = threadIdx.x >> 6, wm = wave >> 1, wn = wave & 1, fr = lane & 15, q = lane >> 4;
    float* out = P.out;
    for (int t = vb; t < (NTOK / 128) * 8; t += nvb) {
        const int tm = t >> 3, tn = t & 7, m0 = tm * 128, n0 = tn * 128;
        f32x4 acc[1][4][4];
        gemm_tile<1>(smem, g, m0, n0, acc);
        const int mb = m0 + wm * 64, nb = n0 + wn * 64;
#pragma unroll
        for (int i = 0; i < 4; ++i)
#pragma unroll
            for (int j = 0; j < 4; ++j) { const size_t off = (size_t)(mb + 16 * i + fr) * 1024 + nb + 16 * j + 4 * q; const float4 xv = *(const float4*)(out + off);
                const f32x4 v = acc[0][i][j]; *(float4*)(out + off) = make_float4(v[0] + xv.x, v[1] + xv.y, v[2] + xv.z, v[3] + xv.w); }
    }
}

constexpr int SMEM_BYTES = 72 * 1024;
static_assert(AttL<4>::TOTAL <= SMEM_BYTES, "attention LDS");
#ifndef ATTN_REF
#define ATTN_REF 0
#endif
#ifndef PROBE_PARTS
#define PROBE_PARTS 7
#endif
#ifndef PROBE_REP
#define PROBE_REP 0
#endif
#define KDEF(name, call) __global__ void __launch_bounds__(256) name(Ptrs P, TrTable tt) { extern __shared__ __attribute__((aligned(16))) char smem[]; (void)tt; call; }
KDEF(k_transpose, transpose_phase(tt, smem, blockIdx.x, gridDim.x))
KDEF(k_consts, consts_phase(P, blockIdx.x, gridDim.x))
KDEF(k_rms1, rmsnorm1_phase(P, blockIdx.x, gridDim.x))
KDEF(k_inproj, inproj_phase(P, smem, blockIdx.x, gridDim.x))
KDEF(k_compress, compress_phase(P, smem, blockIdx.x, gridDim.x))
KDEF(k_s5ends, s5_phase<true>(P, smem, blockIdx.x, gridDim.x))
KDEF(k_s5main, s5_phase<false>(P, smem, blockIdx.x, gridDim.x))
#if ATTN_REF
KDEF(k_attn, attn_ref_phase(P, smem, blockIdx.x, gridDim.x))
#else
KDEF(k_attn, attn_mfma_phase<4>(P, smem, blockIdx.x, gridDim.x))
#endif
KDEF(k_glu, glu_phase(P, smem, blockIdx.x, gridDim.x))
KDEF(k_merge, merge_phase(P, smem, blockIdx.x, gridDim.x))
KDEF(k_outproj, outproj_phase(P, smem, blockIdx.x, gridDim.x))
KDEF(k_up, up_phase(P, smem, blockIdx.x, gridDim.x))
KDEF(k_down, down_phase(P, smem, blockIdx.x, gridDim.x))


__global__ void __launch_bounds__(256) k_mega(Ptrs P, TrTable tt) {
    extern __shared__ __attribute__((aligned(16))) char smem[];
    cg::grid_group grid = cg::this_grid();
    const int vb = blockIdx.x, nvb = gridDim.x;
    transpose_phase(tt, smem, vb, nvb);
    consts_phase(P, vb, nvb);
    rmsnorm1_phase(P, vb, nvb);
    grid.sync();
    inproj_phase(P, smem, vb, nvb);
    if (PROBE_REP & 1) { __syncthreads(); inproj_phase(P, smem, vb, nvb); }
    grid.sync();
    compress_phase(P, smem, vb, nvb);
    s5_phase<true>(P, smem, nvb - 1 - vb, nvb);
    grid.sync();
#if ATTN_REF
    attn_ref_phase(P, smem, vb, nvb);
#else
    attn_mfma_phase<4>(P, smem, vb, nvb);
    if (PROBE_REP & 2) { __syncthreads(); attn_mfma_phase<4>(P, smem, vb, nvb, O_MERGED, PROBE_PARTS); }
#endif
    s5_phase<false>(P, smem, vb, nvb);
    if (PROBE_REP & 4) { __syncthreads(); s5_phase<false>(P, smem, vb, nvb); }
    grid.sync();
    glu_phase(P, smem, vb, nvb);
    if (PROBE_REP & 8) { __syncthreads(); glu_phase(P, smem, vb, nvb); }
    grid.sync();
    merge_phase(P, smem, vb, nvb);
    if (PROBE_REP & 16) { __syncthreads(); merge_phase(P, smem, vb, nvb); }
    grid.sync();
    outproj_phase(P, smem, vb, nvb);
    grid.sync();
    up_phase(P, smem, vb, nvb);
    if (PROBE_REP & 32) { __syncthreads(); up_phase(P, smem, vb, nvb); }
    grid.sync();
    down_phase(P, smem, vb, nvb);
}

static void add_tr(TrTable& tt, int& n, const float* src, bf16_t* dst, const float* kscale, int K, int N, int ldsrc, int mode) {
    TrDesc& d = tt.d[n]; d.src = src; d.dst = dst; d.kscale = kscale; d.K = K; d.N = N; d.ldsrc = ldsrc; d.mode = mode; d.tiles_n = N / 64; d.tile0 = tt.total;
    tt.total += (K / 64) * (N / 64); ++n;
}

extern "C" void kernel_launch(void* const* d_in, const int* in_sizes, int n_in, void* d_out, int out_size, void* d_ws, size_t ws_size, hipStream_t stream) {
    if (n_in != 27 || ws_size < WS_END) { fprintf(stderr, "kernel_launch: unexpected n_in %d or ws_size %zu (need %zu)\n", n_in, ws_size, (size_t)WS_END); return; }
    Ptrs P{};
    for (int i = 0; i < 27; ++i) P.in[i] = (const float*)d_in[i];
    P.out = (float*)d_out; P.ws = (unsigned char*)d_ws;
    unsigned char* ws = P.ws;
    TrTable tt{}; int n = 0;
    add_tr(tt, n, P.in[2], (bf16_t*)(ws + O_WT_IN), nullptr, 1024, NIN, 3864, 1);
    add_tr(tt, n, P.in[11], (bf16_t*)(ws + O_WT_GLU), nullptr, 512, 512, 512, 0);
    add_tr(tt, n, P.in[21], (bf16_t*)(ws + O_WT_PS), nullptr, 512, 1024, 1024, 0);
    add_tr(tt, n, P.in[22], (bf16_t*)(ws + O_WT_PN), nullptr, 512, 1024, 1024, 0);
    add_tr(tt, n, P.in[23], (bf16_t*)(ws + O_WT_OUT), nullptr, 1024, 1024, 1024, 0);
    add_tr(tt, n, P.in[25], (bf16_t*)(ws + O_WT_UP), P.in[24], 1024, 4096, 4096, 0);
    add_tr(tt, n, P.in[26], (bf16_t*)(ws + O_WT_DOWN), nullptr, 4096, 1024, 1024, 0);
    add_tr(tt, n, P.in[15], (bf16_t*)(ws + O_WT_CK1), nullptr, 2048, 128, 128, 0);
    add_tr(tt, n, P.in[17], (bf16_t*)(ws + O_WT_CV1), nullptr, 2048, 128, 128, 0);
    add_tr(tt, n, P.in[16], (bf16_t*)(ws + O_WT_CK2), nullptr, 128, 64, 64, 0);
    add_tr(tt, n, P.in[18], (bf16_t*)(ws + O_WT_CV2), nullptr, 128, 64, 64, 0);
#if MULTI_LAUNCH
    const int G = 1024;
#define LAUNCH(k, grid) hipLaunchKernelGGL(k, dim3(grid), dim3(256), SMEM_BYTES, stream, P, tt)
    LAUNCH(k_transpose, G);
    LAUNCH(k_consts, 64);
    LAUNCH(k_rms1, G);
    LAUNCH(k_inproj, G);
    LAUNCH(k_compress, 64);
    LAUNCH(k_s5ends, G);
    LAUNCH(k_attn, 2048);
    LAUNCH(k_s5main, G);
    LAUNCH(k_glu, G);
    LAUNCH(k_merge, G);
    LAUNCH(k_outproj, G);
    LAUNCH(k_up, G);
    LAUNCH(k_down, G);
#else
    static int grid_blocks = 0;
    if (!grid_blocks) {
        int dev = 0, cus = 0, per_cu = 0;
        (void)hipGetDevice(&dev);
        (void)hipDeviceGetAttribute(&cus, hipDeviceAttributeMultiprocessorCount, dev);
        (void)hipFuncSetAttribute((const void*)k_mega, hipFuncAttributeMaxDynamicSharedMemorySize, SMEM_BYTES);
        (void)hipOccupancyMaxActiveBlocksPerMultiprocessor(&per_cu, k_mega, 256, SMEM_BYTES);
        if (per_cu < 1) { fprintf(stderr, "kernel_launch: occupancy query returned %d\n", per_cu); per_cu = 1; }
        if (per_cu > 2) per_cu = 2;
        grid_blocks = cus * per_cu;
    }
    void* args[] = {(void*)&P, (void*)&tt};
    hipError_t e = hipLaunchCooperativeKernel((void*)k_mega, dim3(grid_blocks), dim3(256), args, SMEM_BYTES, stream);
    if (e != hipSuccess) fprintf(stderr, "cooperative launch failed: %s (grid %d)\n", hipGetErrorString(e), grid_blocks);
#endif
}
```

```cpp
#include <hip/hip_runtime.h>
#include <hip/hip_cooperative_groups.h>
#include <cstdio>
#include <cstdint>
namespace cg = cooperative_groups;

typedef unsigned short bf16_t;
typedef short bf16x8 __attribute__((ext_vector_type(8)));
typedef float f32x4 __attribute__((ext_vector_type(4)));
typedef unsigned u32x4 __attribute__((ext_vector_type(4)));
typedef unsigned u32x2 __attribute__((ext_vector_type(2)));

#ifndef PROBE_REP
#define PROBE_REP 0
#endif

constexpr int NB = 4, SEQ = 8192, DM = 1024, NTOK = NB * SEQ;
constexpr int NIN = 4096;
constexpr int DFF = 4096;
constexpr int CHUNK = 128, NCHUNK = SEQ / CHUNK;
constexpr float EPS = 1e-6f;
constexpr int NWAVES = 8, NTHR = 512;
constexpr float C1 = 0.18033688011112042f;

constexpr size_t MiB = 1024 * 1024;
constexpr size_t al256(size_t x) { return (x + 255) & ~(size_t)255; }
constexpr size_t O_WT_IN = 0;
constexpr size_t O_WT_GLU = O_WT_IN + (size_t)NIN * 1024 * 2;
constexpr size_t O_WT_PS = O_WT_GLU + 512 * 512 * 2;
constexpr size_t O_WT_PN = O_WT_PS + 1024 * 512 * 2;
constexpr size_t O_WT_OUT = O_WT_PN + 1024 * 512 * 2;
constexpr size_t O_WT_UP = O_WT_OUT + 1024 * 1024 * 2;
constexpr size_t O_WT_DOWN = O_WT_UP + (size_t)4096 * 1024 * 2;
constexpr size_t O_WT_CK1 = O_WT_DOWN + (size_t)4096 * 1024 * 2;
constexpr size_t O_WT_CV1 = O_WT_CK1 + 128 * 2048 * 2;
constexpr size_t O_WT_CK2 = O_WT_CV1 + 128 * 2048 * 2;
constexpr size_t O_WT_CV2 = O_WT_CK2 + 64 * 128 * 2;
constexpr size_t O_B1K = O_WT_CV2 + 64 * 128 * 2;
constexpr size_t O_B1V = O_B1K + 512;
constexpr size_t O_ABAR = O_B1V + 512;
constexpr size_t O_AL = O_ABAR + 32 * 64 * 2 * 4;
constexpr size_t O_BBT = O_AL + 32 * 64 * 2 * 4;
constexpr size_t O_CT = O_BBT + 32 * 128 * 16 * 2;
constexpr size_t O_ENDS = O_CT + 32 * 16 * 128 * 2;
constexpr size_t O_SSQ = O_ENDS + (size_t)NB * NCHUNK * 32 * 64 * 2 * 4;
constexpr size_t O_GATES = O_SSQ + (size_t)NTOK * 4;
constexpr size_t O_KC = O_GATES + (size_t)NTOK * 24 * 4;
constexpr size_t O_VCT = O_KC + 8 * 512 * 64 * 2;
constexpr size_t O_M2 = O_VCT + 8 * 512 * 64 * 2;
constexpr size_t O_REGA = al256(O_M2 + 4096);
constexpr size_t O_XN = O_REGA;
constexpr size_t O_YSSM = O_XN;
constexpr size_t O_YNSA = O_XN + 32 * MiB;
constexpr size_t O_U = O_XN + 64 * MiB;
constexpr size_t O_QN = O_U + 32 * MiB;
constexpr size_t O_KCIN = O_QN + 32 * MiB;
constexpr size_t O_VCIN = O_KCIN + 8 * MiB;
constexpr size_t O_KS = O_VCIN + 8 * MiB;
constexpr size_t O_KW = O_KS + 8 * MiB;
constexpr size_t O_YG = O_KW + 8 * MiB;
constexpr size_t O_VST = O_YG + 32 * MiB;
constexpr size_t O_VWT = O_VST + 8 * MiB;
constexpr size_t O_FF = O_REGA;
constexpr size_t O_REGB = O_REGA + 256 * MiB;
constexpr size_t O_MG = O_REGB;
constexpr size_t O_X1B = O_REGB;
constexpr size_t O_MERGED = O_REGB + 128 * MiB;
constexpr size_t WS_END = O_MERGED + 64 * MiB;
static_assert(O_VWT + 8 * MiB <= O_REGB, "region A overflow");

__device__ __forceinline__ float bf2f(bf16_t h) { return __uint_as_float(((unsigned)h) << 16); }
__device__ __forceinline__ float bflo(unsigned w) { return __uint_as_float(w << 16); }
__device__ __forceinline__ float bfhi(unsigned w) { return __uint_as_float(w & 0xffff0000u); }
__device__ __forceinline__ bf16_t f2bf(float f) { unsigned u = __float_as_uint(f); u += 0x7fffu + ((u >> 16) & 1u); return (bf16_t)(u >> 16); }
typedef __bf16 bf16x2_t __attribute__((ext_vector_type(2)));
typedef float f32x2_t __attribute__((ext_vector_type(2)));
__device__ __forceinline__ unsigned pk2(float lo, float hi) { const f32x2_t f = {lo, hi}; const bf16x2_t v = __builtin_convertvector(f, bf16x2_t); return __builtin_bit_cast(unsigned, v); }
__device__ __forceinline__ u32x2 pk4(const f32x4 v) { return (u32x2){pk2(v[0], v[1]), pk2(v[2], v[3])}; }
__device__ __forceinline__ float sigmoidf_(float x) { return 1.0f / (1.0f + __expf(-x)); }
__device__ __forceinline__ float gelu_tanh(float x) { const float u = 0.7978845608028654f * (x + 0.044715f * x * x * x); return 0.5f * x * (1.0f + tanhf(u)); }
__device__ __forceinline__ float wave_sum(float v) {
#pragma unroll
    for (int o = 1; o < 64; o <<= 1) v += __shfl_xor(v, o);
    return v;
}

__device__ __forceinline__ int opaque_tid() { int t = threadIdx.x; asm volatile("" : "+v"(t)); return t; }

struct Ptrs {
    const float* in[27];
    float* out;
    unsigned char* ws;
};

struct TrDesc { const float* src; bf16_t* dst; const float* kscale; int K, N, ldsrc, mode, tiles_n, tile0; };
constexpr int NTR = 11;
struct TrTable { TrDesc d[NTR]; int total; int pad; };

__device__ __forceinline__ int in_col(int n) {
    const int T = n >> 8, p = n & 255, bj = p >> 7, wc = (p >> 5) & 3, dlo = p & 31;
    const int L = 64 * (4 * T + wc) + 32 * bj + dlo;
    if (L < 1792) return L;
    if (L < 3840) return L + 24;
    if (L < 3864) return L - 3840 + 1792;
    return -1;
}

__device__ __forceinline__ void transpose_phase(const TrTable& tt, char* smem, int vb, int nvb) {
    float* tile = (float*)smem;
    const int tid = opaque_tid();
    for (int it = vb; it < tt.total; it += nvb) {
        int di = 0;
#pragma unroll
        for (int i = 1; i < NTR; ++i) if (it >= tt.d[i].tile0) di = i;
        const TrDesc& d = tt.d[di];
        const int lt = it - d.tile0, tn = lt % d.tiles_n, tk = lt / d.tiles_n, k0 = tk * 64, n0 = tn * 64;
#pragma unroll 4
        for (int i = 0; i < 8; ++i) {
            const int kk = (tid >> 6) + 8 * i, nn = tid & 63;
            int col = n0 + nn; if (d.mode == 1) col = in_col(col);
            float v = 0.f;
            if (col >= 0) v = d.src[(size_t)(k0 + kk) * d.ldsrc + col];
            if (d.kscale) v *= d.kscale[k0 + kk];
            tile[kk * 65 + nn] = v;
        }
        __syncthreads();
#pragma unroll 4
        for (int i = 0; i < 8; ++i) {
            const int nn = (tid >> 6) + 8 * i, kk = tid & 63;
            d.dst[(size_t)(n0 + nn) * d.K + k0 + kk] = f2bf(tile[kk * 65 + nn]);
        }
        __syncthreads();
    }
}

__device__ __forceinline__ void consts_phase(const Ptrs& P, int vb, int nvb) {
    const int tid_ = opaque_tid(); const int gt = vb * NTHR + tid_, ngt = nvb * NTHR;
    unsigned char* ws = P.ws;
    for (int i = gt; i < 32 * 64; i += ngt) {
        const int g = i >> 6, p = i & 63;
        const double ar = (double)P.in[3][i], ai = (double)P.in[4][i], dt = exp((double)P.in[5][g]);
        const double mag = exp(ar * dt), abr = mag * cos(ai * dt), abi = mag * sin(ai * dt);
        const double den = ar * ar + ai * ai, nr = abr - 1.0;
        const double fr = (nr * ar + abi * ai) / den, fi = (abi * ar - nr * ai) / den;
        float* ABAR = (float*)(ws + O_ABAR); float* AL = (float*)(ws + O_AL);
        ABAR[i * 2] = (float)abr; ABAR[i * 2 + 1] = (float)abi;
        double pr = abr, pi = abi;
        for (int s = 0; s < 7; ++s) { const double nr2 = pr * pr - pi * pi, ni2 = 2.0 * pr * pi; pr = nr2; pi = ni2; }
        AL[i * 2] = (float)pr; AL[i * 2 + 1] = (float)pi;
        bf16_t* BBT = (bf16_t*)(ws + O_BBT);
        for (int c = 0; c < 16; ++c) {
            const double br = (double)P.in[6][(size_t)i * 16 + c], bi = (double)P.in[7][(size_t)i * 16 + c];
            BBT[((size_t)g * 128 + p) * 16 + c] = f2bf((float)(fr * br - fi * bi));
            BBT[((size_t)g * 128 + 64 + p) * 16 + c] = f2bf((float)(fr * bi + fi * br));
        }
        bf16_t* CT = (bf16_t*)(ws + O_CT);
        for (int c = 0; c < 16; ++c) {
            CT[((size_t)g * 16 + c) * 128 + p] = f2bf(P.in[8][((size_t)g * 16 + c) * 64 + p]);
            CT[((size_t)g * 16 + c) * 128 + 64 + p] = f2bf(-P.in[9][((size_t)g * 16 + c) * 64 + p]);
        }
    }
    {
        const int lane = tid_ & 63, gw = vb * NWAVES + (tid_ >> 6), ngw = nvb * NWAVES;
        for (int i = gw; i < 256; i += ngw) {
            const int n = i & 127; const bool isv = i >= 128;
            const float* pe = P.in[isv ? 14 : 13]; const float* w1 = P.in[isv ? 17 : 15];
            float s = 0.f;
            for (int k = lane; k < 2048; k += 64) s += pe[k] * w1[(size_t)k * 128 + n];
            s = wave_sum(s);
            if (lane == 0) ((float*)(ws + (isv ? O_B1V : O_B1K)))[n] = s;
        }
    }
    if (gt < 3) {
        float gq = 0.f, gk = 0.f;
        for (int d = 0; d < 64; ++d) { gq = fmaxf(gq, fabsf(P.in[19][d])); gk = fmaxf(gk, fabsf(P.in[20][gt * 64 + d])); }
        ((float*)(ws + O_M2))[gt] = 64.0f * C1 * gq * gk;
    }
    float* SSQ = (float*)(ws + O_SSQ);
    for (int i = gt; i < NTOK; i += ngt) SSQ[i] = 0.f;
}

__device__ __forceinline__ void rmsnorm1_phase(const Ptrs& P, int vb, int nvb) {
    const int tid_ = opaque_tid(); const int lane = tid_ & 63, gw = vb * NWAVES + (tid_ >> 6), ngw = nvb * NWAVES;
    const float* x = P.in[0]; const float* g = P.in[1]; bf16_t* XN = (bf16_t*)(P.ws + O_XN);
    for (int row = gw; row < NTOK; row += ngw) {
        const f32x4* xr = (const f32x4*)(x + (size_t)row * DM);
        f32x4 v[4]; float ss = 0.f;
#pragma unroll
        for (int j = 0; j < 4; ++j) { v[j] = xr[j * 64 + lane]; ss += v[j][0] * v[j][0] + v[j][1] * v[j][1] + v[j][2] * v[j][2] + v[j][3] * v[j][3]; }
        ss = wave_sum(ss);
        const float rstd = rsqrtf(ss * (1.0f / DM) + EPS);
#pragma unroll
        for (int j = 0; j < 4; ++j) {
            const f32x4 gg = ((const f32x4*)g)[j * 64 + lane];
            ((u32x2*)(XN + (size_t)row * DM))[j * 64 + lane] = pk4(v[j] * gg * rstd);
        }
    }
}

namespace pg8 {
#define PG8_LAS __attribute__((address_space(3)))
typedef unsigned short bf16_t;
typedef short bf16x8 __attribute__((ext_vector_type(8)));
typedef float f32x4 __attribute__((ext_vector_type(4)));
typedef unsigned u32x4 __attribute__((ext_vector_type(4)));
constexpr int BM = 256, BK = 64, HALF = 128, HTB = HALF * BK * 2  , STAGE_BYTES = 8 * HTB, NXCD = 8, WGM = 8;

__host__ __device__ __forceinline__ int lds_byte(int r, int c) { const int st = (r >> 4) * 2 + (c >> 5), rr = r & 15, cc = c & 31, ob = rr * 64 + cc * 2; return st * 1024 + (ob ^ (((ob >> 9) & 1) << 5)); }
__host__ __device__ __forceinline__ void stage_rc(int b, int& R, int& C) { const int st = b / 1024, sb = b % 1024, swz = sb ^ (((sb >> 9) & 1) << 5); R = (st >> 1) * 16 + swz / 64; C = (st & 1) * 32 + (swz % 64) / 2; }
__host__ __device__ __forceinline__ int perm32(int rho) { const int n = rho >> 4, i = rho & 15; return 8 * (i >> 2) + 4 * n + (i & 3); }

struct Unit { int pm, pn; };
struct Gemm { const bf16_t* A; const bf16_t* Bt; int M, N, K; };

struct StaticOrder {
    int nM, nN, nwg, G, c;
    __host__ __device__ void init(int M, int N, int G_, int c_) { nM = M / BM; nN = N / BM; nwg = nM * nN; G = G_; c = c_; }
    __host__ __device__ bool next(int i, Unit& u) const {
        const long L = (long)i * G + c; if (L >= nwg) return false;
        int wgid = (int)L; { const int q = nwg / NXCD, r = nwg % NXCD, xcd = wgid % NXCD, off = wgid / NXCD; wgid = (xcd < r ? xcd * (q + 1) : r * (q + 1) + (xcd - r) * q) + off; }
        const int nig = WGM * nN, gid = wgid / nig, fm = gid * WGM, gsz = (nM - fm) < WGM ? (nM - fm) : WGM;
        u.pm = fm + ((wgid % nig) % gsz); u.pn = (wgid % nig) / gsz; return true;
    }
    __device__ __forceinline__ void a_ready(const Unit&) const {}
    __device__ __forceinline__ void done(const Unit&) const {}
};
__device__ __forceinline__ float pg_row_ssq(const f32x4 (&acc)[2][2][4][2], int ai, int m) {
    float s = 0.f;
#pragma unroll
    for (int bj = 0; bj < 2; ++bj)
#pragma unroll
        for (int n = 0; n < 2; ++n) { const f32x4 v = acc[ai][bj][m][n]; s += (v[0] * v[0] + v[1] * v[1]) + (v[2] * v[2] + v[3] * v[3]); }
    s += __shfl_xor(s, 16); s += __shfl_xor(s, 32);
    return s;
}
struct EpiIn {
    static constexpr bool PERM = false, AFTER_DRAIN = false;
    unsigned char* ws; const float* gq; const float* gk;
    __device__ __forceinline__ void operator()(const f32x4 (&acc)[2][2][4][2], const Unit& u, int wr, int wc, int fr, int fq) const {
        const int seg = 4 * u.pn + wc, L0 = 64 * seg, row0 = u.pm * BM + wr * 64 + fr;
        if (L0 < 512) {
            ::bf16_t* U = (::bf16_t*)(ws + O_U);
#pragma unroll
            for (int ai = 0; ai < 2; ++ai)
#pragma unroll
                for (int m = 0; m < 4; ++m) { ::bf16_t* rp = U + (size_t)(row0 + ai * HALF + m * 16) * 512 + L0 + 4 * fq;
#pragma unroll
                    for (int bj = 0; bj < 2; ++bj)
#pragma unroll
                        for (int n = 0; n < 2; ++n) *(::u32x2*)(rp + 32 * bj + 16 * n) = pk4(acc[ai][bj][m][n]); }
        } else if (L0 < 1024) {
            ::bf16_t* QN = (::bf16_t*)(ws + O_QN);
#pragma unroll
            for (int ai = 0; ai < 2; ++ai)
#pragma unroll
                for (int m = 0; m < 4; ++m) { const float rs = rsqrtf(pg_row_ssq(acc, ai, m) * (1.0f / 64) + EPS) * C1;
                    ::bf16_t* rp = QN + (size_t)(row0 + ai * HALF + m * 16) * 512 + (L0 - 512) + 4 * fq;
#pragma unroll
                    for (int bj = 0; bj < 2; ++bj)
#pragma unroll
                        for (int n = 0; n < 2; ++n) { const f32x4 gg = *(const f32x4*)(gq + 32 * bj + 16 * n + 4 * fq); *(::u32x2*)(rp + 32 * bj + 16 * n) = pk4(acc[ai][bj][m][n] * gg * rs); } }
        } else if (L0 < 1792) {
            const int idx = (L0 - 1024) >> 6, br = idx >> 2, isv = (idx >> 1) & 1, g = idx & 1;
            if (!isv || br == 0) {
                ::bf16_t* dst = (::bf16_t*)(ws + (br == 0 ? (isv ? O_VCIN : O_KCIN) : (br == 1 ? O_KS : O_KW)));
                const bool donorm = br > 0; const float* gkk = gk + br * 64;
#pragma unroll
                for (int ai = 0; ai < 2; ++ai)
#pragma unroll
                    for (int m = 0; m < 4; ++m) { const int r = row0 + ai * HALF + m * 16, b = r >> 13, s = r & 8191;
                        float rs = 1.f; if (donorm) rs = rsqrtf(pg_row_ssq(acc, ai, m) * (1.0f / 64) + EPS);
                        ::bf16_t* rp = dst + ((size_t)(b * 2 + g) * SEQ + s) * 64 + 4 * fq;
#pragma unroll
                        for (int bj = 0; bj < 2; ++bj)
#pragma unroll
                            for (int n = 0; n < 2; ++n) { f32x4 v = acc[ai][bj][m][n]; if (donorm) v = v * *(const f32x4*)(gkk + 32 * bj + 16 * n + 4 * fq) * rs;
                                *(::u32x2*)(rp + 32 * bj + 16 * n) = pk4(v); } }
            } else {
                ::bf16_t* dst = (::bf16_t*)(ws + (br == 1 ? O_VST : O_VWT));
#pragma unroll
                for (int ai = 0; ai < 2; ++ai)
#pragma unroll
                    for (int m = 0; m < 4; ++m) { const int r = row0 + ai * HALF + m * 16, b = r >> 13, s = r & 8191;
#pragma unroll
                        for (int bj = 0; bj < 2; ++bj)
#pragma unroll
                            for (int n = 0; n < 2; ++n) { const ::u32x2 o = pk4(acc[ai][bj][m][n]); ::bf16_t* dT = dst + ((size_t)(b * 2 + g) * 64 + 32 * bj + 16 * n + 4 * fq) * SEQ + s;
                                dT[0] = (::bf16_t)(o[0] & 0xffff); dT[SEQ] = (::bf16_t)(o[0] >> 16); dT[2 * SEQ] = (::bf16_t)(o[1] & 0xffff); dT[3 * SEQ] = (::bf16_t)(o[1] >> 16); } }
            }
        } else if (L0 < 3840) {
            ::bf16_t* MG = (::bf16_t*)(ws + O_MG);
#pragma unroll
            for (int ai = 0; ai < 2; ++ai)
#pragma unroll
                for (int m = 0; m < 4; ++m) { ::bf16_t* rp = MG + (size_t)(row0 + ai * HALF + m * 16) * 2048 + (L0 - 1792) + 4 * fq;
#pragma unroll
                    for (int bj = 0; bj < 2; ++bj)
#pragma unroll
                        for (int n = 0; n < 2; ++n) { const f32x4 v = acc[ai][bj][m][n]; *(::u32x2*)(rp + 32 * bj + 16 * n) = (::u32x2){pk2(sigmoidf_(v[0]), sigmoidf_(v[1])), pk2(sigmoidf_(v[2]), sigmoidf_(v[3]))}; } }
        } else if (L0 == 3840) {
            float* G = (float*)(ws + O_GATES);
#pragma unroll
            for (int ai = 0; ai < 2; ++ai)
#pragma unroll
                for (int m = 0; m < 4; ++m)
#pragma unroll
                    for (int n = 0; n < 2; ++n) { const int c = 16 * n + 4 * fq;
                        if (c < 24) { const f32x4 v = acc[ai][0][m][n]; *(f32x4*)(G + (size_t)(row0 + ai * HALF + m * 16) * 24 + c) = (f32x4){sigmoidf_(v[0]), sigmoidf_(v[1]), sigmoidf_(v[2]), sigmoidf_(v[3])}; } }
        }
    }
};
#define PG_EPI_LOOP(...) \
    _Pragma("unroll") for (int ai = 0; ai < 2; ++ai) _Pragma("unroll") for (int m = 0; m < 4; ++m) { const int row = u.pm * BM + ai * HALF + wr * 64 + m * 16 + fr; \
        _Pragma("unroll") for (int bj = 0; bj < 2; ++bj) _Pragma("unroll") for (int n = 0; n < 2; ++n) { const int col = u.pn * BM + bj * HALF + wc * 32 + n * 16 + 4 * fq; const f32x4 v = acc[ai][bj][m][n]; __VA_ARGS__ } }
struct EpiGlu {
    static constexpr bool PERM = false, AFTER_DRAIN = false;
    const ::bf16_t* YG; ::bf16_t* YS; const float* bias;
    __device__ __forceinline__ void operator()(const f32x4 (&acc)[2][2][4][2], const Unit& u, int wr, int wc, int fr, int fq) const {
        PG_EPI_LOOP({ const size_t off = (size_t)row * 512 + col; const ::u32x2 yy = *(const ::u32x2*)(YG + off); const f32x4 bb = *(const f32x4*)(bias + col);
            *(::u32x2*)(YS + off) = (::u32x2){pk2(bflo(yy[0]) * sigmoidf_(v[0] + bb[0]), bfhi(yy[0]) * sigmoidf_(v[1] + bb[1])), pk2(bflo(yy[1]) * sigmoidf_(v[2] + bb[2]), bfhi(yy[1]) * sigmoidf_(v[3] + bb[3]))}; })
    }
};
template <int PASS> struct EpiMerge {
    static constexpr bool PERM = false, AFTER_DRAIN = false;
    const ::bf16_t* MG; ::bf16_t* ME;
    __device__ __forceinline__ void operator()(const f32x4 (&acc)[2][2][4][2], const Unit& u, int wr, int wc, int fr, int fq) const {
        PG_EPI_LOOP({ const ::u32x2 gg = *(const ::u32x2*)(MG + (size_t)row * 2048 + PASS * 1024 + col); ::bf16_t* mp = ME + (size_t)row * 1024 + col;
            f32x4 o = {bflo(gg[0]) * v[0], bfhi(gg[0]) * v[1], bflo(gg[1]) * v[2], bfhi(gg[1]) * v[3]};
            if (PASS == 1) { const ::u32x2 pp = *(const ::u32x2*)mp; o[0] += bflo(pp[0]); o[1] += bfhi(pp[0]); o[2] += bflo(pp[1]); o[3] += bfhi(pp[1]); }
            *(::u32x2*)mp = pk4(o); })
    }
};
struct EpiOut {
    static constexpr bool PERM = false, AFTER_DRAIN = false;
    const float* x; float* out; ::bf16_t* X1B; float* SSQ;
    __device__ __forceinline__ void operator()(const f32x4 (&acc)[2][2][4][2], const Unit& u, int wr, int wc, int fr, int fq) const {
#pragma unroll
        for (int ai = 0; ai < 2; ++ai)
#pragma unroll
            for (int m = 0; m < 4; ++m) { const int row = u.pm * BM + ai * HALF + wr * 64 + m * 16 + fr; float s = 0.f;
#pragma unroll
                for (int bj = 0; bj < 2; ++bj)
#pragma unroll
                    for (int n = 0; n < 2; ++n) { const size_t off = (size_t)row * 1024 + u.pn * BM + bj * HALF + wc * 32 + n * 16 + 4 * fq;
                        const f32x4 o = acc[ai][bj][m][n] + *(const f32x4*)(x + off); *(f32x4*)(out + off) = o; *(::u32x2*)(X1B + off) = pk4(o);
                        s += (o[0] * o[0] + o[1] * o[1]) + (o[2] * o[2] + o[3] * o[3]); }
                s += __shfl_xor(s, 16); s += __shfl_xor(s, 32);
                if (fq == 0) atomicAdd(SSQ + row, s); }
    }
};
struct EpiUp {
    static constexpr bool PERM = false, AFTER_DRAIN = false;
    ::bf16_t* FF; const float* SSQ;
    __device__ __forceinline__ void operator()(const f32x4 (&acc)[2][2][4][2], const Unit& u, int wr, int wc, int fr, int fq) const {
#pragma unroll
        for (int ai = 0; ai < 2; ++ai)
#pragma unroll
            for (int m = 0; m < 4; ++m) { const int row = u.pm * BM + ai * HALF + wr * 64 + m * 16 + fr; const float rstd = rsqrtf(SSQ[row] * (1.0f / DM) + EPS);
#pragma unroll
                for (int bj = 0; bj < 2; ++bj)
#pragma unroll
                    for (int n = 0; n < 2; ++n) { f32x4 v = acc[ai][bj][m][n];
#pragma unroll
                        for (int r = 0; r < 4; ++r) { const float a = fmaxf(v[r], 0.f) * rstd; v[r] = a * a; }
                        *(::u32x2*)(FF + (size_t)row * DFF + u.pn * BM + bj * HALF + wc * 32 + n * 16 + 4 * fq) = pk4(v); } }
    }
};
struct EpiDown {
    static constexpr bool PERM = false, AFTER_DRAIN = false;
    float* out;
    __device__ __forceinline__ void operator()(const f32x4 (&acc)[2][2][4][2], const Unit& u, int wr, int wc, int fr, int fq) const {
        PG_EPI_LOOP({ float* op = out + (size_t)row * 1024 + col; *(f32x4*)op = v + *(const f32x4*)op; })
    }
};

template <class Epi, class Sched, bool ALIGN_EPI = false, bool SP2 = false>
__device__ __forceinline__ void gemm_phase(PG8_LAS unsigned char* lds, const Gemm g, const Sched& S, const Epi& E) {
    const int tid = opaque_tid(), wid = __builtin_amdgcn_readfirstlane(tid >> 6), lane = tid & 63, wr = wid >> 2, wc = wid & 3, fr = lane & 15, fq = lane >> 4;
    const int K = g.K, nt = K / BK;
    unsigned voffA[2], voffB[2];
#pragma unroll
    for (int i = 0; i < 2; ++i) { int R, C; stage_rc(tid * 16 + i * 8192, R, C); const int Rb = Epi::PERM ? ((R & ~31) + perm32(R & 31)) : R;
        voffA[i] = (unsigned)(R * K + C) * 2u; voffB[i] = (unsigned)(Rb * K + C) * 2u; }
    const size_t kstep = (size_t)(BK * 2);
    const size_t hstep = (size_t)HALF * K * 2;
    const size_t tstep = 2 * hstep;
    const unsigned ldsw = (unsigned)wid * 1024u;
    const int aoff = lds_byte(wr * 64 + fr, fq * 8), boff = lds_byte(wc * 32 + fr, fq * 8);
#define PG8_SA(b, h) (((b) * 2 + (h)) * HTB)
#define PG8_SB(b, h) ((4 + (b) * 2 + (h)) * HTB)
#define PG8_STAGE(bufoff, gbase, voff) do { _Pragma("unroll") for (int _i = 0; _i < 2; ++_i) \
        __builtin_amdgcn_global_load_lds((const unsigned*)((const char*)(gbase) + (voff)[_i]), (PG8_LAS unsigned*)(lds + (bufoff) + ldsw + _i * 8192), 16, 0, 0); } while (0)
#define PG8_LDA(dst, b, h) do { _Pragma("unroll") for (int m = 0; m < 4; ++m) _Pragma("unroll") for (int k = 0; k < 2; ++k) dst[m][k] = *(const PG8_LAS bf16x8*)(lds + PG8_SA(b, h) + aoff + m * 2048 + k * 1024); } while (0)
#define PG8_LDB(dst, b, h) do { _Pragma("unroll") for (int n = 0; n < 2; ++n) _Pragma("unroll") for (int k = 0; k < 2; ++k) dst[n][k] = *(const PG8_LAS bf16x8*)(lds + PG8_SB(b, h) + boff + n * 2048 + k * 1024); } while (0)
#define PG8_MMA(ai, bj, At, Bt) do { __builtin_amdgcn_s_setprio(1); _Pragma("unroll") for (int m = 0; m < 4; ++m) _Pragma("unroll") for (int n = 0; n < 2; ++n) _Pragma("unroll") for (int k = 0; k < 2; ++k) \
        acc[ai][bj][m][n] = __builtin_amdgcn_mfma_f32_16x16x32_bf16(Bt[n][k], At[m][k], acc[ai][bj][m][n], 0, 0, 0); __builtin_amdgcn_s_setprio(0); } while (0)
#define PG8_WAIT_V(n) asm volatile("s_waitcnt vmcnt(" #n ")" ::: "memory")
#define PG8_WAIT_L(n) asm volatile("s_waitcnt lgkmcnt(" #n ")" ::: "memory")
#define PG8_BAR __builtin_amdgcn_s_barrier()
#define PG8_SCHED __builtin_amdgcn_sched_barrier(0)
    Unit cur, nxt; int ui = 0;
    if (!S.next(0, cur)) return;
    f32x4 acc[2][2][4][2];
#pragma unroll
    for (int a = 0; a < 2; ++a)
#pragma unroll
        for (int b = 0; b < 2; ++b)
#pragma unroll
            for (int m = 0; m < 4; ++m)
#pragma unroll
                for (int n = 0; n < 2; ++n) acc[a][b][m][n] = (f32x4){0.f, 0.f, 0.f, 0.f};
    bf16x8 At[4][2], B0[2][2], B1[2][2];
    const char* cA = (const char*)g.A + (size_t)cur.pm * tstep; const char* cB = (const char*)g.Bt + (size_t)cur.pn * tstep;
    S.a_ready(cur);
    if constexpr (SP2) {
        PG8_STAGE(PG8_SB(0, 0), cB, voffB); PG8_STAGE(PG8_SB(0, 1), cB + hstep, voffB); PG8_STAGE(PG8_SA(0, 0), cA, voffA); PG8_STAGE(PG8_SA(0, 1), cA + hstep, voffA);
        if (wr == 1) PG8_BAR;
        PG8_WAIT_V(2); PG8_BAR;
        PG8_STAGE(PG8_SB(1, 0), cB + kstep, voffB); PG8_STAGE(PG8_SA(1, 0), cA + kstep, voffA); PG8_STAGE(PG8_SB(1, 1), cB + hstep + kstep, voffB);
        PG8_WAIT_V(6); PG8_BAR;
    } else {
        PG8_STAGE(PG8_SB(0, 0), cB, voffB); PG8_STAGE(PG8_SA(0, 0), cA, voffA); PG8_STAGE(PG8_SB(0, 1), cB + hstep, voffB); PG8_STAGE(PG8_SA(0, 1), cA + hstep, voffA);
        if (wr == 1) PG8_BAR;
        PG8_WAIT_V(4); PG8_BAR;
        PG8_STAGE(PG8_SB(1, 0), cB + kstep, voffB); PG8_STAGE(PG8_SA(1, 0), cA + kstep, voffA); PG8_STAGE(PG8_SB(1, 1), cB + hstep + kstep, voffB);
        PG8_WAIT_V(6); PG8_BAR;
    }
    for (;;) {
        const bool has_next = S.next(ui + 1, nxt);
        const char* nA = has_next ? (const char*)g.A + (size_t)nxt.pm * tstep : cA; const char* nB = has_next ? (const char*)g.Bt + (size_t)nxt.pn * tstep : cB;
        for (int t = 0; t < nt; t += 2) {
            const bool last = (t == nt - 2);
            const char* a1 = cA + (size_t)(t + 1) * kstep;
            const char* a2 = last ? nA : cA + (size_t)(t + 2) * kstep; const char* b2 = last ? nB : cB + (size_t)(t + 2) * kstep;
            const char* a3 = a2 + kstep; const char* b3 = b2 + kstep;
            if (last && has_next) S.a_ready(nxt);
            if constexpr (SP2) {
            PG8_LDB(B0, 0, 0); PG8_LDB(B1, 0, 1); PG8_SCHED; PG8_LDA(At, 0, 0); PG8_STAGE(PG8_SA(1, 1), a1 + hstep, voffA);
            PG8_WAIT_V(8); PG8_WAIT_L(0); PG8_BAR; PG8_MMA(0, 0, At, B0); PG8_MMA(0, 1, At, B1); PG8_BAR; PG8_SCHED;
            PG8_LDA(At, 0, 1); PG8_STAGE(PG8_SB(0, 0), b2, voffB); PG8_STAGE(PG8_SB(0, 1), b2 + hstep, voffB); PG8_STAGE(PG8_SA(0, 0), a2, voffA);
            PG8_WAIT_V(8); PG8_WAIT_L(0); PG8_BAR; PG8_MMA(1, 0, At, B0); PG8_MMA(1, 1, At, B1); PG8_BAR; PG8_SCHED;
            PG8_LDB(B0, 1, 0); PG8_LDB(B1, 1, 1); PG8_SCHED; PG8_LDA(At, 1, 0); PG8_STAGE(PG8_SA(0, 1), a2 + hstep, voffA);
            PG8_WAIT_V(8); PG8_WAIT_L(0); PG8_BAR; PG8_MMA(0, 0, At, B0); PG8_MMA(0, 1, At, B1); PG8_BAR; PG8_SCHED;
            PG8_LDA(At, 1, 1); PG8_STAGE(PG8_SB(1, 0), b3, voffB); PG8_STAGE(PG8_SB(1, 1), b3 + hstep, voffB); PG8_STAGE(PG8_SA(1, 0), a3, voffA);
            PG8_WAIT_V(8); PG8_WAIT_L(0); PG8_BAR; PG8_MMA(1, 0, At, B0); PG8_MMA(1, 1, At, B1); PG8_BAR; PG8_SCHED;
            } else {
            PG8_LDB(B0, 0, 0); PG8_SCHED; PG8_LDA(At, 0, 0); PG8_STAGE(PG8_SA(1, 1), a1 + hstep, voffA);
            PG8_WAIT_L(8); PG8_BAR; PG8_WAIT_L(0); PG8_MMA(0, 0, At, B0); PG8_BAR; PG8_SCHED;
            PG8_LDB(B1, 0, 1); PG8_STAGE(PG8_SB(0, 0), b2, voffB);
            PG8_BAR; PG8_WAIT_L(0); PG8_MMA(0, 1, At, B1); PG8_BAR;
            PG8_LDA(At, 0, 1); PG8_STAGE(PG8_SA(0, 0), a2, voffA);
            PG8_BAR; PG8_WAIT_L(0); PG8_MMA(1, 0, At, B0); PG8_BAR; PG8_SCHED;
            PG8_STAGE(PG8_SB(0, 1), b2 + hstep, voffB);
            PG8_WAIT_V(6); PG8_BAR; PG8_MMA(1, 1, At, B1); PG8_BAR;
            PG8_LDB(B0, 1, 0); PG8_SCHED; PG8_LDA(At, 1, 0); PG8_STAGE(PG8_SA(0, 1), a2 + hstep, voffA);
            PG8_WAIT_L(8); PG8_BAR; PG8_WAIT_L(0); PG8_MMA(0, 0, At, B0); PG8_BAR; PG8_SCHED;
            PG8_LDB(B1, 1, 1); PG8_STAGE(PG8_SB(1, 0), b3, voffB);
            PG8_BAR; PG8_WAIT_L(0); PG8_MMA(0, 1, At, B1); PG8_BAR;
            PG8_LDA(At, 1, 1); PG8_STAGE(PG8_SA(1, 0), a3, voffA);
            PG8_BAR; PG8_WAIT_L(0); PG8_MMA(1, 0, At, B0); PG8_BAR; PG8_SCHED;
            PG8_STAGE(PG8_SB(1, 1), b3 + hstep, voffB);
            PG8_WAIT_V(6); PG8_BAR; PG8_MMA(1, 1, At, B1); PG8_BAR;
            }
        }
        if constexpr (ALIGN_EPI) { if (wr == 0) PG8_BAR; }
        if constexpr (!Epi::AFTER_DRAIN) { E(acc, cur, wr, wc, fr, fq); S.done(cur); }
        if (!has_next) break;
#pragma unroll
        for (int a = 0; a < 2; ++a)
#pragma unroll
            for (int b = 0; b < 2; ++b)
#pragma unroll
                for (int m = 0; m < 4; ++m)
#pragma unroll
                    for (int n = 0; n < 2; ++n) acc[a][b][m][n] = (f32x4){0.f, 0.f, 0.f, 0.f};
        cur = nxt; cA = nA; cB = nB; ++ui;
        if constexpr (ALIGN_EPI) { if (wr == 1) PG8_BAR; }
    }
    PG8_WAIT_V(0);
    if constexpr (!ALIGN_EPI) { if (wr == 0) PG8_BAR; }
    PG8_BAR;
    if constexpr (Epi::AFTER_DRAIN) { E.fused(acc, cur, wr, wc, fr, fq, lds, wid, lane); S.done(cur); }
#undef PG8_SA
#undef PG8_SB
#undef PG8_STAGE
#undef PG8_LDA
#undef PG8_LDB
#undef PG8_MMA
#undef PG8_WAIT_V
#undef PG8_WAIT_L
#undef PG8_BAR
#undef PG8_SCHED
}
}
typedef __attribute__((address_space(3))) unsigned char lds_u8;

template <class Epi>
__device__ __forceinline__ void big_gemm(char* smem, const bf16_t* A, const bf16_t* Bt, int M, int N, int K, const Epi& E) {
    pg8::Gemm g{A, Bt, M, N, K}; pg8::StaticOrder S; S.init(M, N, (int)gridDim.x, (int)blockIdx.x);
    pg8::gemm_phase<Epi, pg8::StaticOrder, true, true>((lds_u8*)smem, g, S, E);
}

constexpr int LSTR = 72;
__device__ __forceinline__ void compress_phase(const Ptrs& P, char* smem, int vb, int nvb) {
    unsigned char* ws = P.ws;
    const int tid = opaque_tid(), lane = tid & 63, wave = __builtin_amdgcn_readfirstlane(tid >> 6), wm = wave >> 2, wn = wave & 3, fr = lane & 15, q = lane >> 4;
    bf16_t* As = (bf16_t*)smem;
    bf16_t* Bs = As + 64 * LSTR;
    bf16_t* H = Bs + 128 * LSTR;
    constexpr int HS = 136;
    const int sc = tid & 7, sr = tid >> 3;
    for (int t = vb; t < 128; t += nvb) {
        const int isv = t >> 6, m0 = (t & 63) * 64;
        const bf16_t* Ag = (const bf16_t*)(ws + (isv ? O_VCIN : O_KCIN)) + (size_t)m0 * 1024 + sc * 8;
        const bf16_t* Bg = (const bf16_t*)(ws + (isv ? O_WT_CV1 : O_WT_CK1)) + sc * 8;
        f32x4 acc[2][2];
#pragma unroll
        for (int i = 0; i < 2; ++i)
#pragma unroll
            for (int j = 0; j < 2; ++j) acc[i][j] = (f32x4){0.f, 0.f, 0.f, 0.f};
        u32x4 ra = *(const u32x4*)(Ag + (size_t)sr * 1024), rb0 = *(const u32x4*)(Bg + (size_t)sr * 2048), rb1 = *(const u32x4*)(Bg + (size_t)(sr + 64) * 2048);
        for (int kt = 0; kt < 32; ++kt) {
            __syncthreads();
            *(u32x4*)(As + sr * LSTR + sc * 8) = ra; *(u32x4*)(Bs + sr * LSTR + sc * 8) = rb0; *(u32x4*)(Bs + (sr + 64) * LSTR + sc * 8) = rb1;
            __syncthreads();
            if (kt + 1 < 32) { ra = *(const u32x4*)(Ag + (size_t)sr * 1024 + (kt + 1) * 64); rb0 = *(const u32x4*)(Bg + (size_t)sr * 2048 + (kt + 1) * 64); rb1 = *(const u32x4*)(Bg + (size_t)(sr + 64) * 2048 + (kt + 1) * 64); }
#pragma unroll
            for (int ks = 0; ks < 2; ++ks) {
                bf16x8 a[2], b[2];
#pragma unroll
                for (int i = 0; i < 2; ++i) a[i] = *(const bf16x8*)(As + (wm * 32 + 16 * i + fr) * LSTR + ks * 32 + 8 * q);
#pragma unroll
                for (int j = 0; j < 2; ++j) b[j] = *(const bf16x8*)(Bs + (wn * 32 + 16 * j + fr) * LSTR + ks * 32 + 8 * q);
#pragma unroll
                for (int i = 0; i < 2; ++i)
#pragma unroll
                    for (int j = 0; j < 2; ++j) acc[i][j] = __builtin_amdgcn_mfma_f32_16x16x32_bf16(b[j], a[i], acc[i][j], 0, 0, 0);
            }
        }
        const float* b1 = (const float*)(ws + (isv ? O_B1V : O_B1K));
#pragma unroll
        for (int i = 0; i < 2; ++i)
#pragma unroll
            for (int j = 0; j < 2; ++j) { const f32x4 v = acc[i][j]; const int n = wn * 32 + 16 * j + 4 * q; const f32x4 bb = *(const f32x4*)(b1 + n);
                *(u32x2*)(H + (wm * 32 + 16 * i + fr) * HS + n) = (u32x2){pk2(gelu_tanh(v[0] + bb[0]), gelu_tanh(v[1] + bb[1])), pk2(gelu_tanh(v[2] + bb[2]), gelu_tanh(v[3] + bb[3]))}; }
        __syncthreads();
        if (wave < 4) {
            const bf16_t* W2t = (const bf16_t*)(ws + (isv ? O_WT_CV2 : O_WT_CK2));
            f32x4 o2[4];
#pragma unroll
            for (int j = 0; j < 4; ++j) o2[j] = (f32x4){0.f, 0.f, 0.f, 0.f};
#pragma unroll
            for (int ks = 0; ks < 4; ++ks) {
                const bf16x8 a = *(const bf16x8*)(H + (wave * 16 + fr) * HS + ks * 32 + 8 * q);
#pragma unroll
                for (int j = 0; j < 4; ++j) { const bf16x8 b = *(const bf16x8*)(W2t + (size_t)(16 * j + fr) * 128 + ks * 32 + 8 * q); o2[j] = __builtin_amdgcn_mfma_f32_16x16x32_bf16(b, a, o2[j], 0, 0, 0); }
            }
            const int R = m0 + wave * 16 + fr;
            if (!isv) {
                float s = 0.f;
#pragma unroll
                for (int j = 0; j < 4; ++j) s += (o2[j][0] * o2[j][0] + o2[j][1] * o2[j][1]) + (o2[j][2] * o2[j][2] + o2[j][3] * o2[j][3]);
                s += __shfl_xor(s, 16); s += __shfl_xor(s, 32);
                const float rstd = rsqrtf(s * (1.0f / 64) + EPS); const float* gk = P.in[20];
                bf16_t* dst = (bf16_t*)(ws + O_KC);
#pragma unroll
                for (int j = 0; j < 4; ++j) *(u32x2*)(dst + (size_t)R * 64 + 16 * j + 4 * q) = pk4(o2[j] * *(const f32x4*)(gk + 16 * j + 4 * q) * rstd);
            } else {
                bf16_t* dT0 = (bf16_t*)(ws + O_VCT) + (size_t)(R >> 9) * 64 * 512 + (R & 511);
#pragma unroll
                for (int j = 0; j < 4; ++j) { const u32x2 o = pk4(o2[j]); bf16_t* dT = dT0 + (size_t)(16 * j + 4 * q) * 512;
                    dT[0] = (bf16_t)(o[0] & 0xffff); dT[512] = (bf16_t)(o[0] >> 16); dT[1024] = (bf16_t)(o[1] & 0xffff); dT[1536] = (bf16_t)(o[1] >> 16); }
            }
        }
        __syncthreads();
    }
}

constexpr int S5_BU_STR = 132, S5_XB_STR = 136;
constexpr int S5_WAVE_LDS = 16 * S5_BU_STR * 4 + 16 * S5_XB_STR * 2;
template <bool ENDS_ONLY>
__device__ __forceinline__ void s5_phase(const Ptrs& P, char* smem, int vb, int nvb) {
    unsigned char* ws = P.ws;
    const int tid_ = opaque_tid(); const int lane = tid_ & 63, wave = __builtin_amdgcn_readfirstlane(tid_ >> 6), fr = lane & 15, q = lane >> 4;
    float* BU = (float*)(smem + wave * S5_WAVE_LDS);
    bf16_t* XB = (bf16_t*)(smem + wave * S5_WAVE_LDS + 16 * S5_BU_STR * 4);
    const bf16_t* U = (const bf16_t*)(ws + O_U);
    const float* ABAR = (const float*)(ws + O_ABAR); const float* AL = (const float*)(ws + O_AL);
    float* ENDS = (float*)(ws + O_ENDS);
    const int gw = vb * NWAVES + wave, ngw = nvb * NWAVES;
    for (int it = gw; it < NB * NCHUNK * 32; it += ngw) {
        const int g = it & 31, c = (it >> 5) & (NCHUNK - 1), b = it >> 11;
        const float ar = ABAR[(g * 64 + lane) * 2], ai = ABAR[(g * 64 + lane) * 2 + 1];
        bf16x8 bb[8];
#pragma unroll
        for (int nt = 0; nt < 8; ++nt) {
            bb[nt] = (bf16x8){0, 0, 0, 0, 0, 0, 0, 0};
            if (q < 2) bb[nt] = *(const bf16x8*)((const bf16_t*)(ws + O_BBT) + ((size_t)g * 128 + 16 * nt + fr) * 16 + 8 * q);
        }
        bf16x8 ct[4];
        if (!ENDS_ONLY) {
#pragma unroll
            for (int ks = 0; ks < 4; ++ks) ct[ks] = *(const bf16x8*)((const bf16_t*)(ws + O_CT) + ((size_t)g * 16 + fr) * 128 + ks * 32 + 8 * q);
        }
        float xr = 0.f, xi = 0.f;
        if (!ENDS_ONLY) {
            const float alr = AL[(g * 64 + lane) * 2], ali = AL[(g * 64 + lane) * 2 + 1];
            for (int cp = 0; cp < c; ++cp) {
                const f32x2_t e = *(const f32x2_t*)(ENDS + (((size_t)(b * NCHUNK + cp) * 32 + g) * 64 + lane) * 2);
                const float nr = alr * xr - ali * xi + e[0], ni = alr * xi + ali * xr + e[1]; xr = nr; xi = ni;
            }
        }
        const size_t tok0 = (size_t)b * SEQ + (size_t)c * CHUNK;
        for (int sub = 0; sub < CHUNK / 16; ++sub) {
            const size_t tk = tok0 + sub * 16;
            bf16x8 uf = (bf16x8){0, 0, 0, 0, 0, 0, 0, 0};
            if (q < 2) uf = *(const bf16x8*)(U + (tk + fr) * 512 + g * 16 + 8 * q);
#pragma unroll
            for (int nt = 0; nt < 8; ++nt) {
                f32x4 d = __builtin_amdgcn_mfma_f32_16x16x32_bf16(bb[nt], uf, (f32x4){0.f, 0.f, 0.f, 0.f}, 0, 0, 0);
                *(f32x4*)(BU + fr * S5_BU_STR + 16 * nt + 4 * q) = d;
            }
            asm volatile("s_waitcnt lgkmcnt(0)" ::: "memory");
#pragma unroll 4
            for (int s = 0; s < 16; ++s) {
                const float br = BU[s * S5_BU_STR + lane], bi = BU[s * S5_BU_STR + 64 + lane];
                const float nr = ar * xr - ai * xi + br, ni = ar * xi + ai * xr + bi; xr = nr; xi = ni;
                if (!ENDS_ONLY) { XB[s * S5_XB_STR + lane] = f2bf(xr); XB[s * S5_XB_STR + 64 + lane] = f2bf(xi); }
            }
            asm volatile("s_waitcnt lgkmcnt(0)" ::: "memory");
            if (!ENDS_ONLY) {
                f32x4 y = (f32x4){0.f, 0.f, 0.f, 0.f};
#pragma unroll
                for (int ks = 0; ks < 4; ++ks) {
                    const bf16x8 xf = *(const bf16x8*)(XB + fr * S5_XB_STR + ks * 32 + 8 * q);
                    y = __builtin_amdgcn_mfma_f32_16x16x32_bf16(ct[ks], xf, y, 0, 0, 0);
                }
                const u32x2 uu = *(const u32x2*)(U + (tk + fr) * 512 + g * 16 + 4 * q);
                const f32x4 dd = *(const f32x4*)(P.in[10] + g * 16 + 4 * q);
                const float y0 = gelu_tanh(y[0] + dd[0] * bflo(uu[0])), y1 = gelu_tanh(y[1] + dd[1] * bfhi(uu[0]));
                const float y2 = gelu_tanh(y[2] + dd[2] * bflo(uu[1])), y3 = gelu_tanh(y[3] + dd[3] * bfhi(uu[1]));
                *(u32x2*)((bf16_t*)(ws + O_YG) + (tk + fr) * 512 + g * 16 + 4 * q) = (u32x2){pk2(y0, y1), pk2(y2, y3)};
                asm volatile("s_waitcnt lgkmcnt(0)" ::: "memory");
            }
        }
        if (ENDS_ONLY) *(f32x2_t*)(ENDS + (((size_t)(b * NCHUNK + c) * 32 + g) * 64 + lane) * 2) = (f32x2_t){xr, xi};
    }
}

constexpr int RT = 2;
constexpr int TQ = 4 * RT * NWAVES;
constexpr int KSTR = 72;
constexpr int KV_TILE = 64 * KSTR * 2;
constexpr int IMP_STR = 132;
struct AttL { static constexpr int K0 = 0, V0 = 2 * KV_TILE, IMP = 4 * KV_TILE, SELM = IMP + NWAVES * 4 * RT * IMP_STR * 4, UNI = SELM + NWAVES * 4 * RT * 16, TOTAL = UNI + 64; };
struct AttSrc { const bf16_t* k; const bf16_t* v; int vld; };

__device__ __forceinline__ void att_load(const AttSrc& s, u32x4& kr, u32x4& vr) {
    const int tid = threadIdx.x, row = tid >> 3, ch = tid & 7;
    kr = *(const u32x4*)(s.k + (size_t)row * 64 + ch * 8);
    vr = *(const u32x4*)(s.v + (size_t)row * s.vld + ch * 8);
}
__device__ __forceinline__ void att_store(char* smem, int buf, const u32x4& kr, const u32x4& vr) {
    const int tid = threadIdx.x, row = tid >> 3, ch = tid & 7;
    *(u32x4*)((bf16_t*)(smem + AttL::K0 + buf * KV_TILE) + row * KSTR + ch * 8) = kr;
    *(u32x4*)((bf16_t*)(smem + AttL::V0 + buf * KV_TILE) + row * KSTR + ch * 8) = vr;
}

template <int MODE>
__device__ __forceinline__ void att_block(const bf16_t* Ks, const bf16_t* Vs, const bf16x8 (&qf)[RT][2], f32x4 (&acc)[RT][4], float (&l)[RT],
                                          const float (&invl)[RT], const float (&g0)[RT], const float (&base0)[RT], const int (&hi0)[RT], int wlo, bool need_mask,
                                          unsigned rtmask, float sk, float* imp_w, int blk0, int fr, int q) {
    const float NEGB = -1e30f;
#pragma unroll 1
    for (int kt = 0; kt < 2; ++kt) {
        bf16x8 kf[2][2];
#pragma unroll
        for (int ab = 0; ab < 2; ++ab)
#pragma unroll
            for (int ks = 0; ks < 2; ++ks) kf[ab][ks] = *(const bf16x8*)(Ks + (32 * kt + 16 * ab + fr) * KSTR + 32 * ks + 8 * q);
        bf16x8 vf[4];
        if (MODE != 0) {
#pragma unroll
            for (int dt = 0; dt < 4; ++dt) {
                const u32x2 lo = *(const u32x2*)(Vs + (16 * dt + fr) * KSTR + 32 * kt + 4 * q), hi = *(const u32x2*)(Vs + (16 * dt + fr) * KSTR + 32 * kt + 16 + 4 * q);
                const u32x4 vv = {lo[0], lo[1], hi[0], hi[1]};
                vf[dt] = __builtin_bit_cast(bf16x8, vv);
            }
        }
#pragma unroll
        for (int rt = 0; rt < RT; ++rt) {
            if (!((rtmask >> rt) & 1u)) continue;
            const float bl = base0[rt] + sk * (float)(32 * kt + 4 * q);
            f32x4 S[2];
#pragma unroll
            for (int ab = 0; ab < 2; ++ab) {
#pragma unroll
                for (int r = 0; r < 4; ++r) S[ab][r] = bl + sk * (float)(16 * ab + r);
                S[ab] = __builtin_amdgcn_mfma_f32_16x16x32_bf16(kf[ab][0], qf[rt][0], S[ab], 0, 0, 0);
                S[ab] = __builtin_amdgcn_mfma_f32_16x16x32_bf16(kf[ab][1], qf[rt][1], S[ab], 0, 0, 0);
            }
            if (need_mask) {
                const int hi = hi0[rt] - (32 * kt + 4 * q), lo = hi - wlo;
#pragma unroll
                for (int ab = 0; ab < 2; ++ab)
#pragma unroll
                    for (int r = 0; r < 4; ++r) { const int c = 16 * ab + r; if (c > hi || c < lo) S[ab][r] = NEGB; }
            }
            float ps = 0.f;
#pragma unroll
            for (int ab = 0; ab < 2; ++ab)
#pragma unroll
                for (int r = 0; r < 4; ++r) { S[ab][r] = __builtin_amdgcn_exp2f(S[ab][r]); ps += S[ab][r]; }
            if (MODE == 0) { l[rt] += ps; continue; }
            if (MODE == 2) l[rt] += ps;
            if (MODE == 1) {
                const float il = invl[rt];
#pragma unroll
                for (int ab = 0; ab < 2; ++ab) {
                    S[ab] = S[ab] * il;
                    float cs = (S[ab][0] + S[ab][1]) + (S[ab][2] + S[ab][3]), last = S[ab][3];
                    cs += __shfl_xor(cs, 1); cs += __shfl_xor(cs, 2); last += __shfl_xor(last, 1); last += __shfl_xor(last, 2);
                    const int blk = blk0 + 8 * kt + 4 * ab + q;
                    if ((fr & 3) == 0) { float* ip = imp_w + (4 * rt + (fr >> 2)) * IMP_STR + blk; atomicAdd(ip, cs); if (blk + 1 < 128) atomicAdd(ip + 1, last); }
                    S[ab] = S[ab] * g0[rt];
                }
            }
            const u32x4 pu = {pk2(S[0][0], S[0][1]), pk2(S[0][2], S[0][3]), pk2(S[1][0], S[1][1]), pk2(S[1][2], S[1][3])};
            const bf16x8 pf = __builtin_bit_cast(bf16x8, pu);
#pragma unroll
            for (int dt = 0; dt < 4; ++dt) acc[rt][dt] = __builtin_amdgcn_mfma_f32_16x16x32_bf16(vf[dt], pf, acc[rt][dt], 0, 0, 0);
        }
    }
}

__device__ __forceinline__ void attn_phase(const Ptrs& P, char* smem, int vb, int nvb) {
    typedef AttL L;
    unsigned char* ws = P.ws;
    const int tid = opaque_tid(), lane = tid & 63, wave = __builtin_amdgcn_readfirstlane(tid >> 6), fr = lane & 15, q = lane >> 4;
    constexpr int NQT = SEQ / TQ, TW = 4 * RT;
    float* imp_w = (float*)(smem + L::IMP) + wave * TW * IMP_STR;
    unsigned* selm_w = (unsigned*)(smem + L::SELM) + wave * TW * 4;
    unsigned* uni = (unsigned*)(smem + L::UNI);
    const float* M2 = (const float*)(ws + O_M2);
    const float LOG2E = 1.4426950408889634f;
    const float* G = (const float*)(ws + O_GATES);
    for (int it = vb; it < NB * 2 * NQT; it += nvb) {
        const int qt = NQT - 1 - (it / (NB * 2)), bg = it % (NB * 2), b = bg >> 1, g = bg & 1;
        const int qs = qt * TQ, t0 = qs + TW * wave;
        const int head = fr & 3, h = g * 4 + head;
        const float slope2 = exp2f(-(float)(h + 1)) * LOG2E;
        const bf16_t* QN = (const bf16_t*)(ws + O_QN);
        bf16x8 qf[RT][2]; int tpos[RT];
#pragma unroll
        for (int rt = 0; rt < RT; ++rt) {
            tpos[rt] = t0 + 4 * rt + (fr >> 2);
            const size_t tok = (size_t)b * SEQ + tpos[rt];
#pragma unroll
            for (int ks = 0; ks < 2; ++ks) qf[rt][ks] = *(const bf16x8*)(QN + tok * 512 + h * 64 + 32 * ks + 8 * q);
        }
        for (int i = lane; i < TW * IMP_STR; i += 64) imp_w[i] = 0.f;
        if (tid < 4) uni[tid] = 0u;
        u32x2 Yp[RT][4];
        f32x4 O[RT][4];
#pragma unroll
        for (int rt = 0; rt < RT; ++rt)
#pragma unroll
            for (int dt = 0; dt < 4; ++dt) O[rt][dt] = (f32x4){0.f, 0.f, 0.f, 0.f};
        float l[RT], invl[RT], g0[RT], base0[RT]; int hi0[RT];
#pragma unroll
        for (int rt = 0; rt < RT; ++rt) { l[rt] = 0.f; invl[rt] = 0.f; g0[rt] = G[((size_t)b * SEQ + tpos[rt]) * 24 + h]; }
        u32x4 kr, vr;
        __syncthreads();
        {
            const int jm_tile = (qs + TQ - 1 - 31) >> 4;
            const int nkb = (jm_tile >> 6) + 1;
            const int jm_lo = (t0 - 31) >> 4, jm_hi = (t0 + TW - 1 - 31) >> 4;
            const float m2 = M2[0];
            const bf16_t* KC = (const bf16_t*)(ws + O_KC) + (size_t)bg * 512 * 64;
            const bf16_t* VCT = (const bf16_t*)(ws + O_VCT) + (size_t)bg * 64 * 512;
            int jmax[RT];
#pragma unroll
            for (int rt = 0; rt < RT; ++rt) jmax[rt] = (tpos[rt] - 31) >> 4;
#pragma unroll 1
            for (int pass = 0; pass < 2; ++pass) {
                { AttSrc s0{KC, VCT, 512}; att_load(s0, kr, vr); att_store(smem, 0, kr, vr); }
                __syncthreads();
#pragma unroll 1
                for (int kb = 0; kb < nkb; ++kb) {
                    if (kb + 1 < nkb) { AttSrc s1{KC + (size_t)(kb + 1) * 64 * 64, VCT + (kb + 1) * 64, 512}; att_load(s1, kr, vr); }
                    if (64 * kb <= jm_hi) {
                        const bool need_mask = (64 * kb + 63 > jm_lo);
#pragma unroll
                        for (int rt = 0; rt < RT; ++rt) { base0[rt] = -m2 - slope2 * (float)(tpos[rt] - 31 - 1024 * kb); hi0[rt] = jmax[rt] - 64 * kb; }
                        const bf16_t* Ks = (const bf16_t*)(smem + L::K0 + (kb & 1) * KV_TILE); const bf16_t* Vs = (const bf16_t*)(smem + L::V0 + (kb & 1) * KV_TILE);
                        if (pass == 0) att_block<0>(Ks, Vs, qf, O, l, invl, g0, base0, hi0, 1 << 28, need_mask, (1u << RT) - 1u, slope2 * 16.f, imp_w, 16 * kb, fr, q);
                        else att_block<1>(Ks, Vs, qf, O, l, invl, g0, base0, hi0, 1 << 28, need_mask, (1u << RT) - 1u, slope2 * 16.f, imp_w, 16 * kb, fr, q);
                    }
                    if (kb + 1 < nkb) att_store(smem, (kb + 1) & 1, kr, vr);
                    __syncthreads();
                }
                if (pass == 0) {
#pragma unroll
                    for (int rt = 0; rt < RT; ++rt) { float s = l[rt]; s += __shfl_xor(s, 16); s += __shfl_xor(s, 32); invl[rt] = s > 0.f ? 1.0f / s : 0.f; l[rt] = 0.f; }
                }
            }
#pragma unroll
            for (int rt = 0; rt < RT; ++rt)
#pragma unroll
                for (int dt = 0; dt < 4; ++dt) { Yp[rt][dt] = pk4(O[rt][dt]); O[rt][dt] = (f32x4){0.f, 0.f, 0.f, 0.f}; }
        }
        {
            asm volatile("s_waitcnt lgkmcnt(0)" ::: "memory");
            const int tl = lane >> 3, part = lane & 7, t = t0 + tl, cur = t >> 6;
            float* my = imp_w + tl * IMP_STR + 16 * part;
#pragma unroll 4
            for (int i = 0; i < 16; ++i) { const int blk = 16 * part + i; const float v = my[i];
                const bool valid = blk <= cur, forced = (blk == 0) || (blk == cur) || (blk == cur - 1);
                my[i] = valid ? (v + (forced ? 1e4f : 0.f)) : -1e30f; }
            asm volatile("s_waitcnt lgkmcnt(0)" ::: "memory");
            unsigned m0 = 0u, m1 = 0u, m2_ = 0u, m3 = 0u;
#pragma unroll 1
            for (int r = 0; r < 16; ++r) {
                float bv = -3.4e38f; int bi = 0;
#pragma unroll
                for (int i4 = 0; i4 < 4; ++i4) { const f32x4 v = *(const f32x4*)(my + 4 * i4);
#pragma unroll
                    for (int c = 0; c < 4; ++c) if (v[c] > bv) { bv = v[c]; bi = 16 * part + 4 * i4 + c; } }
#pragma unroll
                for (int o = 1; o < 8; o <<= 1) { const float ov = __shfl_xor(bv, o); const int oi = __shfl_xor(bi, o); if (ov > bv || (ov == bv && oi < bi)) { bv = ov; bi = oi; } }
                if ((bi >> 4) == part) imp_w[tl * IMP_STR + bi] = -3.0e38f;
                const unsigned bit = 1u << (bi & 31); const int wd = bi >> 5;
                m0 |= (wd == 0) ? bit : 0u; m1 |= (wd == 1) ? bit : 0u; m2_ |= (wd == 2) ? bit : 0u; m3 |= (wd == 3) ? bit : 0u;
                asm volatile("s_waitcnt lgkmcnt(0)" ::: "memory");
            }
            if (part == 0) { selm_w[tl * 4 + 0] = m0; selm_w[tl * 4 + 1] = m1; selm_w[tl * 4 + 2] = m2_; selm_w[tl * 4 + 3] = m3; }
#pragma unroll
            for (int o = 8; o < 64; o <<= 1) { m0 |= __shfl_xor(m0, o); m1 |= __shfl_xor(m1, o); m2_ |= __shfl_xor(m2_, o); m3 |= __shfl_xor(m3, o); }
            if (lane == 0) { atomicOr(uni + 0, m0); atomicOr(uni + 1, m1); atomicOr(uni + 2, m2_); atomicOr(uni + 3, m3); }
            __syncthreads();
            const unsigned wu0 = __builtin_amdgcn_readfirstlane(m0), wu1 = __builtin_amdgcn_readfirstlane(m1), wu2 = __builtin_amdgcn_readfirstlane(m2_), wu3 = __builtin_amdgcn_readfirstlane(m3);
            const unsigned bu0 = __builtin_amdgcn_readfirstlane(uni[0]), bu1 = __builtin_amdgcn_readfirstlane(uni[1]), bu2 = __builtin_amdgcn_readfirstlane(uni[2]), bu3 = __builtin_amdgcn_readfirstlane(uni[3]);
            const float m2s = M2[1];
            const bf16_t* KS = (const bf16_t*)(ws + O_KS) + (size_t)bg * SEQ * 64;
            const bf16_t* VST = (const bf16_t*)(ws + O_VST) + (size_t)bg * 64 * SEQ;
            const int nsel = __popc(bu0) + __popc(bu1) + __popc(bu2) + __popc(bu3);
            int cw = 0; unsigned cbits = bu0;
#define NEXT_BLK(dst) do { while (cbits == 0u) { ++cw; cbits = (cw == 1) ? bu1 : (cw == 2) ? bu2 : bu3; } const int bpos_ = __ffs(cbits) - 1; cbits &= cbits - 1u; dst = cw * 32 + bpos_; } while (0)
            int blk_cur = 0, blk_nxt = 0;
            if (nsel > 0) {
                NEXT_BLK(blk_cur);
                { AttSrc s0{KS + (size_t)blk_cur * 64 * 64, VST + blk_cur * 64, SEQ}; att_load(s0, kr, vr); att_store(smem, 0, kr, vr); }
                __syncthreads();
#pragma unroll 1
                for (int i = 0; i < nsel; ++i) {
                    if (i + 1 < nsel) { NEXT_BLK(blk_nxt); AttSrc s1{KS + (size_t)blk_nxt * 64 * 64, VST + blk_nxt * 64, SEQ}; att_load(s1, kr, vr); }
                    const int blk = blk_cur, kb0 = 64 * blk;
                    const unsigned wword = (blk < 32) ? wu0 : (blk < 64) ? wu1 : (blk < 96) ? wu2 : wu3;
                    if (((wword >> (blk & 31)) & 1u) && kb0 <= t0 + TW - 1) {
                        const bool need_mask = (kb0 + 63 > t0);
                        unsigned rtmask = 0u;
#pragma unroll
                        for (int rt = 0; rt < RT; ++rt) {
                            const unsigned w_ = selm_w[(4 * rt + (fr >> 2)) * 4 + (blk >> 5)];
                            const bool sel = (w_ >> (blk & 31)) & 1u;
                            base0[rt] = sel ? (-m2s - slope2 * (float)(tpos[rt] - kb0)) : -1e30f;
                            hi0[rt] = tpos[rt] - kb0;
                            if (__ballot(sel) != 0ull) rtmask |= 1u << rt;
                        }
                        rtmask = __builtin_amdgcn_readfirstlane(rtmask);
                        const bf16_t* Ks = (const bf16_t*)(smem + L::K0 + (i & 1) * KV_TILE); const bf16_t* Vs = (const bf16_t*)(smem + L::V0 + (i & 1) * KV_TILE);
                        att_block<2>(Ks, Vs, qf, O, l, invl, g0, base0, hi0, 1 << 28, need_mask, rtmask, slope2, imp_w, 0, fr, q);
                    }
                    if (i + 1 < nsel) att_store(smem, (i + 1) & 1, kr, vr);
                    blk_cur = blk_nxt;
                    __syncthreads();
                }
            }
#undef NEXT_BLK
#pragma unroll
            for (int rt = 0; rt < RT; ++rt) {
                float s = l[rt]; s += __shfl_xor(s, 16); s += __shfl_xor(s, 32);
                const float cf = (s > 0.f) ? G[((size_t)b * SEQ + tpos[rt]) * 24 + 8 + h] / s : 0.f; l[rt] = 0.f;
#pragma unroll
                for (int dt = 0; dt < 4; ++dt) { const u32x2 yp = Yp[rt][dt]; const f32x4 yv = {bflo(yp[0]), bfhi(yp[0]), bflo(yp[1]), bfhi(yp[1])};
                    Yp[rt][dt] = pk4(yv + O[rt][dt] * cf); O[rt][dt] = (f32x4){0.f, 0.f, 0.f, 0.f}; }
            }
        }
        {
            const float m2w = M2[2];
            const bf16_t* KW = (const bf16_t*)(ws + O_KW) + (size_t)bg * SEQ * 64;
            const bf16_t* VWT = (const bf16_t*)(ws + O_VWT) + (size_t)bg * 64 * SEQ;
            const int wlast = (qs + TQ - 1) >> 6; int wfirst = (qs - 511) >> 6; if (wfirst < 0) wfirst = 0;
            const int nwb = wlast - wfirst + 1;
            { AttSrc s0{KW + (size_t)wfirst * 64 * 64, VWT + wfirst * 64, SEQ}; att_load(s0, kr, vr); att_store(smem, 0, kr, vr); }
            __syncthreads();
#pragma unroll 1
            for (int i = 0; i < nwb; ++i) {
                const int wb = wfirst + i, kb0 = 64 * wb;
                if (i + 1 < nwb) { AttSrc s1{KW + (size_t)(wb + 1) * 64 * 64, VWT + (wb + 1) * 64, SEQ}; att_load(s1, kr, vr); }
                if (kb0 <= t0 + TW - 1 && kb0 + 63 >= t0 - 511) {
                    const bool need_mask = !(kb0 + 63 <= t0 && kb0 >= t0 + TW - 1 - 511);
#pragma unroll
                    for (int rt = 0; rt < RT; ++rt) { base0[rt] = -m2w - slope2 * (float)(tpos[rt] - kb0); hi0[rt] = tpos[rt] - kb0; }
                    const bf16_t* Ks = (const bf16_t*)(smem + L::K0 + (i & 1) * KV_TILE); const bf16_t* Vs = (const bf16_t*)(smem + L::V0 + (i & 1) * KV_TILE);
                    att_block<2>(Ks, Vs, qf, O, l, invl, g0, base0, hi0, 511, need_mask, (1u << RT) - 1u, slope2, imp_w, 0, fr, q);
                }
                if (i + 1 < nwb) att_store(smem, (i + 1) & 1, kr, vr);
                __syncthreads();
            }
        }
        bf16_t* YN = (bf16_t*)(ws + O_YNSA);
#pragma unroll
        for (int rt = 0; rt < RT; ++rt) {
            float s = l[rt]; s += __shfl_xor(s, 16); s += __shfl_xor(s, 32);
            const size_t tok = (size_t)b * SEQ + tpos[rt];
            const float cf = (s > 0.f) ? G[tok * 24 + 16 + h] / s : 0.f;
#pragma unroll
            for (int dt = 0; dt < 4; ++dt) { const u32x2 yp = Yp[rt][dt]; const f32x4 yv = {bflo(yp[0]), bfhi(yp[0]), bflo(yp[1]), bfhi(yp[1])};
                *(u32x2*)(YN + tok * 512 + h * 64 + 16 * dt + 4 * q) = pk4(yv + O[rt][dt] * cf); }
        }
        __syncthreads();
    }
}

constexpr int SMEM_BYTES = 128 * 1024;
static_assert(AttL::TOTAL <= SMEM_BYTES && NWAVES * S5_WAVE_LDS <= SMEM_BYTES && pg8::STAGE_BYTES <= SMEM_BYTES, "LDS budget");

__global__ void __launch_bounds__(NTHR) k_mega(Ptrs P, TrTable tt) {
    extern __shared__ __attribute__((aligned(16))) char smem[];
    cg::grid_group grid = cg::this_grid();
    const int vb = blockIdx.x, nvb = gridDim.x;
    unsigned char* ws = P.ws;
    transpose_phase(tt, smem, vb, nvb);
    consts_phase(P, vb, nvb);
    rmsnorm1_phase(P, vb, nvb);
    grid.sync();
    { pg8::EpiIn E{ws, P.in[19], P.in[20]}; big_gemm(smem, (const bf16_t*)(ws + O_XN), (const bf16_t*)(ws + O_WT_IN), NTOK, NIN, DM, E);
      if (PROBE_REP & 1) big_gemm(smem, (const bf16_t*)(ws + O_XN), (const bf16_t*)(ws + O_WT_IN), NTOK, NIN, DM, E); }
    grid.sync();
    compress_phase(P, smem, vb, nvb);
    s5_phase<true>(P, smem, nvb - 1 - vb, nvb);
    grid.sync();
    attn_phase(P, smem, vb, nvb);
    if (PROBE_REP & 2) attn_phase(P, smem, vb, nvb);
    s5_phase<false>(P, smem, vb, nvb);
    if (PROBE_REP & 4) s5_phase<false>(P, smem, vb, nvb);
    grid.sync();
    { pg8::EpiGlu E{(const bf16_t*)(ws + O_YG), (bf16_t*)(ws + O_YSSM), P.in[12]}; big_gemm(smem, (const bf16_t*)(ws + O_YG), (const bf16_t*)(ws + O_WT_GLU), NTOK, 512, 512, E); }
    grid.sync();
    { pg8::EpiMerge<0> E0{(const bf16_t*)(ws + O_MG), (bf16_t*)(ws + O_MERGED)}; big_gemm(smem, (const bf16_t*)(ws + O_YSSM), (const bf16_t*)(ws + O_WT_PS), NTOK, 1024, 512, E0);
      pg8::EpiMerge<1> E1{(const bf16_t*)(ws + O_MG), (bf16_t*)(ws + O_MERGED)}; big_gemm(smem, (const bf16_t*)(ws + O_YNSA), (const bf16_t*)(ws + O_WT_PN), NTOK, 1024, 512, E1); }
    grid.sync();
    { pg8::EpiOut E{P.in[0], P.out, (bf16_t*)(ws + O_X1B), (float*)(ws + O_SSQ)}; big_gemm(smem, (const bf16_t*)(ws + O_MERGED), (const bf16_t*)(ws + O_WT_OUT), NTOK, 1024, 1024, E); }
    grid.sync();
    { pg8::EpiUp E{(bf16_t*)(ws + O_FF), (const float*)(ws + O_SSQ)}; big_gemm(smem, (const bf16_t*)(ws + O_X1B), (const bf16_t*)(ws + O_WT_UP), NTOK, DFF, DM, E);
      if (PROBE_REP & 32) big_gemm(smem, (const bf16_t*)(ws + O_X1B), (const bf16_t*)(ws + O_WT_UP), NTOK, DFF, DM, E); }
    grid.sync();
    { pg8::EpiDown E{P.out}; big_gemm(smem, (const bf16_t*)(ws + O_FF), (const bf16_t*)(ws + O_WT_DOWN), NTOK, DM, DFF, E); }
}

static void add_tr(TrTable& tt, int& n, const float* src, bf16_t* dst, const float* kscale, int K, int N, int ldsrc, int mode) {
    TrDesc& d = tt.d[n]; d.src = src; d.dst = dst; d.kscale = kscale; d.K = K; d.N = N; d.ldsrc = ldsrc; d.mode = mode; d.tiles_n = N / 64; d.tile0 = tt.total;
    tt.total += (K / 64) * (N / 64); ++n;
}

extern "C" void kernel_launch(void* const* d_in, const int* in_sizes, int n_in, void* d_out, int out_size, void* d_ws, size_t ws_size, hipStream_t stream) {
    if (n_in != 27 || ws_size < WS_END) { fprintf(stderr, "kernel_launch: unexpected n_in %d or ws_size %zu (need %zu)\n", n_in, ws_size, (size_t)WS_END); return; }
    Ptrs P{};
    for (int i = 0; i < 27; ++i) P.in[i] = (const float*)d_in[i];
    P.out = (float*)d_out; P.ws = (unsigned char*)d_ws;
    unsigned char* ws = P.ws;
    TrTable tt{}; int n = 0;
    add_tr(tt, n, P.in[2], (bf16_t*)(ws + O_WT_IN), nullptr, 1024, NIN, 3864, 1);
    add_tr(tt, n, P.in[11], (bf16_t*)(ws + O_WT_GLU), nullptr, 512, 512, 512, 0);
    add_tr(tt, n, P.in[21], (bf16_t*)(ws + O_WT_PS), nullptr, 512, 1024, 1024, 0);
    add_tr(tt, n, P.in[22], (bf16_t*)(ws + O_WT_PN), nullptr, 512, 1024, 1024, 0);
    add_tr(tt, n, P.in[23], (bf16_t*)(ws + O_WT_OUT), nullptr, 1024, 1024, 1024, 0);
    add_tr(tt, n, P.in[25], (bf16_t*)(ws + O_WT_UP), P.in[24], 1024, 4096, 4096, 0);
    add_tr(tt, n, P.in[26], (bf16_t*)(ws + O_WT_DOWN), nullptr, 4096, 1024, 1024, 0);
    add_tr(tt, n, P.in[15], (bf16_t*)(ws + O_WT_CK1), nullptr, 2048, 128, 128, 0);
    add_tr(tt, n, P.in[17], (bf16_t*)(ws + O_WT_CV1), nullptr, 2048, 128, 128, 0);
    add_tr(tt, n, P.in[16], (bf16_t*)(ws + O_WT_CK2), nullptr, 128, 64, 64, 0);
    add_tr(tt, n, P.in[18], (bf16_t*)(ws + O_WT_CV2), nullptr, 128, 64, 64, 0);
    static int grid_blocks = 0;
    if (!grid_blocks) {
        int dev = 0, cus = 0, per_cu = 0;
        (void)hipGetDevice(&dev);
        (void)hipDeviceGetAttribute(&cus, hipDeviceAttributeMultiprocessorCount, dev);
        (void)hipFuncSetAttribute((const void*)k_mega, hipFuncAttributeMaxDynamicSharedMemorySize, SMEM_BYTES);
        (void)hipOccupancyMaxActiveBlocksPerMultiprocessor(&per_cu, k_mega, NTHR, SMEM_BYTES);
        if (per_cu < 1) { fprintf(stderr, "kernel_launch: occupancy query returned %d\n", per_cu); per_cu = 1; }
        grid_blocks = cus;
    }
    void* args[] = {(void*)&P, (void*)&tt};
    hipError_t e = hipLaunchCooperativeKernel((void*)k_mega, dim3(grid_blocks), dim3(NTHR), args, SMEM_BYTES, stream);
    if (e != hipSuccess) fprintf(stderr, "cooperative launch failed: %s (grid %d)\n", hipGetErrorString(e), grid_blocks);
}
```

```cpp
#include <hip/hip_runtime.h>
#include <hip/hip_cooperative_groups.h>
#include <cstdio>
#include <cstdint>
namespace cg = cooperative_groups;

typedef unsigned short bf16_t;
typedef short bf16x8 __attribute__((ext_vector_type(8)));
typedef float f32x4 __attribute__((ext_vector_type(4)));
typedef unsigned u32x4 __attribute__((ext_vector_type(4)));
typedef unsigned u32x2 __attribute__((ext_vector_type(2)));

#ifndef PROBE_REP
#define PROBE_REP 0
#endif

constexpr int NB = 4, SEQ = 8192, DM = 1024, NTOK = NB * SEQ;
constexpr int NIN = 4096;
constexpr int DFF = 4096;
constexpr int CHUNK = 128, NCHUNK = SEQ / CHUNK;
constexpr float EPS = 1e-6f;
constexpr int NWAVES = 8, NTHR = 512;
constexpr float C1 = 0.18033688011112042f;

constexpr size_t MiB = 1024 * 1024;
constexpr size_t al256(size_t x) { return (x + 255) & ~(size_t)255; }
constexpr size_t O_WT_IN = 0;
constexpr size_t O_WT_GLU = O_WT_IN + (size_t)NIN * 1024 * 2;
constexpr size_t O_WT_PS = O_WT_GLU + 512 * 512 * 2;
constexpr size_t O_WT_PN = O_WT_PS + 1024 * 512 * 2;
constexpr size_t O_WT_OUT = O_WT_PN + 1024 * 512 * 2;
constexpr size_t O_WT_UP = O_WT_OUT + 1024 * 1024 * 2;
constexpr size_t O_WT_DOWN = O_WT_UP + (size_t)4096 * 1024 * 2;
constexpr size_t O_WT_CK1 = O_WT_DOWN + (size_t)4096 * 1024 * 2;
constexpr size_t O_WT_CV1 = O_WT_CK1 + 128 * 2048 * 2;
constexpr size_t O_WT_CK2 = O_WT_CV1 + 128 * 2048 * 2;
constexpr size_t O_WT_CV2 = O_WT_CK2 + 64 * 128 * 2;
constexpr size_t O_B1K = O_WT_CV2 + 64 * 128 * 2;
constexpr size_t O_B1V = O_B1K + 512;
constexpr size_t O_ABAR = O_B1V + 512;
constexpr size_t O_AL = O_ABAR + 32 * 64 * 2 * 4;
constexpr size_t O_BBT = O_AL + 32 * 64 * 2 * 4;
constexpr size_t O_CT = O_BBT + 32 * 128 * 16 * 2;
constexpr size_t O_ENDS = O_CT + 32 * 16 * 128 * 2;
constexpr size_t O_SSQ = O_ENDS + (size_t)NB * NCHUNK * 32 * 64 * 2 * 4;
constexpr size_t O_GATES = O_SSQ + (size_t)NTOK * 4;
constexpr size_t O_KC = O_GATES + (size_t)NTOK * 24 * 4;
constexpr size_t O_VCT = O_KC + 8 * 512 * 64 * 2;
constexpr size_t O_M2 = O_VCT + 8 * 512 * 64 * 2;
constexpr size_t O_BAR = O_M2 + 4096;
constexpr size_t O_REGA = al256(O_BAR + 16384);
constexpr size_t O_XN = O_REGA;
constexpr size_t O_YSSM = O_XN;
constexpr size_t O_YNSA = O_XN + 32 * MiB;
constexpr size_t O_U = O_XN + 64 * MiB;
constexpr size_t O_QN = O_U + 32 * MiB;
constexpr size_t O_KCIN = O_QN + 32 * MiB;
constexpr size_t O_VCIN = O_KCIN + 8 * MiB;
constexpr size_t O_KS = O_VCIN + 8 * MiB;
constexpr size_t O_KW = O_KS + 8 * MiB;
constexpr size_t O_YG = O_KW + 8 * MiB;
constexpr size_t O_VST = O_YG + 32 * MiB;
constexpr size_t O_VWT = O_VST + 8 * MiB;
constexpr size_t O_FF = O_REGA;
constexpr size_t O_REGB = O_REGA + 256 * MiB;
constexpr size_t O_MG = O_REGB;
constexpr size_t O_X1B = O_REGB;
constexpr size_t O_MERGED = O_REGB + 128 * MiB;
constexpr size_t WS_END = O_MERGED + 64 * MiB;
static_assert(O_VWT + 8 * MiB <= O_REGB, "region A overflow");

__device__ __forceinline__ float bf2f(bf16_t h) { return __uint_as_float(((unsigned)h) << 16); }
__device__ __forceinline__ float bflo(unsigned w) { return __uint_as_float(w << 16); }
__device__ __forceinline__ float bfhi(unsigned w) { return __uint_as_float(w & 0xffff0000u); }
__device__ __forceinline__ bf16_t f2bf(float f) { unsigned u = __float_as_uint(f); u += 0x7fffu + ((u >> 16) & 1u); return (bf16_t)(u >> 16); }
typedef __bf16 bf16x2_t __attribute__((ext_vector_type(2)));
typedef float f32x2_t __attribute__((ext_vector_type(2)));
__device__ __forceinline__ unsigned pk2(float lo, float hi) { const f32x2_t f = {lo, hi}; const bf16x2_t v = __builtin_convertvector(f, bf16x2_t); return __builtin_bit_cast(unsigned, v); }
__device__ __forceinline__ u32x2 pk4(const f32x4 v) { return (u32x2){pk2(v[0], v[1]), pk2(v[2], v[3])}; }
__device__ __forceinline__ float sigmoidf_(float x) { return 1.0f / (1.0f + __expf(-x)); }
__device__ __forceinline__ float gelu_tanh(float x) { const float u = 0.7978845608028654f * (x + 0.044715f * x * x * x); return 0.5f * x * (1.0f + tanhf(u)); }
__device__ __forceinline__ float wave_sum(float v) {
#pragma unroll
    for (int o = 1; o < 64; o <<= 1) v += __shfl_xor(v, o);
    return v;
}

__device__ __forceinline__ int opaque_tid() { int t = threadIdx.x; asm volatile("" : "+v"(t)); return t; }

struct Ptrs {
    const float* in[27];
    float* out;
    unsigned char* ws;
};

struct TrDesc { const float* src; bf16_t* dst; const float* kscale; int K, N, ldsrc, mode, tiles_n, tile0; };
constexpr int NTR = 11;
struct TrTable { TrDesc d[NTR]; int total; int pad; };

__device__ __forceinline__ int in_col(int n) {
    const int T = n >> 8, p = n & 255, bj = p >> 7, wc = (p >> 5) & 3, dlo = p & 31;
    const int L = 64 * (4 * T + wc) + 32 * bj + dlo;
    if (L < 1792) return L;
    if (L < 3840) return L + 24;
    if (L < 3864) return L - 3840 + 1792;
    return -1;
}

__device__ __forceinline__ void transpose_phase(const TrTable& tt, char* smem, int vb, int nvb) {
    float* tile = (float*)smem;
    const int tid = opaque_tid();
    for (int it = vb; it < tt.total; it += nvb) {
        int di = 0;
#pragma unroll
        for (int i = 1; i < NTR; ++i) if (it >= tt.d[i].tile0) di = i;
        const TrDesc& d = tt.d[di];
        const int lt = it - d.tile0, tn = lt % d.tiles_n, tk = lt / d.tiles_n, k0 = tk * 64, n0 = tn * 64;
#pragma unroll 4
        for (int i = 0; i < 8; ++i) {
            const int kk = (tid >> 6) + 8 * i, nn = tid & 63;
            int col = n0 + nn; if (d.mode == 1) col = in_col(col);
            float v = 0.f;
            if (col >= 0) v = d.src[(size_t)(k0 + kk) * d.ldsrc + col];
            if (d.kscale) v *= d.kscale[k0 + kk];
            tile[kk * 65 + nn] = v;
        }
        __syncthreads();
#pragma unroll 4
        for (int i = 0; i < 8; ++i) {
            const int nn = (tid >> 6) + 8 * i, kk = tid & 63;
            d.dst[(size_t)(n0 + nn) * d.K + k0 + kk] = f2bf(tile[kk * 65 + nn]);
        }
        __syncthreads();
    }
}

__device__ __forceinline__ void consts_phase(const Ptrs& P, int vb, int nvb) {
    const int tid_ = opaque_tid(); const int gt = vb * NTHR + tid_, ngt = nvb * NTHR;
    unsigned char* ws = P.ws;
    for (int i = gt; i < 32 * 64; i += ngt) {
        const int g = i >> 6, p = i & 63;
        const double ar = (double)P.in[3][i], ai = (double)P.in[4][i], dt = exp((double)P.in[5][g]);
        const double mag = exp(ar * dt), abr = mag * cos(ai * dt), abi = mag * sin(ai * dt);
        const double den = ar * ar + ai * ai, nr = abr - 1.0;
        const double fr = (nr * ar + abi * ai) / den, fi = (abi * ar - nr * ai) / den;
        float* ABAR = (float*)(ws + O_ABAR); float* AL = (float*)(ws + O_AL);
        ABAR[i * 2] = (float)abr; ABAR[i * 2 + 1] = (float)abi;
        double pr = abr, pi = abi;
        for (int s = 0; s < 7; ++s) { const double nr2 = pr * pr - pi * pi, ni2 = 2.0 * pr * pi; pr = nr2; pi = ni2; }
        AL[i * 2] = (float)pr; AL[i * 2 + 1] = (float)pi;
        bf16_t* BBT = (bf16_t*)(ws + O_BBT);
        for (int c = 0; c < 16; ++c) {
            const double br = (double)P.in[6][(size_t)i * 16 + c], bi = (double)P.in[7][(size_t)i * 16 + c];
            BBT[((size_t)g * 128 + p) * 16 + c] = f2bf((float)(fr * br - fi * bi));
            BBT[((size_t)g * 128 + 64 + p) * 16 + c] = f2bf((float)(fr * bi + fi * br));
        }
        bf16_t* CT = (bf16_t*)(ws + O_CT);
        for (int c = 0; c < 16; ++c) {
            CT[((size_t)g * 16 + c) * 128 + p] = f2bf(P.in[8][((size_t)g * 16 + c) * 64 + p]);
            CT[((size_t)g * 16 + c) * 128 + 64 + p] = f2bf(-P.in[9][((size_t)g * 16 + c) * 64 + p]);
        }
    }
    {
        const int lane = tid_ & 63, gw = vb * NWAVES + (tid_ >> 6), ngw = nvb * NWAVES;
        for (int i = gw; i < 256; i += ngw) {
            const int n = i & 127; const bool isv = i >= 128;
            const float* pe = P.in[isv ? 14 : 13]; const float* w1 = P.in[isv ? 17 : 15];
            float s = 0.f;
            for (int k = lane; k < 2048; k += 64) s += pe[k] * w1[(size_t)k * 128 + n];
            s = wave_sum(s);
            if (lane == 0) ((float*)(ws + (isv ? O_B1V : O_B1K)))[n] = s;
        }
    }
    if (gt < 3) {
        float gq = 0.f, gk = 0.f;
        for (int d = 0; d < 64; ++d) { gq = fmaxf(gq, fabsf(P.in[19][d])); gk = fmaxf(gk, fabsf(P.in[20][gt * 64 + d])); }
        ((float*)(ws + O_M2))[gt] = 64.0f * C1 * gq * gk;
    }
    float* SSQ = (float*)(ws + O_SSQ);
    for (int i = gt; i < NTOK; i += ngt) SSQ[i] = 0.f;
}

__device__ __forceinline__ void rmsnorm1_phase(const Ptrs& P, int vb, int nvb) {
    const int tid_ = opaque_tid(); const int lane = tid_ & 63, gw = vb * NWAVES + (tid_ >> 6), ngw = nvb * NWAVES;
    const float* x = P.in[0]; const float* g = P.in[1]; bf16_t* XN = (bf16_t*)(P.ws + O_XN);
    for (int row = gw; row < NTOK; row += ngw) {
        const f32x4* xr = (const f32x4*)(x + (size_t)row * DM);
        f32x4 v[4]; float ss = 0.f;
#pragma unroll
        for (int j = 0; j < 4; ++j) { v[j] = xr[j * 64 + lane]; ss += v[j][0] * v[j][0] + v[j][1] * v[j][1] + v[j][2] * v[j][2] + v[j][3] * v[j][3]; }
        ss = wave_sum(ss);
        const float rstd = rsqrtf(ss * (1.0f / DM) + EPS);
#pragma unroll
        for (int j = 0; j < 4; ++j) {
            const f32x4 gg = ((const f32x4*)g)[j * 64 + lane];
            ((u32x2*)(XN + (size_t)row * DM))[j * 64 + lane] = pk4(v[j] * gg * rstd);
        }
    }
}

namespace pg8 {
#define PG8_LAS __attribute__((address_space(3)))
typedef unsigned short bf16_t;
typedef short bf16x8 __attribute__((ext_vector_type(8)));
typedef float f32x4 __attribute__((ext_vector_type(4)));
typedef unsigned u32x4 __attribute__((ext_vector_type(4)));
constexpr int BM = 256, BK = 64, HALF = 128, HTB = HALF * BK * 2  , STAGE_BYTES = 8 * HTB, NXCD = 8, WGM = 8;

__host__ __device__ __forceinline__ int lds_byte(int r, int c) { const int st = (r >> 4) * 2 + (c >> 5), rr = r & 15, cc = c & 31, ob = rr * 64 + cc * 2; return st * 1024 + (ob ^ (((ob >> 9) & 1) << 5)); }
__host__ __device__ __forceinline__ void stage_rc(int b, int& R, int& C) { const int st = b / 1024, sb = b % 1024, swz = sb ^ (((sb >> 9) & 1) << 5); R = (st >> 1) * 16 + swz / 64; C = (st & 1) * 32 + (swz % 64) / 2; }
__host__ __device__ __forceinline__ int perm32(int rho) { const int n = rho >> 4, i = rho & 15; return 8 * (i >> 2) + 4 * n + (i & 3); }

struct Unit { int pm, pn; };
struct Gemm { const bf16_t* A; const bf16_t* Bt; int M, N, K; };

struct StaticOrder {
    int nM, nN, nwg, G, c;
    __host__ __device__ void init(int M, int N, int G_, int c_) { nM = M / BM; nN = N / BM; nwg = nM * nN; G = G_; c = c_; }
    __host__ __device__ bool next(int i, Unit& u) const {
        const long L = (long)i * G + c; if (L >= nwg) return false;
        int wgid = (int)L; { const int q = nwg / NXCD, r = nwg % NXCD, xcd = wgid % NXCD, off = wgid / NXCD; wgid = (xcd < r ? xcd * (q + 1) : r * (q + 1) + (xcd - r) * q) + off; }
        const int nig = WGM * nN, gid = wgid / nig, fm = gid * WGM, gsz = (nM - fm) < WGM ? (nM - fm) : WGM;
        u.pm = fm + ((wgid % nig) % gsz); u.pn = (wgid % nig) / gsz; return true;
    }
    __device__ __forceinline__ void a_ready(const Unit&) const {}
    __device__ __forceinline__ void done(const Unit&) const {}
};
__device__ __forceinline__ float pg_row_ssq(const f32x4 (&acc)[2][2][4][2], int ai, int m) {
    float s = 0.f;
#pragma unroll
    for (int bj = 0; bj < 2; ++bj)
#pragma unroll
        for (int n = 0; n < 2; ++n) { const f32x4 v = acc[ai][bj][m][n]; s += (v[0] * v[0] + v[1] * v[1]) + (v[2] * v[2] + v[3] * v[3]); }
    s += __shfl_xor(s, 16); s += __shfl_xor(s, 32);
    return s;
}
struct EpiIn {
    static constexpr bool PERM = false, AFTER_DRAIN = false;
    unsigned char* ws; const float* gq; const float* gk;
    __device__ __forceinline__ void operator()(const f32x4 (&acc)[2][2][4][2], const Unit& u, int wr, int wc, int fr, int fq) const {
        const int seg = 4 * u.pn + wc, L0 = 64 * seg, row0 = u.pm * BM + wr * 64 + fr;
        if (L0 < 512) {
            ::bf16_t* U = (::bf16_t*)(ws + O_U);
#pragma unroll
            for (int ai = 0; ai < 2; ++ai)
#pragma unroll
                for (int m = 0; m < 4; ++m) { ::bf16_t* rp = U + (size_t)(row0 + ai * HALF + m * 16) * 512 + L0 + 4 * fq;
#pragma unroll
                    for (int bj = 0; bj < 2; ++bj)
#pragma unroll
                        for (int n = 0; n < 2; ++n) *(::u32x2*)(rp + 32 * bj + 16 * n) = pk4(acc[ai][bj][m][n]); }
        } else if (L0 < 1024) {
            ::bf16_t* QN = (::bf16_t*)(ws + O_QN);
#pragma unroll
            for (int ai = 0; ai < 2; ++ai)
#pragma unroll
                for (int m = 0; m < 4; ++m) { const float rs = rsqrtf(pg_row_ssq(acc, ai, m) * (1.0f / 64) + EPS) * C1;
                    ::bf16_t* rp = QN + (size_t)(row0 + ai * HALF + m * 16) * 512 + (L0 - 512) + 4 * fq;
#pragma unroll
                    for (int bj = 0; bj < 2; ++bj)
#pragma unroll
                        for (int n = 0; n < 2; ++n) { const f32x4 gg = *(const f32x4*)(gq + 32 * bj + 16 * n + 4 * fq); *(::u32x2*)(rp + 32 * bj + 16 * n) = pk4(acc[ai][bj][m][n] * gg * rs); } }
        } else if (L0 < 1792) {
            const int idx = (L0 - 1024) >> 6, br = idx >> 2, isv = (idx >> 1) & 1, g = idx & 1;
            if (!isv || br == 0) {
                ::bf16_t* dst = (::bf16_t*)(ws + (br == 0 ? (isv ? O_VCIN : O_KCIN) : (br == 1 ? O_KS : O_KW)));
                const bool donorm = br > 0; const float* gkk = gk + br * 64;
#pragma unroll
                for (int ai = 0; ai < 2; ++ai)
#pragma unroll
                    for (int m = 0; m < 4; ++m) { const int r = row0 + ai * HALF + m * 16, b = r >> 13, s = r & 8191;
                        float rs = 1.f; if (donorm) rs = rsqrtf(pg_row_ssq(acc, ai, m) * (1.0f / 64) + EPS);
                        ::bf16_t* rp = dst + ((size_t)(b * 2 + g) * SEQ + s) * 64 + 4 * fq;
#pragma unroll
                        for (int bj = 0; bj < 2; ++bj)
#pragma unroll
                            for (int n = 0; n < 2; ++n) { f32x4 v = acc[ai][bj][m][n]; if (donorm) v = v * *(const f32x4*)(gkk + 32 * bj + 16 * n + 4 * fq) * rs;
                                *(::u32x2*)(rp + 32 * bj + 16 * n) = pk4(v); } }
            } else {
                ::bf16_t* dst = (::bf16_t*)(ws + (br == 1 ? O_VST : O_VWT));
#pragma unroll
                for (int ai = 0; ai < 2; ++ai)
#pragma unroll
                    for (int m = 0; m < 4; ++m) { const int r = row0 + ai * HALF + m * 16, b = r >> 13, s = r & 8191;
#pragma unroll
                        for (int bj = 0; bj < 2; ++bj)
#pragma unroll
                            for (int n = 0; n < 2; ++n) { const ::u32x2 o = pk4(acc[ai][bj][m][n]); ::bf16_t* dT = dst + ((size_t)(b * 2 + g) * 64 + 32 * bj + 16 * n + 4 * fq) * SEQ + s;
                                dT[0] = (::bf16_t)(o[0] & 0xffff); dT[SEQ] = (::bf16_t)(o[0] >> 16); dT[2 * SEQ] = (::bf16_t)(o[1] & 0xffff); dT[3 * SEQ] = (::bf16_t)(o[1] >> 16); } }
            }
        } else if (L0 < 3840) {
            ::bf16_t* MG = (::bf16_t*)(ws + O_MG);
#pragma unroll
            for (int ai = 0; ai < 2; ++ai)
#pragma unroll
                for (int m = 0; m < 4; ++m) { ::bf16_t* rp = MG + (size_t)(row0 + ai * HALF + m * 16) * 2048 + (L0 - 1792) + 4 * fq;
#pragma unroll
                    for (int bj = 0; bj < 2; ++bj)
#pragma unroll
                        for (int n = 0; n < 2; ++n) { const f32x4 v = acc[ai][bj][m][n]; *(::u32x2*)(rp + 32 * bj + 16 * n) = (::u32x2){pk2(sigmoidf_(v[0]), sigmoidf_(v[1])), pk2(sigmoidf_(v[2]), sigmoidf_(v[3]))}; } }
        } else if (L0 == 3840) {
            float* G = (float*)(ws + O_GATES);
#pragma unroll
            for (int ai = 0; ai < 2; ++ai)
#pragma unroll
                for (int m = 0; m < 4; ++m)
#pragma unroll
                    for (int n = 0; n < 2; ++n) { const int c = 16 * n + 4 * fq;
                        if (c < 24) { const f32x4 v = acc[ai][0][m][n]; *(f32x4*)(G + (size_t)(row0 + ai * HALF + m * 16) * 24 + c) = (f32x4){sigmoidf_(v[0]), sigmoidf_(v[1]), sigmoidf_(v[2]), sigmoidf_(v[3])}; } }
        }
    }
};
#define PG_EPI_LOOP(...) \
    _Pragma("unroll") for (int ai = 0; ai < 2; ++ai) _Pragma("unroll") for (int m = 0; m < 4; ++m) { const int row = u.pm * BM + ai * HALF + wr * 64 + m * 16 + fr; \
        _Pragma("unroll") for (int bj = 0; bj < 2; ++bj) _Pragma("unroll") for (int n = 0; n < 2; ++n) { const int col = u.pn * BM + bj * HALF + wc * 32 + n * 16 + 4 * fq; const f32x4 v = acc[ai][bj][m][n]; __VA_ARGS__ } }
struct EpiGlu {
    static constexpr bool PERM = false, AFTER_DRAIN = false;
    const ::bf16_t* YG; ::bf16_t* YS; const float* bias;
    __device__ __forceinline__ void operator()(const f32x4 (&acc)[2][2][4][2], const Unit& u, int wr, int wc, int fr, int fq) const {
        PG_EPI_LOOP({ const size_t off = (size_t)row * 512 + col; const ::u32x2 yy = *(const ::u32x2*)(YG + off); const f32x4 bb = *(const f32x4*)(bias + col);
            *(::u32x2*)(YS + off) = (::u32x2){pk2(bflo(yy[0]) * sigmoidf_(v[0] + bb[0]), bfhi(yy[0]) * sigmoidf_(v[1] + bb[1])), pk2(bflo(yy[1]) * sigmoidf_(v[2] + bb[2]), bfhi(yy[1]) * sigmoidf_(v[3] + bb[3]))}; })
    }
};
template <int PASS> struct EpiMerge {
    static constexpr bool PERM = false, AFTER_DRAIN = false;
    const ::bf16_t* MG; ::bf16_t* ME;
    __device__ __forceinline__ void operator()(const f32x4 (&acc)[2][2][4][2], const Unit& u, int wr, int wc, int fr, int fq) const {
        PG_EPI_LOOP({ const ::u32x2 gg = *(const ::u32x2*)(MG + (size_t)row * 2048 + PASS * 1024 + col); ::bf16_t* mp = ME + (size_t)row * 1024 + col;
            f32x4 o = {bflo(gg[0]) * v[0], bfhi(gg[0]) * v[1], bflo(gg[1]) * v[2], bfhi(gg[1]) * v[3]};
            if (PASS == 1) { const ::u32x2 pp = *(const ::u32x2*)mp; o[0] += bflo(pp[0]); o[1] += bfhi(pp[0]); o[2] += bflo(pp[1]); o[3] += bfhi(pp[1]); }
            *(::u32x2*)mp = pk4(o); })
    }
};
struct EpiOut {
    static constexpr bool PERM = false, AFTER_DRAIN = false;
    const float* x; float* out; ::bf16_t* X1B; float* SSQ;
    __device__ __forceinline__ void operator()(const f32x4 (&acc)[2][2][4][2], const Unit& u, int wr, int wc, int fr, int fq) const {
#pragma unroll
        for (int ai = 0; ai < 2; ++ai)
#pragma unroll
            for (int m = 0; m < 4; ++m) { const int row = u.pm * BM + ai * HALF + wr * 64 + m * 16 + fr; float s = 0.f;
#pragma unroll
                for (int bj = 0; bj < 2; ++bj)
#pragma unroll
                    for (int n = 0; n < 2; ++n) { const size_t off = (size_t)row * 1024 + u.pn * BM + bj * HALF + wc * 32 + n * 16 + 4 * fq;
                        const f32x4 o = acc[ai][bj][m][n] + *(const f32x4*)(x + off); *(f32x4*)(out + off) = o; *(::u32x2*)(X1B + off) = pk4(o);
                        s += (o[0] * o[0] + o[1] * o[1]) + (o[2] * o[2] + o[3] * o[3]); }
                s += __shfl_xor(s, 16); s += __shfl_xor(s, 32);
                if (fq == 0) atomicAdd(SSQ + row, s); }
    }
};
struct EpiUp {
    static constexpr bool PERM = false, AFTER_DRAIN = false;
    ::bf16_t* FF; const float* SSQ;
    __device__ __forceinline__ void operator()(const f32x4 (&acc)[2][2][4][2], const Unit& u, int wr, int wc, int fr, int fq) const {
#pragma unroll
        for (int ai = 0; ai < 2; ++ai)
#pragma unroll
            for (int m = 0; m < 4; ++m) { const int row = u.pm * BM + ai * HALF + wr * 64 + m * 16 + fr; const float rstd = rsqrtf(SSQ[row] * (1.0f / DM) + EPS);
#pragma unroll
                for (int bj = 0; bj < 2; ++bj)
#pragma unroll
                    for (int n = 0; n < 2; ++n) { f32x4 v = acc[ai][bj][m][n];
#pragma unroll
                        for (int r = 0; r < 4; ++r) { const float a = fmaxf(v[r], 0.f) * rstd; v[r] = a * a; }
                        *(::u32x2*)(FF + (size_t)row * DFF + u.pn * BM + bj * HALF + wc * 32 + n * 16 + 4 * fq) = pk4(v); } }
    }
};
struct EpiDown {
    static constexpr bool PERM = false, AFTER_DRAIN = false;
    float* out;
    __device__ __forceinline__ void operator()(const f32x4 (&acc)[2][2][4][2], const Unit& u, int wr, int wc, int fr, int fq) const {
        PG_EPI_LOOP({ float* op = out + (size_t)row * 1024 + col; *(f32x4*)op = v + *(const f32x4*)op; })
    }
};

template <class Epi, class Sched, bool ALIGN_EPI = false, bool SP2 = false>
__device__ __forceinline__ void gemm_phase(PG8_LAS unsigned char* lds, const Gemm g, const Sched& S, const Epi& E) {
    const int tid = opaque_tid(), wid = __builtin_amdgcn_readfirstlane(tid >> 6), lane = tid & 63, wr = wid >> 2, wc = wid & 3, fr = lane & 15, fq = lane >> 4;
    const int K = g.K, nt = K / BK;
    unsigned voffA[2], voffB[2];
#pragma unroll
    for (int i = 0; i < 2; ++i) { int R, C; stage_rc(tid * 16 + i * 8192, R, C); const int Rb = Epi::PERM ? ((R & ~31) + perm32(R & 31)) : R;
        voffA[i] = (unsigned)(R * K + C) * 2u; voffB[i] = (unsigned)(Rb * K + C) * 2u; }
    const size_t kstep = (size_t)(BK * 2);
    const size_t hstep = (size_t)HALF * K * 2;
    const size_t tstep = 2 * hstep;
    const unsigned ldsw = (unsigned)wid * 1024u;
    const int aoff = lds_byte(wr * 64 + fr, fq * 8), boff = lds_byte(wc * 32 + fr, fq * 8);
#define PG8_SA(b, h) (((b) * 2 + (h)) * HTB)
#define PG8_SB(b, h) ((4 + (b) * 2 + (h)) * HTB)
#define PG8_STAGE(bufoff, gbase, voff) do { _Pragma("unroll") for (int _i = 0; _i < 2; ++_i) \
        __builtin_amdgcn_global_load_lds((const unsigned*)((const char*)(gbase) + (voff)[_i]), (PG8_LAS unsigned*)(lds + (bufoff) + ldsw + _i * 8192), 16, 0, 0); } while (0)
#define PG8_LDA(dst, b, h) do { _Pragma("unroll") for (int m = 0; m < 4; ++m) _Pragma("unroll") for (int k = 0; k < 2; ++k) dst[m][k] = *(const PG8_LAS bf16x8*)(lds + PG8_SA(b, h) + aoff + m * 2048 + k * 1024); } while (0)
#define PG8_LDB(dst, b, h) do { _Pragma("unroll") for (int n = 0; n < 2; ++n) _Pragma("unroll") for (int k = 0; k < 2; ++k) dst[n][k] = *(const PG8_LAS bf16x8*)(lds + PG8_SB(b, h) + boff + n * 2048 + k * 1024); } while (0)
#define PG8_MMA(ai, bj, At, Bt) do { __builtin_amdgcn_s_setprio(1); _Pragma("unroll") for (int m = 0; m < 4; ++m) _Pragma("unroll") for (int n = 0; n < 2; ++n) _Pragma("unroll") for (int k = 0; k < 2; ++k) \
        acc[ai][bj][m][n] = __builtin_amdgcn_mfma_f32_16x16x32_bf16(Bt[n][k], At[m][k], acc[ai][bj][m][n], 0, 0, 0); __builtin_amdgcn_s_setprio(0); } while (0)
#define PG8_WAIT_V(n) asm volatile("s_waitcnt vmcnt(" #n ")" ::: "memory")
#define PG8_WAIT_L(n) asm volatile("s_waitcnt lgkmcnt(" #n ")" ::: "memory")
#define PG8_BAR __builtin_amdgcn_s_barrier()
#define PG8_SCHED __builtin_amdgcn_sched_barrier(0)
    Unit cur, nxt; int ui = 0;
    if (!S.next(0, cur)) return;
    f32x4 acc[2][2][4][2];
#pragma unroll
    for (int a = 0; a < 2; ++a)
#pragma unroll
        for (int b = 0; b < 2; ++b)
#pragma unroll
            for (int m = 0; m < 4; ++m)
#pragma unroll
                for (int n = 0; n < 2; ++n) acc[a][b][m][n] = (f32x4){0.f, 0.f, 0.f, 0.f};
    bf16x8 At[4][2], B0[2][2], B1[2][2];
    const char* cA = (const char*)g.A + (size_t)cur.pm * tstep; const char* cB = (const char*)g.Bt + (size_t)cur.pn * tstep;
    S.a_ready(cur);
    if constexpr (SP2) {
        PG8_STAGE(PG8_SB(0, 0), cB, voffB); PG8_STAGE(PG8_SB(0, 1), cB + hstep, voffB); PG8_STAGE(PG8_SA(0, 0), cA, voffA); PG8_STAGE(PG8_SA(0, 1), cA + hstep, voffA);
        if (wr == 1) PG8_BAR;
        PG8_WAIT_V(2); PG8_BAR;
        PG8_STAGE(PG8_SB(1, 0), cB + kstep, voffB); PG8_STAGE(PG8_SA(1, 0), cA + kstep, voffA); PG8_STAGE(PG8_SB(1, 1), cB + hstep + kstep, voffB);
        PG8_WAIT_V(6); PG8_BAR;
    } else {
        PG8_STAGE(PG8_SB(0, 0), cB, voffB); PG8_STAGE(PG8_SA(0, 0), cA, voffA); PG8_STAGE(PG8_SB(0, 1), cB + hstep, voffB); PG8_STAGE(PG8_SA(0, 1), cA + hstep, voffA);
        if (wr == 1) PG8_BAR;
        PG8_WAIT_V(4); PG8_BAR;
        PG8_STAGE(PG8_SB(1, 0), cB + kstep, voffB); PG8_STAGE(PG8_SA(1, 0), cA + kstep, voffA); PG8_STAGE(PG8_SB(1, 1), cB + hstep + kstep, voffB);
        PG8_WAIT_V(6); PG8_BAR;
    }
    for (;;) {
        const bool has_next = S.next(ui + 1, nxt);
        const char* nA = has_next ? (const char*)g.A + (size_t)nxt.pm * tstep : cA; const char* nB = has_next ? (const char*)g.Bt + (size_t)nxt.pn * tstep : cB;
        for (int t = 0; t < nt; t += 2) {
            const bool last = (t == nt - 2);
            const char* a1 = cA + (size_t)(t + 1) * kstep;
            const char* a2 = last ? nA : cA + (size_t)(t + 2) * kstep; const char* b2 = last ? nB : cB + (size_t)(t + 2) * kstep;
            const char* a3 = a2 + kstep; const char* b3 = b2 + kstep;
            if (last && has_next) S.a_ready(nxt);
            if constexpr (SP2) {
            PG8_LDB(B0, 0, 0); PG8_LDB(B1, 0, 1); PG8_SCHED; PG8_LDA(At, 0, 0); PG8_STAGE(PG8_SA(1, 1), a1 + hstep, voffA);
            PG8_WAIT_V(8); PG8_WAIT_L(0); PG8_BAR; PG8_MMA(0, 0, At, B0); PG8_MMA(0, 1, At, B1); PG8_BAR; PG8_SCHED;
            PG8_LDA(At, 0, 1); PG8_STAGE(PG8_SB(0, 0), b2, voffB); PG8_STAGE(PG8_SB(0, 1), b2 + hstep, voffB); PG8_STAGE(PG8_SA(0, 0), a2, voffA);
            PG8_WAIT_V(8); PG8_WAIT_L(0); PG8_BAR; PG8_MMA(1, 0, At, B0); PG8_MMA(1, 1, At, B1); PG8_BAR; PG8_SCHED;
            PG8_LDB(B0, 1, 0); PG8_LDB(B1, 1, 1); PG8_SCHED; PG8_LDA(At, 1, 0); PG8_STAGE(PG8_SA(0, 1), a2 + hstep, voffA);
            PG8_WAIT_V(8); PG8_WAIT_L(0); PG8_BAR; PG8_MMA(0, 0, At, B0); PG8_MMA(0, 1, At, B1); PG8_BAR; PG8_SCHED;
            PG8_LDA(At, 1, 1); PG8_STAGE(PG8_SB(1, 0), b3, voffB); PG8_STAGE(PG8_SB(1, 1), b3 + hstep, voffB); PG8_STAGE(PG8_SA(1, 0), a3, voffA);
            PG8_WAIT_V(8); PG8_WAIT_L(0); PG8_BAR; PG8_MMA(1, 0, At, B0); PG8_MMA(1, 1, At, B1); PG8_BAR; PG8_SCHED;
            } else {
            PG8_LDB(B0, 0, 0); PG8_SCHED; PG8_LDA(At, 0, 0); PG8_STAGE(PG8_SA(1, 1), a1 + hstep, voffA);
            PG8_WAIT_L(8); PG8_BAR; PG8_WAIT_L(0); PG8_MMA(0, 0, At, B0); PG8_BAR; PG8_SCHED;
            PG8_LDB(B1, 0, 1); PG8_STAGE(PG8_SB(0, 0), b2, voffB);
            PG8_BAR; PG8_WAIT_L(0); PG8_MMA(0, 1, At, B1); PG8_BAR;
            PG8_LDA(At, 0, 1); PG8_STAGE(PG8_SA(0, 0), a2, voffA);
            PG8_BAR; PG8_WAIT_L(0); PG8_MMA(1, 0, At, B0); PG8_BAR; PG8_SCHED;
            PG8_STAGE(PG8_SB(0, 1), b2 + hstep, voffB);
            PG8_WAIT_V(6); PG8_BAR; PG8_MMA(1, 1, At, B1); PG8_BAR;
            PG8_LDB(B0, 1, 0); PG8_SCHED; PG8_LDA(At, 1, 0); PG8_STAGE(PG8_SA(0, 1), a2 + hstep, voffA);
            PG8_WAIT_L(8); PG8_BAR; PG8_WAIT_L(0); PG8_MMA(0, 0, At, B0); PG8_BAR; PG8_SCHED;
            PG8_LDB(B1, 1, 1); PG8_STAGE(PG8_SB(1, 0), b3, voffB);
            PG8_BAR; PG8_WAIT_L(0); PG8_MMA(0, 1, At, B1); PG8_BAR;
            PG8_LDA(At, 1, 1); PG8_STAGE(PG8_SA(1, 0), a3, voffA);
            PG8_BAR; PG8_WAIT_L(0); PG8_MMA(1, 0, At, B0); PG8_BAR; PG8_SCHED;
            PG8_STAGE(PG8_SB(1, 1), b3 + hstep, voffB);
            PG8_WAIT_V(6); PG8_BAR; PG8_MMA(1, 1, At, B1); PG8_BAR;
            }
        }
        if constexpr (ALIGN_EPI) { if (wr == 0) PG8_BAR; }
        if constexpr (!Epi::AFTER_DRAIN) { E(acc, cur, wr, wc, fr, fq); S.done(cur); }
        if (!has_next) break;
#pragma unroll
        for (int a = 0; a < 2; ++a)
#pragma unroll
            for (int b = 0; b < 2; ++b)
#pragma unroll
                for (int m = 0; m < 4; ++m)
#pragma unroll
                    for (int n = 0; n < 2; ++n) acc[a][b][m][n] = (f32x4){0.f, 0.f, 0.f, 0.f};
        cur = nxt; cA = nA; cB = nB; ++ui;
        if constexpr (ALIGN_EPI) { if (wr == 1) PG8_BAR; }
    }
    PG8_WAIT_V(0);
    if constexpr (!ALIGN_EPI) { if (wr == 0) PG8_BAR; }
    PG8_BAR;
    if constexpr (Epi::AFTER_DRAIN) { E.fused(acc, cur, wr, wc, fr, fq, lds, wid, lane); S.done(cur); }
#undef PG8_SA
#undef PG8_SB
#undef PG8_STAGE
#undef PG8_LDA
#undef PG8_LDB
#undef PG8_MMA
#undef PG8_WAIT_V
#undef PG8_WAIT_L
#undef PG8_BAR
#undef PG8_SCHED
}
}
#define XB_TMO      128
#define XB_XCNT(j)  (256  + 64 * (j))
#define XB_XSUB(j)  (1280 + 64 * (j))
#define XB_XGEN(j)  (2304 + 64 * (j))
#define XB_TOP      3328
#define XB_TOPGEN   3392
#define XCD_BAR_WORDS 3456
#define XB_SPIN_CAP (1u << 18)

__device__ __forceinline__ unsigned xb_ld(unsigned* p)              { return __hip_atomic_load(p, __ATOMIC_RELAXED, __HIP_MEMORY_SCOPE_AGENT); }
__device__ __forceinline__ unsigned xb_add(unsigned* p, unsigned v) { return __hip_atomic_fetch_add(p, v, __ATOMIC_RELAXED, __HIP_MEMORY_SCOPE_AGENT); }
__device__ __forceinline__ unsigned xb_xcc_id() { return (unsigned)__builtin_amdgcn_s_getreg((3 << 11) | 20) & 0xFu; }
#define XB_SPIN(cond, bar) do { unsigned _sp = 0; while (cond) { __builtin_amdgcn_s_sleep(1); \
    if ((++_sp & 255u) == 0u) { if (xb_ld(&(bar)[XB_TMO])) break; if (_sp > XB_SPIN_CAP) { atomicAdd(&(bar)[XB_TMO], 1u); break; } } } } while (0)

struct XcdBarrier {
    unsigned* bar; unsigned x;
    volatile __attribute__((address_space(3))) unsigned* st;
};

__device__ __forceinline__ XcdBarrier xcd_barrier_post(unsigned* bar, volatile __attribute__((address_space(3))) unsigned* st) {
    XcdBarrier b; b.bar = bar; b.x = xb_xcc_id(); b.st = st;
    if (threadIdx.x == 0) (void)xb_add(&bar[XB_XCNT(b.x)], 1u);
    return b;
}
__device__ __forceinline__ void xcd_barrier_complete(unsigned* bar, unsigned x, unsigned& nloc, unsigned& nx) {
    const unsigned G = gridDim.x * gridDim.y * gridDim.z;
    unsigned sum, cnt, mine, sp = 0u;
    for (;;) {
        sum = 0u; cnt = 0u; mine = 0u;
#pragma unroll
        for (unsigned j = 0; j < 16; ++j) { const unsigned c = xb_ld(&bar[XB_XCNT(j)]); sum += c; cnt += (c > 0u) ? 1u : 0u; mine = (j == x) ? c : mine; }
        if (sum == G) break;
        __builtin_amdgcn_s_sleep(1);
        if ((++sp & 255u) == 0u) { if (xb_ld(&bar[XB_TMO])) break; if (sp > XB_SPIN_CAP) { atomicAdd(&bar[XB_TMO], 1u); break; } }
    }
    nloc = mine > 0u ? mine : 1u; nx = cnt > 0u ? cnt : 1u;
}

__device__ __forceinline__ void xcd_barrier(const XcdBarrier& b) {
    asm volatile("s_waitcnt vmcnt(0)" ::: "memory");
    __syncthreads();
    if (threadIdx.x == 0) {
        unsigned* bar = b.bar;
        __builtin_amdgcn_s_waitcnt(0);
        unsigned nloc = b.st[0], nx = b.st[1];
        if (nloc == 0u) { xcd_barrier_complete(bar, b.x, nloc, nx); b.st[0] = nloc; b.st[1] = nx; }
        const unsigned old = xb_add(&bar[XB_XSUB(b.x)], 1u);
        const unsigned gen = old / nloc;
        if (old + 1u == (gen + 1u) * nloc) {
            __builtin_amdgcn_fence(__ATOMIC_RELEASE, "agent");
            asm volatile("s_waitcnt vmcnt(0)" ::: "memory");
            const unsigned og = xb_add(&bar[XB_TOP], 1u);
            const unsigned tg = og / nx;
            if (og + 1u == (tg + 1u) * nx) xb_add(&bar[XB_TOPGEN], 1u);
            else XB_SPIN(xb_ld(&bar[XB_TOPGEN]) == tg, bar);
            __builtin_amdgcn_fence(__ATOMIC_ACQUIRE, "agent");
            xb_add(&bar[XB_XGEN(b.x)], 1u);
            asm volatile("s_waitcnt vmcnt(0)" ::: "memory");
        } else {
            XB_SPIN(xb_ld(&bar[XB_XGEN(b.x)]) == gen, bar);
            __builtin_amdgcn_fence(__ATOMIC_ACQUIRE, "agent");
            asm volatile("s_waitcnt vmcnt(0)" ::: "memory");
        }
    }
    __syncthreads();
}

typedef __attribute__((address_space(3))) unsigned char lds_u8;

template <class Epi>
__device__ __forceinline__ void big_gemm(char* smem, const bf16_t* A, const bf16_t* Bt, int M, int N, int K, const Epi& E) {
    pg8::Gemm g{A, Bt, M, N, K}; pg8::StaticOrder S; S.init(M, N, (int)gridDim.x, (int)blockIdx.x);
    pg8::gemm_phase<Epi, pg8::StaticOrder, true, true>((lds_u8*)smem, g, S, E);
}

constexpr int LSTR = 72;
__device__ __forceinline__ void compress_phase(const Ptrs& P, char* smem, int vb, int nvb) {
    unsigned char* ws = P.ws;
    const int tid = opaque_tid(), lane = tid & 63, wave = __builtin_amdgcn_readfirstlane(tid >> 6), wm = wave >> 2, wn = wave & 3, fr = lane & 15, q = lane >> 4;
    bf16_t* As = (bf16_t*)smem;
    bf16_t* Bs = As + 64 * LSTR;
    bf16_t* H = Bs + 128 * LSTR;
    constexpr int HS = 136;
    const int sc = tid & 7, sr = tid >> 3;
    for (int t = vb; t < 128; t += nvb) {
        const int isv = t >> 6, m0 = (t & 63) * 64;
        const bf16_t* Ag = (const bf16_t*)(ws + (isv ? O_VCIN : O_KCIN)) + (size_t)m0 * 1024 + sc * 8;
        const bf16_t* Bg = (const bf16_t*)(ws + (isv ? O_WT_CV1 : O_WT_CK1)) + sc * 8;
        f32x4 acc[2][2];
#pragma unroll
        for (int i = 0; i < 2; ++i)
#pragma unroll
            for (int j = 0; j < 2; ++j) acc[i][j] = (f32x4){0.f, 0.f, 0.f, 0.f};
        u32x4 ra = *(const u32x4*)(Ag + (size_t)sr * 1024), rb0 = *(const u32x4*)(Bg + (size_t)sr * 2048), rb1 = *(const u32x4*)(Bg + (size_t)(sr + 64) * 2048);
        for (int kt = 0; kt < 32; ++kt) {
            __syncthreads();
            *(u32x4*)(As + sr * LSTR + sc * 8) = ra; *(u32x4*)(Bs + sr * LSTR + sc * 8) = rb0; *(u32x4*)(Bs + (sr + 64) * LSTR + sc * 8) = rb1;
            __syncthreads();
            if (kt + 1 < 32) { ra = *(const u32x4*)(Ag + (size_t)sr * 1024 + (kt + 1) * 64); rb0 = *(const u32x4*)(Bg + (size_t)sr * 2048 + (kt + 1) * 64); rb1 = *(const u32x4*)(Bg + (size_t)(sr + 64) * 2048 + (kt + 1) * 64); }
#pragma unroll
            for (int ks = 0; ks < 2; ++ks) {
                bf16x8 a[2], b[2];
#pragma unroll
                for (int i = 0; i < 2; ++i) a[i] = *(const bf16x8*)(As + (wm * 32 + 16 * i + fr) * LSTR + ks * 32 + 8 * q);
#pragma unroll
                for (int j = 0; j < 2; ++j) b[j] = *(const bf16x8*)(Bs + (wn * 32 + 16 * j + fr) * LSTR + ks * 32 + 8 * q);
#pragma unroll
                for (int i = 0; i < 2; ++i)
#pragma unroll
                    for (int j = 0; j < 2; ++j) acc[i][j] = __builtin_amdgcn_mfma_f32_16x16x32_bf16(b[j], a[i], acc[i][j], 0, 0, 0);
            }
        }
        const float* b1 = (const float*)(ws + (isv ? O_B1V : O_B1K));
#pragma unroll
        for (int i = 0; i < 2; ++i)
#pragma unroll
            for (int j = 0; j < 2; ++j) { const f32x4 v = acc[i][j]; const int n = wn * 32 + 16 * j + 4 * q; const f32x4 bb = *(const f32x4*)(b1 + n);
                *(u32x2*)(H + (wm * 32 + 16 * i + fr) * HS + n) = (u32x2){pk2(gelu_tanh(v[0] + bb[0]), gelu_tanh(v[1] + bb[1])), pk2(gelu_tanh(v[2] + bb[2]), gelu_tanh(v[3] + bb[3]))}; }
        __syncthreads();
        if (wave < 4) {
            const bf16_t* W2t = (const bf16_t*)(ws + (isv ? O_WT_CV2 : O_WT_CK2));
            f32x4 o2[4];
#pragma unroll
            for (int j = 0; j < 4; ++j) o2[j] = (f32x4){0.f, 0.f, 0.f, 0.f};
#pragma unroll
            for (int ks = 0; ks < 4; ++ks) {
                const bf16x8 a = *(const bf16x8*)(H + (wave * 16 + fr) * HS + ks * 32 + 8 * q);
#pragma unroll
                for (int j = 0; j < 4; ++j) { const bf16x8 b = *(const bf16x8*)(W2t + (size_t)(16 * j + fr) * 128 + ks * 32 + 8 * q); o2[j] = __builtin_amdgcn_mfma_f32_16x16x32_bf16(b, a, o2[j], 0, 0, 0); }
            }
            const int R = m0 + wave * 16 + fr;
            if (!isv) {
                float s = 0.f;
#pragma unroll
                for (int j = 0; j < 4; ++j) s += (o2[j][0] * o2[j][0] + o2[j][1] * o2[j][1]) + (o2[j][2] * o2[j][2] + o2[j][3] * o2[j][3]);
                s += __shfl_xor(s, 16); s += __shfl_xor(s, 32);
                const float rstd = rsqrtf(s * (1.0f / 64) + EPS); const float* gk = P.in[20];
                bf16_t* dst = (bf16_t*)(ws + O_KC);
#pragma unroll
                for (int j = 0; j < 4; ++j) *(u32x2*)(dst + (size_t)R * 64 + 16 * j + 4 * q) = pk4(o2[j] * *(const f32x4*)(gk + 16 * j + 4 * q) * rstd);
            } else {
                bf16_t* dT0 = (bf16_t*)(ws + O_VCT) + (size_t)(R >> 9) * 64 * 512 + (R & 511);
#pragma unroll
                for (int j = 0; j < 4; ++j) { const u32x2 o = pk4(o2[j]); bf16_t* dT = dT0 + (size_t)(16 * j + 4 * q) * 512;
                    dT[0] = (bf16_t)(o[0] & 0xffff); dT[512] = (bf16_t)(o[0] >> 16); dT[1024] = (bf16_t)(o[1] & 0xffff); dT[1536] = (bf16_t)(o[1] >> 16); }
            }
        }
        __syncthreads();
    }
}

constexpr int S5_BU_STR = 132, S5_XB_STR = 136;
constexpr int S5_WAVE_LDS = 16 * S5_BU_STR * 4 + 16 * S5_XB_STR * 2;
template <bool ENDS_ONLY>
__device__ __forceinline__ void s5_phase(const Ptrs& P, char* smem, int vb, int nvb) {
    unsigned char* ws = P.ws;
    const int tid_ = opaque_tid(); const int lane = tid_ & 63, wave = __builtin_amdgcn_readfirstlane(tid_ >> 6), fr = lane & 15, q = lane >> 4;
    float* BU = (float*)(smem + wave * S5_WAVE_LDS);
    bf16_t* XB = (bf16_t*)(smem + wave * S5_WAVE_LDS + 16 * S5_BU_STR * 4);
    const bf16_t* U = (const bf16_t*)(ws + O_U);
    const float* ABAR = (const float*)(ws + O_ABAR); const float* AL = (const float*)(ws + O_AL);
    float* ENDS = (float*)(ws + O_ENDS);
    const int gw = vb * NWAVES + wave, ngw = nvb * NWAVES;
    for (int it = gw; it < NB * NCHUNK * 32; it += ngw) {
        const int g = it & 31, c = (it >> 5) & (NCHUNK - 1), b = it >> 11;
        const float ar = ABAR[(g * 64 + lane) * 2], ai = ABAR[(g * 64 + lane) * 2 + 1];
        bf16x8 bb[8];
#pragma unroll
        for (int nt = 0; nt < 8; ++nt) {
            bb[nt] = (bf16x8){0, 0, 0, 0, 0, 0, 0, 0};
            if (q < 2) bb[nt] = *(const bf16x8*)((const bf16_t*)(ws + O_BBT) + ((size_t)g * 128 + 16 * nt + fr) * 16 + 8 * q);
        }
        bf16x8 ct[4];
        if (!ENDS_ONLY) {
#pragma unroll
            for (int ks = 0; ks < 4; ++ks) ct[ks] = *(const bf16x8*)((const bf16_t*)(ws + O_CT) + ((size_t)g * 16 + fr) * 128 + ks * 32 + 8 * q);
        }
        float xr = 0.f, xi = 0.f;
        if (!ENDS_ONLY) {
            const float alr = AL[(g * 64 + lane) * 2], ali = AL[(g * 64 + lane) * 2 + 1];
            for (int cp = 0; cp < c; ++cp) {
                const f32x2_t e = *(const f32x2_t*)(ENDS + (((size_t)(b * NCHUNK + cp) * 32 + g) * 64 + lane) * 2);
                const float nr = alr * xr - ali * xi + e[0], ni = alr * xi + ali * xr + e[1]; xr = nr; xi = ni;
            }
        }
        const size_t tok0 = (size_t)b * SEQ + (size_t)c * CHUNK;
        for (int sub = 0; sub < CHUNK / 16; ++sub) {
            const size_t tk = tok0 + sub * 16;
            bf16x8 uf = (bf16x8){0, 0, 0, 0, 0, 0, 0, 0};
            if (q < 2) uf = *(const bf16x8*)(U + (tk + fr) * 512 + g * 16 + 8 * q);
#pragma unroll
            for (int nt = 0; nt < 8; ++nt) {
                f32x4 d = __builtin_amdgcn_mfma_f32_16x16x32_bf16(bb[nt], uf, (f32x4){0.f, 0.f, 0.f, 0.f}, 0, 0, 0);
                *(f32x4*)(BU + fr * S5_BU_STR + 16 * nt + 4 * q) = d;
            }
            asm volatile("s_waitcnt lgkmcnt(0)" ::: "memory");
#pragma unroll 4
            for (int s = 0; s < 16; ++s) {
                const float br = BU[s * S5_BU_STR + lane], bi = BU[s * S5_BU_STR + 64 + lane];
                const float nr = ar * xr - ai * xi + br, ni = ar * xi + ai * xr + bi; xr = nr; xi = ni;
                if (!ENDS_ONLY) { XB[s * S5_XB_STR + lane] = f2bf(xr); XB[s * S5_XB_STR + 64 + lane] = f2bf(xi); }
            }
            asm volatile("s_waitcnt lgkmcnt(0)" ::: "memory");
            if (!ENDS_ONLY) {
                f32x4 y = (f32x4){0.f, 0.f, 0.f, 0.f};
#pragma unroll
                for (int ks = 0; ks < 4; ++ks) {
                    const bf16x8 xf = *(const bf16x8*)(XB + fr * S5_XB_STR + ks * 32 + 8 * q);
                    y = __builtin_amdgcn_mfma_f32_16x16x32_bf16(ct[ks], xf, y, 0, 0, 0);
                }
                const u32x2 uu = *(const u32x2*)(U + (tk + fr) * 512 + g * 16 + 4 * q);
                const f32x4 dd = *(const f32x4*)(P.in[10] + g * 16 + 4 * q);
                const float y0 = gelu_tanh(y[0] + dd[0] * bflo(uu[0])), y1 = gelu_tanh(y[1] + dd[1] * bfhi(uu[0]));
                const float y2 = gelu_tanh(y[2] + dd[2] * bflo(uu[1])), y3 = gelu_tanh(y[3] + dd[3] * bfhi(uu[1]));
                *(u32x2*)((bf16_t*)(ws + O_YG) + (tk + fr) * 512 + g * 16 + 4 * q) = (u32x2){pk2(y0, y1), pk2(y2, y3)};
                asm volatile("s_waitcnt lgkmcnt(0)" ::: "memory");
            }
        }
        if (ENDS_ONLY) *(f32x2_t*)(ENDS + (((size_t)(b * NCHUNK + c) * 32 + g) * 64 + lane) * 2) = (f32x2_t){xr, xi};
    }
}

constexpr int RT = 2;
constexpr int TQ = 4 * RT * NWAVES;
constexpr int KSTR = 72;
constexpr int KV_TILE = 64 * KSTR * 2;
constexpr int IMP_STR = 132;
struct AttL { static constexpr int K0 = 0, V0 = 2 * KV_TILE, IMP = 4 * KV_TILE, SELM = IMP + NWAVES * 4 * RT * IMP_STR * 4, UNI = SELM + NWAVES * 4 * RT * 16, TOTAL = UNI + 64; };
struct AttSrc { const bf16_t* k; const bf16_t* v; int vld; };

__device__ __forceinline__ void att_load(const AttSrc& s, u32x4& kr, u32x4& vr) {
    const int tid = threadIdx.x, row = tid >> 3, ch = tid & 7;
    kr = *(const u32x4*)(s.k + (size_t)row * 64 + ch * 8);
    vr = *(const u32x4*)(s.v + (size_t)row * s.vld + ch * 8);
}
__device__ __forceinline__ void att_store(char* smem, int buf, const u32x4& kr, const u32x4& vr) {
    const int tid = threadIdx.x, row = tid >> 3, ch = tid & 7;
    *(u32x4*)((bf16_t*)(smem + AttL::K0 + buf * KV_TILE) + row * KSTR + ch * 8) = kr;
    *(u32x4*)((bf16_t*)(smem + AttL::V0 + buf * KV_TILE) + row * KSTR + ch * 8) = vr;
}

template <int MODE>
__device__ __forceinline__ void att_block(const bf16_t* Ks, const bf16_t* Vs, const bf16x8 (&qf)[RT][2], f32x4 (&acc)[RT][4], float (&l)[RT],
                                          const float (&invl)[RT], const float (&g0)[RT], const float (&base0)[RT], const int (&hi0)[RT], int wlo, bool need_mask,
                                          unsigned rtmask, float sk, float* imp_w, int blk0, int fr, int q) {
    const float NEGB = -1e30f;
#pragma unroll 1
    for (int kt = 0; kt < 2; ++kt) {
        bf16x8 kf[2][2];
#pragma unroll
        for (int ab = 0; ab < 2; ++ab)
#pragma unroll
            for (int ks = 0; ks < 2; ++ks) kf[ab][ks] = *(const bf16x8*)(Ks + (32 * kt + 16 * ab + fr) * KSTR + 32 * ks + 8 * q);
        bf16x8 vf[4];
        if (MODE != 0) {
#pragma unroll
            for (int dt = 0; dt < 4; ++dt) {
                const u32x2 lo = *(const u32x2*)(Vs + (16 * dt + fr) * KSTR + 32 * kt + 4 * q), hi = *(const u32x2*)(Vs + (16 * dt + fr) * KSTR + 32 * kt + 16 + 4 * q);
                const u32x4 vv = {lo[0], lo[1], hi[0], hi[1]};
                vf[dt] = __builtin_bit_cast(bf16x8, vv);
            }
        }
#pragma unroll
        for (int rt = 0; rt < RT; ++rt) {
            if (!((rtmask >> rt) & 1u)) continue;
            const float bl = base0[rt] + sk * (float)(32 * kt + 4 * q);
            f32x4 S[2];
#pragma unroll
            for (int ab = 0; ab < 2; ++ab) {
#pragma unroll
                for (int r = 0; r < 4; ++r) S[ab][r] = bl + sk * (float)(16 * ab + r);
                S[ab] = __builtin_amdgcn_mfma_f32_16x16x32_bf16(kf[ab][0], qf[rt][0], S[ab], 0, 0, 0);
                S[ab] = __builtin_amdgcn_mfma_f32_16x16x32_bf16(kf[ab][1], qf[rt][1], S[ab], 0, 0, 0);
            }
            if (need_mask) {
                const int hi = hi0[rt] - (32 * kt + 4 * q), lo = hi - wlo;
#pragma unroll
                for (int ab = 0; ab < 2; ++ab)
#pragma unroll
                    for (int r = 0; r < 4; ++r) { const int c = 16 * ab + r; if (c > hi || c < lo) S[ab][r] = NEGB; }
            }
            float ps = 0.f;
#pragma unroll
            for (int ab = 0; ab < 2; ++ab)
#pragma unroll
                for (int r = 0; r < 4; ++r) { S[ab][r] = __builtin_amdgcn_exp2f(S[ab][r]); ps += S[ab][r]; }
            if (MODE == 0) { l[rt] += ps; continue; }
            if (MODE == 2) l[rt] += ps;
            if (MODE == 1) {
                const float il = invl[rt];
#pragma unroll
                for (int ab = 0; ab < 2; ++ab) {
                    S[ab] = S[ab] * il;
                    float cs = (S[ab][0] + S[ab][1]) + (S[ab][2] + S[ab][3]), last = S[ab][3];
                    cs += __shfl_xor(cs, 1); cs += __shfl_xor(cs, 2); last += __shfl_xor(last, 1); last += __shfl_xor(last, 2);
                    const int blk = blk0 + 8 * kt + 4 * ab + q;
                    if ((fr & 3) == 0) { float* ip = imp_w + (4 * rt + (fr >> 2)) * IMP_STR + blk; atomicAdd(ip, cs); if (blk + 1 < 128) atomicAdd(ip + 1, last); }
                    S[ab] = S[ab] * g0[rt];
                }
            }
            const u32x4 pu = {pk2(S[0][0], S[0][1]), pk2(S[0][2], S[0][3]), pk2(S[1][0], S[1][1]), pk2(S[1][2], S[1][3])};
            const bf16x8 pf = __builtin_bit_cast(bf16x8, pu);
#pragma unroll
            for (int dt = 0; dt < 4; ++dt) acc[rt][dt] = __builtin_amdgcn_mfma_f32_16x16x32_bf16(vf[dt], pf, acc[rt][dt], 0, 0, 0);
        }
    }
}

__device__ __forceinline__ void attn_phase(const Ptrs& P, char* smem, int vb, int nvb) {
    typedef AttL L;
    unsigned char* ws = P.ws;
    const int tid = opaque_tid(), lane = tid & 63, wave = __builtin_amdgcn_readfirstlane(tid >> 6), fr = lane & 15, q = lane >> 4;
    constexpr int NQT = SEQ / TQ, TW = 4 * RT;
    float* imp_w = (float*)(smem + L::IMP) + wave * TW * IMP_STR;
    unsigned* selm_w = (unsigned*)(smem + L::SELM) + wave * TW * 4;
    unsigned* uni = (unsigned*)(smem + L::UNI);
    const float* M2 = (const float*)(ws + O_M2);
    const float LOG2E = 1.4426950408889634f;
    const float* G = (const float*)(ws + O_GATES);
    for (int it = vb; it < NB * 2 * NQT; it += nvb) {
        const int qt = NQT - 1 - (it / (NB * 2)), bg = it % (NB * 2), b = bg >> 1, g = bg & 1;
        const int qs = qt * TQ, t0 = qs + TW * wave;
        const int head = fr & 3, h = g * 4 + head;
        const float slope2 = exp2f(-(float)(h + 1)) * LOG2E;
        const bf16_t* QN = (const bf16_t*)(ws + O_QN);
        bf16x8 qf[RT][2]; int tpos[RT];
#pragma unroll
        for (int rt = 0; rt < RT; ++rt) {
            tpos[rt] = t0 + 4 * rt + (fr >> 2);
            const size_t tok = (size_t)b * SEQ + tpos[rt];
#pragma unroll
            for (int ks = 0; ks < 2; ++ks) qf[rt][ks] = *(const bf16x8*)(QN + tok * 512 + h * 64 + 32 * ks + 8 * q);
        }
        for (int i = lane; i < TW * IMP_STR; i += 64) imp_w[i] = 0.f;
        if (tid < 4) uni[tid] = 0u;
        u32x2 Yp[RT][4];
        f32x4 O[RT][4];
#pragma unroll
        for (int rt = 0; rt < RT; ++rt)
#pragma unroll
            for (int dt = 0; dt < 4; ++dt) O[rt][dt] = (f32x4){0.f, 0.f, 0.f, 0.f};
        float l[RT], invl[RT], g0[RT], base0[RT]; int hi0[RT];
#pragma unroll
        for (int rt = 0; rt < RT; ++rt) { l[rt] = 0.f; invl[rt] = 0.f; g0[rt] = G[((size_t)b * SEQ + tpos[rt]) * 24 + h]; }
        u32x4 kr, vr;
        __syncthreads();
        {
            const int jm_tile = (qs + TQ - 1 - 31) >> 4;
            const int nkb = (jm_tile >> 6) + 1;
            const int jm_lo = (t0 - 31) >> 4, jm_hi = (t0 + TW - 1 - 31) >> 4;
            const float m2 = M2[0];
            const bf16_t* KC = (const bf16_t*)(ws + O_KC) + (size_t)bg * 512 * 64;
            const bf16_t* VCT = (const bf16_t*)(ws + O_VCT) + (size_t)bg * 64 * 512;
            int jmax[RT];
#pragma unroll
            for (int rt = 0; rt < RT; ++rt) jmax[rt] = (tpos[rt] - 31) >> 4;
#pragma unroll 1
            for (int pass = 0; pass < 2; ++pass) {
                { AttSrc s0{KC, VCT, 512}; att_load(s0, kr, vr); att_store(smem, 0, kr, vr); }
                __syncthreads();
#pragma unroll 1
                for (int kb = 0; kb < nkb; ++kb) {
                    if (kb + 1 < nkb) { AttSrc s1{KC + (size_t)(kb + 1) * 64 * 64, VCT + (kb + 1) * 64, 512}; att_load(s1, kr, vr); }
                    if (64 * kb <= jm_hi) {
                        const bool need_mask = (64 * kb + 63 > jm_lo);
#pragma unroll
                        for (int rt = 0; rt < RT; ++rt) { base0[rt] = -m2 - slope2 * (float)(tpos[rt] - 31 - 1024 * kb); hi0[rt] = jmax[rt] - 64 * kb; }
                        const bf16_t* Ks = (const bf16_t*)(smem + L::K0 + (kb & 1) * KV_TILE); const bf16_t* Vs = (const bf16_t*)(smem + L::V0 + (kb & 1) * KV_TILE);
                        if (pass == 0) att_block<0>(Ks, Vs, qf, O, l, invl, g0, base0, hi0, 1 << 28, need_mask, (1u << RT) - 1u, slope2 * 16.f, imp_w, 16 * kb, fr, q);
                        else att_block<1>(Ks, Vs, qf, O, l, invl, g0, base0, hi0, 1 << 28, need_mask, (1u << RT) - 1u, slope2 * 16.f, imp_w, 16 * kb, fr, q);
                    }
                    if (kb + 1 < nkb) att_store(smem, (kb + 1) & 1, kr, vr);
                    __syncthreads();
                }
                if (pass == 0) {
#pragma unroll
                    for (int rt = 0; rt < RT; ++rt) { float s = l[rt]; s += __shfl_xor(s, 16); s += __shfl_xor(s, 32); invl[rt] = s > 0.f ? 1.0f / s : 0.f; l[rt] = 0.f; }
                }
            }
#pragma unroll
            for (int rt = 0; rt < RT; ++rt)
#pragma unroll
                for (int dt = 0; dt < 4; ++dt) { Yp[rt][dt] = pk4(O[rt][dt]); O[rt][dt] = (f32x4){0.f, 0.f, 0.f, 0.f}; }
        }
        {
            asm volatile("s_waitcnt lgkmcnt(0)" ::: "memory");
            const int tl = lane >> 3, part = lane & 7, t = t0 + tl, cur = t >> 6;
            float* my = imp_w + tl * IMP_STR + 16 * part;
#pragma unroll 4
            for (int i = 0; i < 16; ++i) { const int blk = 16 * part + i; const float v = my[i];
                const bool valid = blk <= cur, forced = (blk == 0) || (blk == cur) || (blk == cur - 1);
                my[i] = valid ? (v + (forced ? 1e4f : 0.f)) : -1e30f; }
            asm volatile("s_waitcnt lgkmcnt(0)" ::: "memory");
            unsigned m0 = 0u, m1 = 0u, m2_ = 0u, m3 = 0u;
#pragma unroll 1
            for (int r = 0; r < 16; ++r) {
                float bv = -3.4e38f; int bi = 0;
#pragma unroll
                for (int i4 = 0; i4 < 4; ++i4) { const f32x4 v = *(const f32x4*)(my + 4 * i4);
#pragma unroll
                    for (int c = 0; c < 4; ++c) if (v[c] > bv) { bv = v[c]; bi = 16 * part + 4 * i4 + c; } }
#pragma unroll
                for (int o = 1; o < 8; o <<= 1) { const float ov = __shfl_xor(bv, o); const int oi = __shfl_xor(bi, o); if (ov > bv || (ov == bv && oi < bi)) { bv = ov; bi = oi; } }
                if ((bi >> 4) == part) imp_w[tl * IMP_STR + bi] = -3.0e38f;
                const unsigned bit = 1u << (bi & 31); const int wd = bi >> 5;
                m0 |= (wd == 0) ? bit : 0u; m1 |= (wd == 1) ? bit : 0u; m2_ |= (wd == 2) ? bit : 0u; m3 |= (wd == 3) ? bit : 0u;
                asm volatile("s_waitcnt lgkmcnt(0)" ::: "memory");
            }
            if (part == 0) { selm_w[tl * 4 + 0] = m0; selm_w[tl * 4 + 1] = m1; selm_w[tl * 4 + 2] = m2_; selm_w[tl * 4 + 3] = m3; }
#pragma unroll
            for (int o = 8; o < 64; o <<= 1) { m0 |= __shfl_xor(m0, o); m1 |= __shfl_xor(m1, o); m2_ |= __shfl_xor(m2_, o); m3 |= __shfl_xor(m3, o); }
            if (lane == 0) { atomicOr(uni + 0, m0); atomicOr(uni + 1, m1); atomicOr(uni + 2, m2_); atomicOr(uni + 3, m3); }
            __syncthreads();
            const unsigned wu0 = __builtin_amdgcn_readfirstlane(m0), wu1 = __builtin_amdgcn_readfirstlane(m1), wu2 = __builtin_amdgcn_readfirstlane(m2_), wu3 = __builtin_amdgcn_readfirstlane(m3);
            const unsigned bu0 = __builtin_amdgcn_readfirstlane(uni[0]), bu1 = __builtin_amdgcn_readfirstlane(uni[1]), bu2 = __builtin_amdgcn_readfirstlane(uni[2]), bu3 = __builtin_amdgcn_readfirstlane(uni[3]);
            const float m2s = M2[1];
            const bf16_t* KS = (const bf16_t*)(ws + O_KS) + (size_t)bg * SEQ * 64;
            const bf16_t* VST = (const bf16_t*)(ws + O_VST) + (size_t)bg * 64 * SEQ;
            const int nsel = __popc(bu0) + __popc(bu1) + __popc(bu2) + __popc(bu3);
            int cw = 0; unsigned cbits = bu0;
#define NEXT_BLK(dst) do { while (cbits == 0u) { ++cw; cbits = (cw == 1) ? bu1 : (cw == 2) ? bu2 : bu3; } const int bpos_ = __ffs(cbits) - 1; cbits &= cbits - 1u; dst = cw * 32 + bpos_; } while (0)
            int blk_cur = 0, blk_nxt = 0;
            if (nsel > 0) {
                NEXT_BLK(blk_cur);
                { AttSrc s0{KS + (size_t)blk_cur * 64 * 64, VST + blk_cur * 64, SEQ}; att_load(s0, kr, vr); att_store(smem, 0, kr, vr); }
                __syncthreads();
#pragma unroll 1
                for (int i = 0; i < nsel; ++i) {
                    if (i + 1 < nsel) { NEXT_BLK(blk_nxt); AttSrc s1{KS + (size_t)blk_nxt * 64 * 64, VST + blk_nxt * 64, SEQ}; att_load(s1, kr, vr); }
                    const int blk = blk_cur, kb0 = 64 * blk;
                    const unsigned wword = (blk < 32) ? wu0 : (blk < 64) ? wu1 : (blk < 96) ? wu2 : wu3;
                    if (((wword >> (blk & 31)) & 1u) && kb0 <= t0 + TW - 1) {
                        const bool need_mask = (kb0 + 63 > t0);
                        unsigned rtmask = 0u;
#pragma unroll
                        for (int rt = 0; rt < RT; ++rt) {
                            const unsigned w_ = selm_w[(4 * rt + (fr >> 2)) * 4 + (blk >> 5)];
                            const bool sel = (w_ >> (blk & 31)) & 1u;
                            base0[rt] = sel ? (-m2s - slope2 * (float)(tpos[rt] - kb0)) : -1e30f;
                            hi0[rt] = tpos[rt] - kb0;
                            if (__ballot(sel) != 0ull) rtmask |= 1u << rt;
                        }
                        rtmask = __builtin_amdgcn_readfirstlane(rtmask);
                        const bf16_t* Ks = (const bf16_t*)(smem + L::K0 + (i & 1) * KV_TILE); const bf16_t* Vs = (const bf16_t*)(smem + L::V0 + (i & 1) * KV_TILE);
                        att_block<2>(Ks, Vs, qf, O, l, invl, g0, base0, hi0, 1 << 28, need_mask, rtmask, slope2, imp_w, 0, fr, q);
                    }
                    if (i + 1 < nsel) att_store(smem, (i + 1) & 1, kr, vr);
                    blk_cur = blk_nxt;
                    __syncthreads();
                }
            }
#undef NEXT_BLK
#pragma unroll
            for (int rt = 0; rt < RT; ++rt) {
                float s = l[rt]; s += __shfl_xor(s, 16); s += __shfl_xor(s, 32);
                const float cf = (s > 0.f) ? G[((size_t)b * SEQ + tpos[rt]) * 24 + 8 + h] / s : 0.f; l[rt] = 0.f;
#pragma unroll
                for (int dt = 0; dt < 4; ++dt) { const u32x2 yp = Yp[rt][dt]; const f32x4 yv = {bflo(yp[0]), bfhi(yp[0]), bflo(yp[1]), bfhi(yp[1])};
                    Yp[rt][dt] = pk4(yv + O[rt][dt] * cf); O[rt][dt] = (f32x4){0.f, 0.f, 0.f, 0.f}; }
            }
        }
        {
            const float m2w = M2[2];
            const bf16_t* KW = (const bf16_t*)(ws + O_KW) + (size_t)bg * SEQ * 64;
            const bf16_t* VWT = (const bf16_t*)(ws + O_VWT) + (size_t)bg * 64 * SEQ;
            const int wlast = (qs + TQ - 1) >> 6; int wfirst = (qs - 511) >> 6; if (wfirst < 0) wfirst = 0;
            const int nwb = wlast - wfirst + 1;
            { AttSrc s0{KW + (size_t)wfirst * 64 * 64, VWT + wfirst * 64, SEQ}; att_load(s0, kr, vr); att_store(smem, 0, kr, vr); }
            __syncthreads();
#pragma unroll 1
            for (int i = 0; i < nwb; ++i) {
                const int wb = wfirst + i, kb0 = 64 * wb;
                if (i + 1 < nwb) { AttSrc s1{KW + (size_t)(wb + 1) * 64 * 64, VWT + (wb + 1) * 64, SEQ}; att_load(s1, kr, vr); }
                if (kb0 <= t0 + TW - 1 && kb0 + 63 >= t0 - 511) {
                    const bool need_mask = !(kb0 + 63 <= t0 && kb0 >= t0 + TW - 1 - 511);
#pragma unroll
                    for (int rt = 0; rt < RT; ++rt) { base0[rt] = -m2w - slope2 * (float)(tpos[rt] - kb0); hi0[rt] = tpos[rt] - kb0; }
                    const bf16_t* Ks = (const bf16_t*)(smem + L::K0 + (i & 1) * KV_TILE); const bf16_t* Vs = (const bf16_t*)(smem + L::V0 + (i & 1) * KV_TILE);
                    att_block<2>(Ks, Vs, qf, O, l, invl, g0, base0, hi0, 511, need_mask, (1u << RT) - 1u, slope2, imp_w, 0, fr, q);
                }
                if (i + 1 < nwb) att_store(smem, (i + 1) & 1, kr, vr);
                __syncthreads();
            }
        }
        bf16_t* YN = (bf16_t*)(ws + O_YNSA);
#pragma unroll
        for (int rt = 0; rt < RT; ++rt) {
            float s = l[rt]; s += __shfl_xor(s, 16); s += __shfl_xor(s, 32);
            const size_t tok = (size_t)b * SEQ + tpos[rt];
            const float cf = (s > 0.f) ? G[tok * 24 + 16 + h] / s : 0.f;
#pragma unroll
            for (int dt = 0; dt < 4; ++dt) { const u32x2 yp = Yp[rt][dt]; const f32x4 yv = {bflo(yp[0]), bfhi(yp[0]), bflo(yp[1]), bfhi(yp[1])};
                *(u32x2*)(YN + tok * 512 + h * 64 + 16 * dt + 4 * q) = pk4(yv + O[rt][dt] * cf); }
        }
        __syncthreads();
    }
}

constexpr int SMEM_MAIN = 128 * 1024, SMEM_BYTES = SMEM_MAIN + 64;
static_assert(AttL::TOTAL <= SMEM_MAIN && NWAVES * S5_WAVE_LDS <= SMEM_MAIN && pg8::STAGE_BYTES <= SMEM_MAIN, "LDS budget");

__global__ void __launch_bounds__(NTHR) k_mega(Ptrs P, TrTable tt) {
    extern __shared__ __attribute__((aligned(16))) char smem[];
    cg::grid_group grid = cg::this_grid();
    const int vb = blockIdx.x, nvb = gridDim.x;
    unsigned char* ws = P.ws;
    volatile __attribute__((address_space(3))) unsigned* bst = (volatile __attribute__((address_space(3))) unsigned*)((__attribute__((address_space(3))) char*)smem + SMEM_MAIN);
    if (threadIdx.x < 2) bst[threadIdx.x] = 0u;
    if (vb == 0) for (int i = threadIdx.x; i < XCD_BAR_WORDS; i += NTHR) ((unsigned*)(ws + O_BAR))[i] = 0u;
    transpose_phase(tt, smem, vb, nvb);
    if (PROBE_REP & 64) transpose_phase(tt, smem, vb, nvb);
    consts_phase(P, vb, nvb);
    rmsnorm1_phase(P, vb, nvb);
    if (PROBE_REP & 64) rmsnorm1_phase(P, vb, nvb);
    grid.sync();
    const XcdBarrier xbar = xcd_barrier_post((unsigned*)(ws + O_BAR), bst);
#define GRID_BAR() xcd_barrier(xbar)
    { pg8::EpiIn E{ws, P.in[19], P.in[20]}; big_gemm(smem, (const bf16_t*)(ws + O_XN), (const bf16_t*)(ws + O_WT_IN), NTOK, NIN, DM, E);
      if (PROBE_REP & 1) big_gemm(smem, (const bf16_t*)(ws + O_XN), (const bf16_t*)(ws + O_WT_IN), NTOK, NIN, DM, E); }
    GRID_BAR();
    compress_phase(P, smem, vb, nvb);
    s5_phase<true>(P, smem, nvb - 1 - vb, nvb);
    if (PROBE_REP & 128) { compress_phase(P, smem, vb, nvb); s5_phase<true>(P, smem, nvb - 1 - vb, nvb); }
    GRID_BAR();
    attn_phase(P, smem, vb, nvb);
    if (PROBE_REP & 2) attn_phase(P, smem, vb, nvb);
    s5_phase<false>(P, smem, vb, nvb);
    if (PROBE_REP & 4) s5_phase<false>(P, smem, vb, nvb);
    GRID_BAR();
    { pg8::EpiGlu E{(const bf16_t*)(ws + O_YG), (bf16_t*)(ws + O_YSSM), P.in[12]}; big_gemm(smem, (const bf16_t*)(ws + O_YG), (const bf16_t*)(ws + O_WT_GLU), NTOK, 512, 512, E); }
    GRID_BAR();
    { pg8::EpiMerge<0> E0{(const bf16_t*)(ws + O_MG), (bf16_t*)(ws + O_MERGED)}; big_gemm(smem, (const bf16_t*)(ws + O_YSSM), (const bf16_t*)(ws + O_WT_PS), NTOK, 1024, 512, E0);
      pg8::EpiMerge<1> E1{(const bf16_t*)(ws + O_MG), (bf16_t*)(ws + O_MERGED)}; big_gemm(smem, (const bf16_t*)(ws + O_YNSA), (const bf16_t*)(ws + O_WT_PN), NTOK, 1024, 512, E1); }
    GRID_BAR();
    { pg8::EpiOut E{P.in[0], P.out, (bf16_t*)(ws + O_X1B), (float*)(ws + O_SSQ)}; big_gemm(smem, (const bf16_t*)(ws + O_MERGED), (const bf16_t*)(ws + O_WT_OUT), NTOK, 1024, 1024, E); }
    GRID_BAR();
    { pg8::EpiUp E{(bf16_t*)(ws + O_FF), (const float*)(ws + O_SSQ)}; big_gemm(smem, (const bf16_t*)(ws + O_X1B), (const bf16_t*)(ws + O_WT_UP), NTOK, DFF, DM, E);
      if (PROBE_REP & 32) big_gemm(smem, (const bf16_t*)(ws + O_X1B), (const bf16_t*)(ws + O_WT_UP), NTOK, DFF, DM, E); }
    GRID_BAR();
    { pg8::EpiDown E{P.out}; big_gemm(smem, (const bf16_t*)(ws + O_FF), (const bf16_t*)(ws + O_WT_DOWN), NTOK, DM, DFF, E); }
}

static void add_tr(TrTable& tt, int& n, const float* src, bf16_t* dst, const float* kscale, int K, int N, int ldsrc, int mode) {
    TrDesc& d = tt.d[n]; d.src = src; d.dst = dst; d.kscale = kscale; d.K = K; d.N = N; d.ldsrc = ldsrc; d.mode = mode; d.tiles_n = N / 64; d.tile0 = tt.total;
    tt.total += (K / 64) * (N / 64); ++n;
}

extern "C" void kernel_launch(void* const* d_in, const int* in_sizes, int n_in, void* d_out, int out_size, void* d_ws, size_t ws_size, hipStream_t stream) {
    if (n_in != 27 || ws_size < WS_END) { fprintf(stderr, "kernel_launch: unexpected n_in %d or ws_size %zu (need %zu)\n", n_in, ws_size, (size_t)WS_END); return; }
    Ptrs P{};
    for (int i = 0; i < 27; ++i) P.in[i] = (const float*)d_in[i];
    P.out = (float*)d_out; P.ws = (unsigned char*)d_ws;
    unsigned char* ws = P.ws;
    TrTable tt{}; int n = 0;
    add_tr(tt, n, P.in[2], (bf16_t*)(ws + O_WT_IN), nullptr, 1024, NIN, 3864, 1);
    add_tr(tt, n, P.in[11], (bf16_t*)(ws + O_WT_GLU), nullptr, 512, 512, 512, 0);
    add_tr(tt, n, P.in[21], (bf16_t*)(ws + O_WT_PS), nullptr, 512, 1024, 1024, 0);
    add_tr(tt, n, P.in[22], (bf16_t*)(ws + O_WT_PN), nullptr, 512, 1024, 1024, 0);
    add_tr(tt, n, P.in[23], (bf16_t*)(ws + O_WT_OUT), nullptr, 1024, 1024, 1024, 0);
    add_tr(tt, n, P.in[25], (bf16_t*)(ws + O_WT_UP), P.in[24], 1024, 4096, 4096, 0);
    add_tr(tt, n, P.in[26], (bf16_t*)(ws + O_WT_DOWN), nullptr, 4096, 1024, 1024, 0);
    add_tr(tt, n, P.in[15], (bf16_t*)(ws + O_WT_CK1), nullptr, 2048, 128, 128, 0);
    add_tr(tt, n, P.in[17], (bf16_t*)(ws + O_WT_CV1), nullptr, 2048, 128, 128, 0);
    add_tr(tt, n, P.in[16], (bf16_t*)(ws + O_WT_CK2), nullptr, 128, 64, 64, 0);
    add_tr(tt, n, P.in[18], (bf16_t*)(ws + O_WT_CV2), nullptr, 128, 64, 64, 0);
    static int grid_blocks = 0;
    if (!grid_blocks) {
        int dev = 0, cus = 0, per_cu = 0;
        (void)hipGetDevice(&dev);
        (void)hipDeviceGetAttribute(&cus, hipDeviceAttributeMultiprocessorCount, dev);
        (void)hipFuncSetAttribute((const void*)k_mega, hipFuncAttributeMaxDynamicSharedMemorySize, SMEM_BYTES);
        (void)hipOccupancyMaxActiveBlocksPerMultiprocessor(&per_cu, k_mega, NTHR, SMEM_BYTES);
        if (per_cu < 1) { fprintf(stderr, "kernel_launch: occupancy query returned %d\n", per_cu); per_cu = 1; }
        grid_blocks = cus;
    }
    void* args[] = {(void*)&P, (void*)&tt};
    hipError_t e = hipLaunchCooperativeKernel((void*)k_mega, dim3(grid_blocks), dim3(NTHR), args, SMEM_BYTES, stream);
    if (e != hipSuccess) fprintf(stderr, "cooperative launch failed: %s (grid %d)\n", hipGetErrorString(e), grid_blocks);
}
```

```cpp
#include <hip/hip_runtime.h>
#include <cstdio>
#include <cstdint>

typedef unsigned short bf16_t;
typedef short bf16x8 __attribute__((ext_vector_type(8)));
typedef float f32x4 __attribute__((ext_vector_type(4)));
typedef unsigned u32x4 __attribute__((ext_vector_type(4)));
typedef unsigned u32x2 __attribute__((ext_vector_type(2)));

#ifndef PROBE_CLK
#define PROBE_CLK 0
#endif
#ifndef PROBE_STAMP
#define PROBE_STAMP -1
#endif
#ifndef PROBE_PARTS
#define PROBE_PARTS 7
#endif
#ifndef PROBE_REP
#define PROBE_REP 0
#endif

constexpr int NB = 4, SEQ = 8192, DM = 1024, NTOK = NB * SEQ;
constexpr int NIN = 4096;
constexpr int DFF = 4096;
constexpr int SEGT = 512, NSEG = SEQ / SEGT;
constexpr float EPS = 1e-6f;
constexpr int NWAVES = 8, NTHR = 512;
constexpr float C1 = 0.18033688011112042f;

constexpr size_t MiB = 1024 * 1024;
constexpr size_t al256(size_t x) { return (x + 255) & ~(size_t)255; }
constexpr size_t O_WT_IN = 0;
constexpr size_t O_WT_GLU = O_WT_IN + (size_t)NIN * 1024 * 2;
constexpr size_t O_WT_PS = O_WT_GLU + 512 * 512 * 2;
constexpr size_t O_WT_PN = O_WT_PS + 1024 * 512 * 2;
constexpr size_t O_WT_OUT = O_WT_PN + 1024 * 512 * 2;
constexpr size_t O_WT_UP = O_WT_OUT + 1024 * 1024 * 2;
constexpr size_t O_WT_DOWN = O_WT_UP + (size_t)4096 * 1024 * 2;
constexpr size_t O_WT_CK1 = O_WT_DOWN + (size_t)4096 * 1024 * 2;
constexpr size_t O_WT_CV1 = O_WT_CK1 + 128 * 2048 * 2;
constexpr size_t O_WT_CK2 = O_WT_CV1 + 128 * 2048 * 2;
constexpr size_t O_WT_CV2 = O_WT_CK2 + 64 * 128 * 2;
constexpr size_t O_B1K = O_WT_CV2 + 64 * 128 * 2;
constexpr size_t O_B1V = O_B1K + 512;
constexpr size_t O_ABAR = O_B1V + 512;
constexpr size_t O_AL = O_ABAR + 32 * 64 * 2 * 4;
constexpr size_t O_BBT = O_AL + 32 * 64 * 2 * 4;
constexpr size_t O_CT = O_BBT + 32 * 128 * 16 * 2;
constexpr size_t O_ENDS = O_CT + 32 * 16 * 128 * 2;
constexpr size_t O_SSQ = O_ENDS + (size_t)NB * NSEG * 32 * 64 * 2 * 4;
constexpr size_t O_GATES = O_SSQ + (size_t)NTOK * 4;
constexpr size_t O_KC = O_GATES + (size_t)NTOK * 24 * 4;
constexpr size_t O_VCT = O_KC + 8 * 512 * 64 * 2;
constexpr size_t O_M2 = O_VCT + 8 * 512 * 64 * 2;
constexpr size_t O_BAR = O_M2 + 4096;
constexpr size_t O_E16 = O_BAR + 16384;
constexpr size_t O_A16 = O_E16 + 32 * 128 * 256 * 2;
constexpr size_t O_REGA = al256(O_A16 + 32 * 64 * 2 * 4);
constexpr size_t O_XN = O_REGA;
constexpr size_t O_YSSM = O_XN;
constexpr size_t O_YNSA = O_XN + 32 * MiB;
constexpr size_t O_U = O_XN + 64 * MiB;
constexpr size_t O_QN = O_U + 32 * MiB;
constexpr size_t O_KCIN = O_QN + 32 * MiB;
constexpr size_t O_VCIN = O_KCIN + 8 * MiB;
constexpr size_t O_KS = O_VCIN + 8 * MiB;
constexpr size_t O_KW = O_KS + 8 * MiB;
constexpr size_t O_YG = O_KW + 8 * MiB;
constexpr size_t O_VST = O_YG + 32 * MiB;
constexpr size_t O_VWT = O_VST + 8 * MiB;
constexpr size_t O_FF = O_REGA;
constexpr size_t O_REGB = O_REGA + 256 * MiB;
constexpr size_t O_MG = O_REGB;
constexpr size_t O_X1B = O_REGB;
constexpr size_t O_MERGED = O_REGB + 128 * MiB;
constexpr size_t WS_END = O_MERGED + 64 * MiB;
static_assert(O_VWT + 8 * MiB <= O_REGB, "region A overflow");

__device__ __forceinline__ float bf2f(bf16_t h) { return __uint_as_float(((unsigned)h) << 16); }
__device__ __forceinline__ float bflo(unsigned w) { return __uint_as_float(w << 16); }
__device__ __forceinline__ float bfhi(unsigned w) { return __uint_as_float(w & 0xffff0000u); }
__device__ __forceinline__ bf16_t f2bf(float f) { unsigned u = __float_as_uint(f); u += 0x7fffu + ((u >> 16) & 1u); return (bf16_t)(u >> 16); }
typedef __bf16 bf16x2_t __attribute__((ext_vector_type(2)));
typedef float f32x2_t __attribute__((ext_vector_type(2)));
__device__ __forceinline__ unsigned pk2(float lo, float hi) { const f32x2_t f = {lo, hi}; const bf16x2_t v = __builtin_convertvector(f, bf16x2_t); return __builtin_bit_cast(unsigned, v); }
__device__ __forceinline__ u32x2 pk4(const f32x4 v) { return (u32x2){pk2(v[0], v[1]), pk2(v[2], v[3])}; }
__device__ __forceinline__ float sigmoidf_(float x) { return __builtin_amdgcn_rcpf(1.0f + __builtin_amdgcn_exp2f(x * -1.4426950408889634f)); }
__device__ __forceinline__ float gelu_tanh(float x) { const float w = __builtin_fmaf(x * x, -0.10294324f, -2.3022082f); return x * __builtin_amdgcn_rcpf(1.0f + __builtin_amdgcn_exp2f(x * w)); }
__device__ __forceinline__ float wave_sum(float v) {
#pragma unroll
    for (int o = 1; o < 64; o <<= 1) v += __shfl_xor(v, o);
    return v;
}

__device__ __forceinline__ int opaque_tid() { int t = threadIdx.x; asm volatile("" : "+v"(t)); return t; }

struct Ptrs {
    const float* in[27];
    float* out;
    unsigned char* ws;
};

struct TrDesc { const float* src; bf16_t* dst; const float* kscale; int K, N, ldsrc, mode, tiles_n, tile0; };
constexpr int NTR = 11;
struct TrTable { TrDesc d[NTR]; int total; int n; };

__device__ __forceinline__ int in_col(int n) {
    const int T = n >> 8, p = n & 255, bj = p >> 7, wc = (p >> 5) & 3, dlo = p & 31;
    const int L = 64 * (4 * T + wc) + 32 * bj + dlo;
    if (L < 1792) return L;
    if (L < 3840) return L + 24;
    if (L < 3864) return L - 3840 + 1792;
    return -1;
}

__device__ __forceinline__ void tr_load(const TrTable& tt, int it, int tid, f32x4 (&v)[2], float (&ks)[2]) {
    int di = 0;
#pragma unroll
    for (int i = 1; i < NTR; ++i) if (i < tt.n && it >= tt.d[i].tile0) di = i;
    const TrDesc& d = tt.d[di];
    const int lt = it - d.tile0, tn = lt % d.tiles_n, tk = lt / d.tiles_n, k0 = tk * 64, n0 = tn * 64;
#pragma unroll
    for (int i = 0; i < 2; ++i) {
        const int kk = (tid >> 4) + 32 * i, nn = (tid & 15) * 4;
        int col = n0 + nn; if (d.mode == 1) col = in_col(col);
        v[i] = (f32x4){0.f, 0.f, 0.f, 0.f};
        if (col >= 0) v[i] = __builtin_nontemporal_load((const f32x4*)(d.src + (size_t)(k0 + kk) * d.ldsrc + col));
        ks[i] = 1.0f; if (d.kscale) ks[i] = d.kscale[k0 + kk];
    }
}
__device__ __forceinline__ void transpose_phase(const TrTable& tt, char* smem, int first, int step, bool pair = false) {
    const int tid = opaque_tid();
#define TR_IT(j_) (pair ? first + ((j_) & 1) + ((j_) >> 1) * step : first + (j_) * step)
    constexpr int TRD = 3;
    f32x4 vq[TRD][2]; float sq[TRD][2];
#pragma unroll
    for (int t = 0; t < TRD; ++t) {
#pragma unroll
        for (int i = 0; i < 2; ++i) { vq[t][i] = (f32x4){0.f, 0.f, 0.f, 0.f}; sq[t][i] = 1.f; }
        if (TR_IT(t) < tt.total) tr_load(tt, TR_IT(t), tid, vq[t], sq[t]);
    }
    for (int j = 0; TR_IT(j) < tt.total; ++j) {
        const int it = TR_IT(j);
        float* tile = (float*)smem + (j & 1) * (64 * 65 + 32);
        int di = 0;
#pragma unroll
        for (int i = 1; i < NTR; ++i) if (i < tt.n && it >= tt.d[i].tile0) di = i;
        const TrDesc& d = tt.d[di];
        const int lt = it - d.tile0, tn = lt % d.tiles_n, tk = lt / d.tiles_n, k0 = tk * 64, n0 = tn * 64;
#pragma unroll
        for (int i = 0; i < 2; ++i) { const int kk = (tid >> 4) + 32 * i, nn = (tid & 15) * 4; float* tp = tile + kk * 65 + nn; const f32x4 w = vq[0][i] * sq[0][i]; tp[0] = w[0]; tp[1] = w[1]; tp[2] = w[2]; tp[3] = w[3]; }
#pragma unroll
        for (int t = 0; t + 1 < TRD; ++t)
#pragma unroll
            for (int i = 0; i < 2; ++i) { vq[t][i] = vq[t + 1][i]; sq[t][i] = sq[t + 1][i]; }
        if (TR_IT(j + TRD) < tt.total) tr_load(tt, TR_IT(j + TRD), tid, vq[TRD - 1], sq[TRD - 1]);
        __syncthreads();
        {
            const int nn = tid >> 3, kc = (tid & 7) * 8; const float* tp = tile + kc * 65 + nn;
            const u32x4 o = {pk2(tp[0], tp[65]), pk2(tp[2 * 65], tp[3 * 65]), pk2(tp[4 * 65], tp[5 * 65]), pk2(tp[6 * 65], tp[7 * 65])};
            *(u32x4*)(d.dst + (size_t)(n0 + nn) * d.K + k0 + kc) = o;
        }
    }
#undef TR_IT
    __syncthreads();
}

__device__ __forceinline__ void consts_phase(const Ptrs& P, int vb, int nvb) {
    const int tid_ = opaque_tid(); const int gt = vb * NTHR + tid_, ngt = nvb * NTHR;
    unsigned char* ws = P.ws;
    for (int i = vb + nvb * tid_; i < 32 * 64; i += ngt) {
        const int g = i >> 6, p = i & 63;
        const float ar = P.in[3][i], ai = P.in[4][i], dt = expf(P.in[5][g]);
        const float mag = expf(ar * dt), abr = mag * cosf(ai * dt), abi = mag * sinf(ai * dt);
        const float den = ar * ar + ai * ai, nr = abr - 1.0f;
        const float fr = (nr * ar + abi * ai) / den, fi = (abi * ar - nr * ai) / den;
        float* ABAR = (float*)(ws + O_ABAR); float* AL = (float*)(ws + O_AL);
        ABAR[i * 2] = abr; ABAR[i * 2 + 1] = abi;
        double pr = (double)abr, pi = (double)abi;
        for (int s = 0; s < 9; ++s) { const double nr2 = pr * pr - pi * pi, ni2 = 2.0 * pr * pi; pr = nr2; pi = ni2; }
        AL[i * 2] = (float)pr; AL[i * 2 + 1] = (float)pi;
        bf16_t* BBT = (bf16_t*)(ws + O_BBT);
        for (int c = 0; c < 16; ++c) {
            const float br = P.in[6][(size_t)i * 16 + c], bi = P.in[7][(size_t)i * 16 + c];
            BBT[((size_t)g * 128 + 2 * p) * 16 + c] = f2bf(fr * br - fi * bi);
            BBT[((size_t)g * 128 + 2 * p + 1) * 16 + c] = f2bf(fr * bi + fi * br);
        }
        bf16_t* CT = (bf16_t*)(ws + O_CT);
        for (int c = 0; c < 16; ++c) {
            CT[((size_t)g * 16 + c) * 128 + 2 * p] = f2bf(P.in[8][((size_t)g * 16 + c) * 64 + p]);
            CT[((size_t)g * 16 + c) * 128 + 2 * p + 1] = f2bf(-P.in[9][((size_t)g * 16 + c) * 64 + p]);
        }
    }
    for (int it = gt; it < 32 * 64 * 16; it += ngt) {
        const int i = it >> 4, s = it & 15, g = i >> 6, p = i & 63;
        const float ar = P.in[3][i], ai = P.in[4][i], dt = expf(P.in[5][g]);
        const float mag = expf(ar * dt), abr = mag * cosf(ai * dt), abi = mag * sinf(ai * dt);
        const float den = ar * ar + ai * ai, nr = abr - 1.0f;
        const float fr = (nr * ar + abi * ai) / den, fi = (abi * ar - nr * ai) / den;
        float wr_ = 1.f, wi_ = 0.f;
        for (int k = 0; k < 15 - s; ++k) { const float nwr = wr_ * abr - wi_ * abi, nwi = wr_ * abi + wi_ * abr; wr_ = nwr; wi_ = nwi; }
        bf16_t* E16 = (bf16_t*)(ws + O_E16) + ((size_t)g * 128 + 2 * p) * 256 + 16 * s;
        for (int c = 0; c < 16; ++c) {
            const float br = P.in[6][(size_t)i * 16 + c], bi = P.in[7][(size_t)i * 16 + c];
            const float bbr = fr * br - fi * bi, bbi = fr * bi + fi * br;
            E16[c] = f2bf(wr_ * bbr - wi_ * bbi); E16[256 + c] = f2bf(wr_ * bbi + wi_ * bbr);
        }
        if (s == 0) { const float nwr = wr_ * abr - wi_ * abi, nwi = wr_ * abi + wi_ * abr; ((float*)(ws + O_A16))[i * 2] = nwr; ((float*)(ws + O_A16))[i * 2 + 1] = nwi; }
    }
    if (gt < 3) {
        float gq = 0.f, gk = 0.f;
        for (int d = 0; d < 64; ++d) { gq = fmaxf(gq, fabsf(P.in[19][d])); gk = fmaxf(gk, fabsf(P.in[20][gt * 64 + d])); }
        ((float*)(ws + O_M2))[gt] = 64.0f * C1 * gq * gk;
    }
    float* SSQ = (float*)(ws + O_SSQ);
    for (int i = gt; i < NTOK; i += ngt) SSQ[i] = 0.f;
    if ((tid_ >> 6) == 0) {
        const int lane = tid_ & 63;
        for (int o = vb; o < 256; o += nvb) {
            const int isv = o >> 7, n = o & 127;
            const float* pe = P.in[isv ? 14 : 13]; const float* w1 = P.in[isv ? 17 : 15];
            float wv[32], pv[32];
#pragma unroll
            for (int i = 0; i < 32; ++i) { wv[i] = w1[(size_t)(lane + 64 * i) * 128 + n]; pv[i] = pe[lane + 64 * i]; }
            float s_ = 0.f;
#pragma unroll
            for (int i = 0; i < 32; ++i) s_ += pv[i] * bflo(pk2(wv[i], 0.f));
            s_ = wave_sum(s_);
            if (lane == 0) ((float*)(ws + (isv ? O_B1V : O_B1K)))[n] = s_;
        }
    }
}

__device__ __forceinline__ void rmsnorm1_phase(const Ptrs& P, int vb, int nvb) {
    const int tid_ = opaque_tid(); const int lane = tid_ & 63, gw = vb * NWAVES + (tid_ >> 6), ngw = nvb * NWAVES;
    const float* x = P.in[0]; const float* g = P.in[1]; bf16_t* XN = (bf16_t*)(P.ws + O_XN);
    f32x4 gg[4];
#pragma unroll
    for (int j = 0; j < 4; ++j) gg[j] = ((const f32x4*)g)[j * 64 + lane];
    f32x4 r0[4], r1[4], r2[4];
    const int nrow = (NTOK - gw + ngw - 1) / ngw;
#define RMS_LOAD(dst, k) do { if ((k) < nrow) { _Pragma("unroll") for (int j = 0; j < 4; ++j) dst[j] = __builtin_nontemporal_load((const f32x4*)(x + (size_t)(gw + (k) * ngw) * DM) + j * 64 + lane); } } while (0)
#define RMS_ROW(src, k) do { if ((k) < nrow) { const int row = gw + (k) * ngw; float ss = 0.f; \
        _Pragma("unroll") for (int j = 0; j < 4; ++j) { const f32x4 v = src[j]; ss += v[0] * v[0] + v[1] * v[1] + v[2] * v[2] + v[3] * v[3]; } \
        ss = wave_sum(ss); const float rstd = rsqrtf(ss * (1.0f / DM) + EPS); \
        _Pragma("unroll") for (int j = 0; j < 4; ++j) ((u32x2*)(XN + (size_t)row * DM))[j * 64 + lane] = pk4(src[j] * gg[j] * rstd); } } while (0)
    RMS_LOAD(r0, 0); RMS_LOAD(r1, 1);
    for (int k = 0; k < nrow; k += 3) {
        RMS_LOAD(r2, k + 2); RMS_ROW(r0, k);
        RMS_LOAD(r0, k + 3); RMS_ROW(r1, k + 1);
        RMS_LOAD(r1, k + 4); RMS_ROW(r2, k + 2);
    }
#undef RMS_LOAD
#undef RMS_ROW
}

namespace pg8 {
#define PG8_LAS __attribute__((address_space(3)))
typedef unsigned short bf16_t;
typedef short bf16x8 __attribute__((ext_vector_type(8)));
typedef float f32x4 __attribute__((ext_vector_type(4)));
typedef unsigned u32x4 __attribute__((ext_vector_type(4)));
constexpr int BM = 256, BK = 64, HALF = 128, HTB = HALF * BK * 2  , STAGE_BYTES = 8 * HTB, NXCD = 8, WGM = 8;

__host__ __device__ __forceinline__ int lds_byte(int r, int c) { const int st = (r >> 4) * 2 + (c >> 5), rr = r & 15, cc = c & 31, ob = rr * 64 + cc * 2; return st * 1024 + (ob ^ (((ob >> 9) & 1) << 5)); }
__host__ __device__ __forceinline__ void stage_rc(int b, int& R, int& C) { const int st = b / 1024, sb = b % 1024, swz = sb ^ (((sb >> 9) & 1) << 5); R = (st >> 1) * 16 + swz / 64; C = (st & 1) * 32 + (swz % 64) / 2; }
__host__ __device__ __forceinline__ int perm32(int rho) { const int n = rho >> 4, i = rho & 15; return 8 * (i >> 2) + 4 * n + (i & 3); }

struct Unit { int pm, pn; };
struct Gemm { const bf16_t* A; const bf16_t* Bt; int M, N, K; const bf16_t* A2; const bf16_t* Bt2; };

struct StaticOrder {
    int nM, nN, nwg, G, c;
    __host__ __device__ void init(int M, int N, int G_, int c_) { nM = M / BM; nN = N / BM; nwg = nM * nN; G = G_; c = c_; }
    __host__ __device__ bool next(int i, Unit& u) const {
        const long L = (long)i * G + c; if (L >= nwg) return false;
        int wgid = (int)L; { const int q = nwg / NXCD, r = nwg % NXCD, xcd = wgid % NXCD, off = wgid / NXCD; wgid = (xcd < r ? xcd * (q + 1) : r * (q + 1) + (xcd - r) * q) + off; }
        const int nig = WGM * nN, gid = wgid / nig, fm = gid * WGM, gsz = (nM - fm) < WGM ? (nM - fm) : WGM;
        u.pm = fm + ((wgid % nig) % gsz); u.pn = (wgid % nig) / gsz; return true;
    }
    __device__ __forceinline__ void a_ready(const Unit&) const {}
    __device__ __forceinline__ void done(const Unit&) const {}
};
__device__ __forceinline__ float pg_row_ssq(const f32x4 (&acc)[2][2][4][2], int ai, int m) {
    float s = 0.f;
#pragma unroll
    for (int bj = 0; bj < 2; ++bj)
#pragma unroll
        for (int n = 0; n < 2; ++n) { const f32x4 v = acc[ai][bj][m][n]; s += (v[0] * v[0] + v[1] * v[1]) + (v[2] * v[2] + v[3] * v[3]); }
    s += __shfl_xor(s, 16); s += __shfl_xor(s, 32);
    return s;
}
__device__ __forceinline__ size_t tiled_off(int row, int col, int N) { return (((size_t)(row >> 4) * (size_t)(N >> 5) + (size_t)(col >> 5)) << 9) + (size_t)(((row & 15) << 5) + (col & 31)); }
__device__ __forceinline__ unsigned tiled_lane(int wr, int wc, int fr, int fq, int N) { return (unsigned)(((4 * wr) * (N >> 5) + wc) << 9) + (unsigned)(fr * 32 + 8 * fq); }
__device__ __forceinline__ constexpr unsigned tiled_sub(int ai, int m, int bj, int N) { return (unsigned)(((8 * ai + m) * (N >> 5) + 4 * bj) << 9); }
__device__ __forceinline__ ::u32x4 pk8(const f32x4 a, const f32x4 b) { const ::u32x2 x = pk4(a), y = pk4(b); return (::u32x4){x[0], x[1], y[0], y[1]}; }
struct EpiIn {
    static constexpr bool PERM = true, AFTER_DRAIN = false;
    unsigned char* ws; const float* gq; const float* gk;
    __device__ __forceinline__ void operator()(const f32x4 (&acc)[2][2][4][2], const Unit& u, int wr, int wc, int fr, int fq) const {
        const int seg = 4 * u.pn + wc, L0 = 64 * seg, row0 = u.pm * BM + wr * 64 + fr;
        if (L0 < 512) {
            ::bf16_t* U = (::bf16_t*)(ws + O_U);
#pragma unroll
            for (int ai = 0; ai < 2; ++ai)
#pragma unroll
                for (int m = 0; m < 4; ++m) { ::bf16_t* rp = U + (size_t)(row0 + ai * HALF + m * 16) * 512 + L0 + 8 * fq;
#pragma unroll
                    for (int bj = 0; bj < 2; ++bj) *(::u32x4*)(rp + 32 * bj) = pk8(acc[ai][bj][m][0], acc[ai][bj][m][1]); }
        } else if (L0 < 1024) {
            ::bf16_t* QN = (::bf16_t*)(ws + O_QN);
            f32x4 gqr[2][2];
#pragma unroll
            for (int bj = 0; bj < 2; ++bj) { gqr[bj][0] = *(const f32x4*)(gq + 32 * bj + 8 * fq); gqr[bj][1] = *(const f32x4*)(gq + 32 * bj + 8 * fq + 4); }
#pragma unroll
            for (int ai = 0; ai < 2; ++ai)
#pragma unroll
                for (int m = 0; m < 4; ++m) { const float rs = rsqrtf(pg_row_ssq(acc, ai, m) * (1.0f / 64) + EPS) * C1;
                    ::bf16_t* rp = QN + (size_t)(row0 + ai * HALF + m * 16) * 512 + (L0 - 512) + 8 * fq;
#pragma unroll
                    for (int bj = 0; bj < 2; ++bj) *(::u32x4*)(rp + 32 * bj) = pk8(acc[ai][bj][m][0] * gqr[bj][0] * rs, acc[ai][bj][m][1] * gqr[bj][1] * rs); }
        } else if (L0 < 1792) {
            const int idx = (L0 - 1024) >> 6, br = idx >> 2, isv = (idx >> 1) & 1, g = idx & 1;
            if (!isv || br == 0) {
                ::bf16_t* dst = (::bf16_t*)(ws + (br == 0 ? (isv ? O_VCIN : O_KCIN) : (br == 1 ? O_KS : O_KW)));
                const bool donorm = br > 0; const float* gkk = gk + br * 64;
                f32x4 gkr_[2][2];
#pragma unroll
                for (int bj = 0; bj < 2; ++bj) { gkr_[bj][0] = *(const f32x4*)(gkk + 32 * bj + 8 * fq); gkr_[bj][1] = *(const f32x4*)(gkk + 32 * bj + 8 * fq + 4); }
#pragma unroll
                for (int ai = 0; ai < 2; ++ai)
#pragma unroll
                    for (int m = 0; m < 4; ++m) { const int r = row0 + ai * HALF + m * 16, b = r >> 13, s = r & 8191;
                        float rs = 1.f; if (donorm) rs = rsqrtf(pg_row_ssq(acc, ai, m) * (1.0f / 64) + EPS);
                        ::bf16_t* rp = dst + ((size_t)(b * 2 + g) * SEQ + s) * 64 + 8 * fq;
#pragma unroll
                        for (int bj = 0; bj < 2; ++bj) { f32x4 v0 = acc[ai][bj][m][0], v1 = acc[ai][bj][m][1];
                            if (donorm) { v0 = v0 * gkr_[bj][0] * rs; v1 = v1 * gkr_[bj][1] * rs; }
                            *(::u32x4*)(rp + 32 * bj) = pk8(v0, v1); } }
            } else {
                ::bf16_t* dst = (::bf16_t*)(ws + (br == 1 ? O_VST : O_VWT));
#pragma unroll
                for (int ai = 0; ai < 2; ++ai)
#pragma unroll
                    for (int m = 0; m < 4; ++m) { const int r = row0 + ai * HALF + m * 16, b = r >> 13, s = r & 8191;
#pragma unroll
                        for (int bj = 0; bj < 2; ++bj)
#pragma unroll
                            for (int n = 0; n < 2; ++n) { const ::u32x2 o = pk4(acc[ai][bj][m][n]); ::bf16_t* dT = dst + ((size_t)(b * 2 + g) * 64 + 32 * bj + 8 * fq + 4 * n) * SEQ + s;
                                dT[0] = (::bf16_t)(o[0] & 0xffff); dT[SEQ] = (::bf16_t)(o[0] >> 16); dT[2 * SEQ] = (::bf16_t)(o[1] & 0xffff); dT[3 * SEQ] = (::bf16_t)(o[1] >> 16); } }
            }
        } else if (L0 < 3840) {
            ::bf16_t* MG = (::bf16_t*)(ws + O_MG);
#pragma unroll
            for (int ai = 0; ai < 2; ++ai)
#pragma unroll
                for (int m = 0; m < 4; ++m) { ::bf16_t* rp = MG + (size_t)(row0 + ai * HALF + m * 16) * 2048 + (L0 - 1792) + 8 * fq;
#pragma unroll
                    for (int bj = 0; bj < 2; ++bj) { const f32x4 v = acc[ai][bj][m][0], w = acc[ai][bj][m][1];
                        *(::u32x4*)(rp + 32 * bj) = (::u32x4){pk2(sigmoidf_(v[0]), sigmoidf_(v[1])), pk2(sigmoidf_(v[2]), sigmoidf_(v[3])), pk2(sigmoidf_(w[0]), sigmoidf_(w[1])), pk2(sigmoidf_(w[2]), sigmoidf_(w[3]))}; } }
        } else if (L0 == 3840) {
            float* G = (float*)(ws + O_GATES);
#pragma unroll
            for (int ai = 0; ai < 2; ++ai)
#pragma unroll
                for (int m = 0; m < 4; ++m)
#pragma unroll
                    for (int n = 0; n < 2; ++n) { const int c = 8 * fq + 4 * n;
                        if (c < 24) { const f32x4 v = acc[ai][0][m][n]; *(f32x4*)(G + (size_t)(row0 + ai * HALF + m * 16) * 24 + c) = (f32x4){sigmoidf_(v[0]), sigmoidf_(v[1]), sigmoidf_(v[2]), sigmoidf_(v[3])}; } }
        }
    }
};
#define PG_EPI_LOOP(...) \
    _Pragma("unroll") for (int ai = 0; ai < 2; ++ai) _Pragma("unroll") for (int m = 0; m < 4; ++m) { const int row = u.pm * BM + ai * HALF + wr * 64 + m * 16 + fr; \
        _Pragma("unroll") for (int bj = 0; bj < 2; ++bj) _Pragma("unroll") for (int n = 0; n < 2; ++n) { const int col = u.pn * BM + bj * HALF + wc * 32 + 8 * fq + 4 * n; const f32x4 v = acc[ai][bj][m][n]; __VA_ARGS__ } }
struct EpiGlu {
    static constexpr bool PERM = true, AFTER_DRAIN = false;
    const ::bf16_t* YG; ::bf16_t* YS; const float* bias;
    __device__ __forceinline__ void operator()(const f32x4 (&acc)[2][2][4][2], const Unit& u, int wr, int wc, int fr, int fq) const {
        const size_t ub_ = tiled_off(u.pm * BM, u.pn * BM, 512); const ::bf16_t* ygb_ = YG + ub_; ::bf16_t* ysb_ = YS + ub_; const unsigned gl_ = tiled_lane(wr, wc, fr, fq, 512);
        f32x4 br_[2][2];
#pragma unroll
        for (int bj = 0; bj < 2; ++bj) { const int col = u.pn * BM + bj * HALF + wc * 32 + 8 * fq; br_[bj][0] = *(const f32x4*)(bias + col); br_[bj][1] = *(const f32x4*)(bias + col + 4); }
#pragma unroll
        for (int ai = 0; ai < 2; ++ai)
#pragma unroll
            for (int m = 0; m < 4; ++m) { const int row = u.pm * BM + ai * HALF + wr * 64 + m * 16 + fr;
#pragma unroll
                for (int bj = 0; bj < 2; ++bj) { const int col = u.pn * BM + bj * HALF + wc * 32 + 8 * fq;
                    const unsigned off = gl_ + tiled_sub(ai, m, bj, 512); const ::u32x4 yy = *(const ::u32x4*)(ygb_ + off);
                    const f32x4 b0 = br_[bj][0], b1 = br_[bj][1]; const f32x4 v0 = acc[ai][bj][m][0], v1 = acc[ai][bj][m][1];
                    *(::u32x4*)(ysb_ + off) = (::u32x4){pk2(bflo(yy[0]) * sigmoidf_(v0[0] + b0[0]), bfhi(yy[0]) * sigmoidf_(v0[1] + b0[1])), pk2(bflo(yy[1]) * sigmoidf_(v0[2] + b0[2]), bfhi(yy[1]) * sigmoidf_(v0[3] + b0[3])),
                                                     pk2(bflo(yy[2]) * sigmoidf_(v1[0] + b1[0]), bfhi(yy[2]) * sigmoidf_(v1[1] + b1[1])), pk2(bflo(yy[3]) * sigmoidf_(v1[2] + b1[2]), bfhi(yy[3]) * sigmoidf_(v1[3] + b1[3]))}; } }
    }
};
struct EpiMergeDual {
    static constexpr bool PERM = true, AFTER_DRAIN = false;
    const ::bf16_t* MG; ::bf16_t* ME;
    __device__ __forceinline__ void mid(f32x4 (&acc)[2][2][4][2], const Unit& u, int wr, int wc, int fr, int fq) const {
#pragma unroll
        for (int ai = 0; ai < 2; ++ai)
#pragma unroll
            for (int m = 0; m < 4; ++m) { const int row = u.pm * BM + ai * HALF + wr * 64 + m * 16 + fr;
#pragma unroll
                for (int bj = 0; bj < 2; ++bj) { const int colb = u.pn * BM + bj * HALF + wc * 32 + 8 * fq;
                    const ::u32x4 g0w = *(const ::u32x4*)(MG + (size_t)row * 2048 + colb), g1w = *(const ::u32x4*)(MG + (size_t)row * 2048 + 1024 + colb);
#pragma unroll
                    for (int n = 0; n < 2; ++n) { const ::u32x2 g0 = {g0w[2 * n], g0w[2 * n + 1]}, g1 = {g1w[2 * n], g1w[2 * n + 1]};
                        const f32x4 r = {bflo(g0[0]) * __builtin_amdgcn_rcpf(fmaxf(bflo(g1[0]), 1e-30f)), bfhi(g0[0]) * __builtin_amdgcn_rcpf(fmaxf(bfhi(g1[0]), 1e-30f)), bflo(g0[1]) * __builtin_amdgcn_rcpf(fmaxf(bflo(g1[1]), 1e-30f)), bfhi(g0[1]) * __builtin_amdgcn_rcpf(fmaxf(bfhi(g1[1]), 1e-30f))};
                        acc[ai][bj][m][n] = acc[ai][bj][m][n] * r; } } }
    }
    __device__ __forceinline__ void operator()(const f32x4 (&acc)[2][2][4][2], const Unit& u, int wr, int wc, int fr, int fq) const {
#pragma unroll
        for (int ai = 0; ai < 2; ++ai)
#pragma unroll
            for (int m = 0; m < 4; ++m) { const int row = u.pm * BM + ai * HALF + wr * 64 + m * 16 + fr;
#pragma unroll
                for (int bj = 0; bj < 2; ++bj) { const int col = u.pn * BM + bj * HALF + wc * 32 + 8 * fq;
                    const ::u32x4 g1 = *(const ::u32x4*)(MG + (size_t)row * 2048 + 1024 + col); const f32x4 v = acc[ai][bj][m][0], w = acc[ai][bj][m][1];
                    const f32x4 o0 = {bflo(g1[0]) * v[0], bfhi(g1[0]) * v[1], bflo(g1[1]) * v[2], bfhi(g1[1]) * v[3]}, o1 = {bflo(g1[2]) * w[0], bfhi(g1[2]) * w[1], bflo(g1[3]) * w[2], bfhi(g1[3]) * w[3]};
                    *(::u32x4*)(ME + tiled_off(row, col, 1024)) = pk8(o0, o1); } }
    }
};
struct EpiOut {
    static constexpr bool PERM = true, AFTER_DRAIN = false;
    const float* x; ::bf16_t* X1B; float* SSQ;
    __device__ __forceinline__ void operator()(const f32x4 (&acc)[2][2][4][2], const Unit& u, int wr, int wc, int fr, int fq) const {
#pragma unroll
        for (int ai = 0; ai < 2; ++ai)
#pragma unroll
            for (int m = 0; m < 4; ++m) { const int row = u.pm * BM + ai * HALF + wr * 64 + m * 16 + fr; float s = 0.f;
#pragma unroll
                for (int bj = 0; bj < 2; ++bj) { const size_t off = (size_t)row * 1024 + u.pn * BM + bj * HALF + wc * 32 + 8 * fq;
                    const f32x4 o0 = acc[ai][bj][m][0] + *(const f32x4*)(x + off), o1 = acc[ai][bj][m][1] + *(const f32x4*)(x + off + 4);
                    const ::u32x2 p0 = pk4(o0), p1 = pk4(o1); *(::u32x4*)(X1B + tiled_off(row, u.pn * BM + bj * HALF + wc * 32 + 8 * fq, 1024)) = (::u32x4){p0[0], p0[1], p1[0], p1[1]};
                    s += ((o0[0] * o0[0] + o0[1] * o0[1]) + (o0[2] * o0[2] + o0[3] * o0[3])) + ((o1[0] * o1[0] + o1[1] * o1[1]) + (o1[2] * o1[2] + o1[3] * o1[3])); }
                s += __shfl_xor(s, 16); s += __shfl_xor(s, 32);
                if (fq == 0) atomicAdd(SSQ + row, s); }
    }
};
struct EpiUp {
    static constexpr bool PERM = true, AFTER_DRAIN = false;
    ::bf16_t* FF; const float* SSQ;
    __device__ __forceinline__ void operator()(const f32x4 (&acc)[2][2][4][2], const Unit& u, int wr, int wc, int fr, int fq) const {
#pragma unroll
        for (int ai = 0; ai < 2; ++ai)
#pragma unroll
            for (int m = 0; m < 4; ++m) { const int row = u.pm * BM + ai * HALF + wr * 64 + m * 16 + fr; const float rstd = rsqrtf(SSQ[row] * (1.0f / DM) + EPS);
#pragma unroll
                for (int bj = 0; bj < 2; ++bj) { f32x4 v0 = acc[ai][bj][m][0], v1 = acc[ai][bj][m][1];
#pragma unroll
                    for (int r = 0; r < 4; ++r) { const float a = fmaxf(v0[r], 0.f) * rstd, b_ = fmaxf(v1[r], 0.f) * rstd; v0[r] = a * a; v1[r] = b_ * b_; }
                    *(::u32x4*)(FF + tiled_off(row, u.pn * BM + bj * HALF + wc * 32 + 8 * fq, DFF)) = pk8(v0, v1); } }
    }
};
struct EpiDown {
    static constexpr bool PERM = true, AFTER_DRAIN = false;
    const ::bf16_t* X1B; float* out;
    __device__ __forceinline__ void operator()(const f32x4 (&acc)[2][2][4][2], const Unit& u, int wr, int wc, int fr, int fq) const {
#pragma unroll
        for (int ai = 0; ai < 2; ++ai)
#pragma unroll
            for (int m = 0; m < 4; ++m) { const int row = u.pm * BM + ai * HALF + wr * 64 + m * 16 + fr;
#pragma unroll
                for (int bj = 0; bj < 2; ++bj) { const size_t off = (size_t)row * 1024 + u.pn * BM + bj * HALF + wc * 32 + 8 * fq; const ::u32x4 xx = *(const ::u32x4*)(X1B + tiled_off(row, u.pn * BM + bj * HALF + wc * 32 + 8 * fq, 1024));
                    *(f32x4*)(out + off) = acc[ai][bj][m][0] + (f32x4){bflo(xx[0]), bfhi(xx[0]), bflo(xx[1]), bfhi(xx[1])};
                    *(f32x4*)(out + off + 4) = acc[ai][bj][m][1] + (f32x4){bflo(xx[2]), bfhi(xx[2]), bflo(xx[3]), bfhi(xx[3])}; } }
    }
};

template <class Epi, class Sched, bool ALIGN_EPI = false, bool SP2 = false, bool DUAL = false, bool ATILED = false>
__device__ __forceinline__ void gemm_phase(PG8_LAS unsigned char* lds, const Gemm g, const Sched& S, const Epi& E) {
    const int tid = opaque_tid(), wid = __builtin_amdgcn_readfirstlane(tid >> 6), lane = tid & 63, wr = wid >> 2, wc = wid & 3, fr = lane & 15, fq = lane >> 4;
    const int K = g.K, hK = K / BK, nt = DUAL ? 2 * hK : hK;
    unsigned voffA[2], voffB[2];
#pragma unroll
    for (int i = 0; i < 2; ++i) { int R, C; stage_rc(tid * 16 + i * 8192, R, C); const int Rb = Epi::PERM ? ((R & ~31) + perm32(R & 31)) : R;
        voffA[i] = ATILED ? (unsigned)(((R >> 4) * (K >> 5) + (C >> 5)) * 1024 + ((R & 15) * 32 + (C & 31)) * 2) : (unsigned)(R * K + C) * 2u; voffB[i] = (unsigned)(Rb * K + C) * 2u; }
    const size_t kstep = (size_t)(BK * 2);
    const size_t kstepA = ATILED ? (size_t)2048 : kstep;
    const size_t hstep = (size_t)HALF * K * 2;
    const size_t tstep = 2 * hstep;
    const unsigned ldsw = (unsigned)wid * 1024u;
    const int aoff = lds_byte(wr * 64 + fr, fq * 8), boff = lds_byte(wc * 32 + fr, fq * 8);
#define PG8_SA(b, h) (((b) * 2 + (h)) * HTB)
#define PG8_SB(b, h) ((4 + (b) * 2 + (h)) * HTB)
#define PG8_STAGE(bufoff, gbase, voff) do { _Pragma("unroll") for (int _i = 0; _i < 2; ++_i) \
        __builtin_amdgcn_global_load_lds((const unsigned*)((const char*)(gbase) + (voff)[_i]), (PG8_LAS unsigned*)(lds + (bufoff) + ldsw + _i * 8192), 16, 0, 0); } while (0)
#define PG8_LDA(dst, b, h) do { _Pragma("unroll") for (int m = 0; m < 4; ++m) _Pragma("unroll") for (int k = 0; k < 2; ++k) dst[m][k] = *(const PG8_LAS bf16x8*)(lds + PG8_SA(b, h) + aoff + m * 2048 + k * 1024); } while (0)
#define PG8_LDB(dst, b, h) do { _Pragma("unroll") for (int n = 0; n < 2; ++n) _Pragma("unroll") for (int k = 0; k < 2; ++k) dst[n][k] = *(const PG8_LAS bf16x8*)(lds + PG8_SB(b, h) + boff + n * 2048 + k * 1024); } while (0)
#define PG8_MMA(ai, bj, At, Bt) do { __builtin_amdgcn_s_setprio(1); _Pragma("unroll") for (int m = 0; m < 4; ++m) _Pragma("unroll") for (int n = 0; n < 2; ++n) _Pragma("unroll") for (int k = 0; k < 2; ++k) \
        acc[ai][bj][m][n] = __builtin_amdgcn_mfma_f32_16x16x32_bf16(Bt[n][k], At[m][k], acc[ai][bj][m][n], 0, 0, 0); __builtin_amdgcn_s_setprio(0); } while (0)
#define PG8_WAIT_V(n) asm volatile("s_waitcnt vmcnt(" #n ")" ::: "memory")
#define PG8_WAIT_L(n) asm volatile("s_waitcnt lgkmcnt(" #n ")" ::: "memory")
#define PG8_BAR __builtin_amdgcn_s_barrier()
#define PG8_SCHED __builtin_amdgcn_sched_barrier(0)
    Unit cur, nxt; int ui = 0;
    if (!S.next(0, cur)) return;
    f32x4 acc[2][2][4][2];
#pragma unroll
    for (int a = 0; a < 2; ++a)
#pragma unroll
        for (int b = 0; b < 2; ++b)
#pragma unroll
            for (int m = 0; m < 4; ++m)
#pragma unroll
                for (int n = 0; n < 2; ++n) acc[a][b][m][n] = (f32x4){0.f, 0.f, 0.f, 0.f};
    bf16x8 At[4][2], B0[2][2], B1[2][2];
    const char* cA = (const char*)g.A + (size_t)cur.pm * tstep; const char* cB = (const char*)g.Bt + (size_t)cur.pn * tstep;
    const char* cA2 = DUAL ? (const char*)g.A2 + (size_t)cur.pm * tstep : cA; const char* cB2 = DUAL ? (const char*)g.Bt2 + (size_t)cur.pn * tstep : cB;
    S.a_ready(cur);
    if constexpr (SP2) {
        PG8_STAGE(PG8_SB(0, 0), cB, voffB); PG8_STAGE(PG8_SB(0, 1), cB + hstep, voffB); PG8_STAGE(PG8_SA(0, 0), cA, voffA); PG8_STAGE(PG8_SA(0, 1), cA + hstep, voffA);
        if (wr == 1) PG8_BAR;
        PG8_WAIT_V(2); PG8_BAR;
        PG8_STAGE(PG8_SB(1, 0), cB + kstep, voffB); PG8_STAGE(PG8_SA(1, 0), cA + kstepA, voffA); PG8_STAGE(PG8_SB(1, 1), cB + hstep + kstep, voffB);
        PG8_WAIT_V(6); PG8_BAR;
    } else {
        PG8_STAGE(PG8_SB(0, 0), cB, voffB); PG8_STAGE(PG8_SA(0, 0), cA, voffA); PG8_STAGE(PG8_SB(0, 1), cB + hstep, voffB); PG8_STAGE(PG8_SA(0, 1), cA + hstep, voffA);
        if (wr == 1) PG8_BAR;
        PG8_WAIT_V(4); PG8_BAR;
        PG8_STAGE(PG8_SB(1, 0), cB + kstep, voffB); PG8_STAGE(PG8_SA(1, 0), cA + kstepA, voffA); PG8_STAGE(PG8_SB(1, 1), cB + hstep + kstep, voffB);
        PG8_WAIT_V(6); PG8_BAR;
    }
    for (;;) {
        const bool has_next = S.next(ui + 1, nxt);
        const char* nA = has_next ? (const char*)g.A + (size_t)nxt.pm * tstep : cA; const char* nB = has_next ? (const char*)g.Bt + (size_t)nxt.pn * tstep : cB;
        const char* nA2 = (DUAL && has_next) ? (const char*)g.A2 + (size_t)nxt.pm * tstep : cA2; const char* nB2 = (DUAL && has_next) ? (const char*)g.Bt2 + (size_t)nxt.pn * tstep : cB2;
        for (int t = 0; t < nt; t += 2) {
            const bool last = (t == nt - 2);
            if constexpr (DUAL) { if (t == hK) E.mid(acc, cur, wr, wc, fr, fq); }
            const bool p2a = DUAL && (t >= hK), p2b = DUAL && (t + 2 >= hK);
            const char* a1 = p2a ? cA2 + (size_t)(t + 1 - hK) * kstepA : cA + (size_t)(t + 1) * kstepA;
            const char* a2 = last ? nA : (p2b ? cA2 + (size_t)(t + 2 - hK) * kstepA : cA + (size_t)(t + 2) * kstepA);
            const char* b2 = last ? nB : (p2b ? cB2 + (size_t)(t + 2 - hK) * kstep : cB + (size_t)(t + 2) * kstep);
            const char* a3 = a2 + kstepA; const char* b3 = b2 + kstep;
            if (last && has_next) S.a_ready(nxt);
            if constexpr (SP2) {
            PG8_LDB(B0, 0, 0); PG8_LDB(B1, 0, 1); PG8_SCHED; PG8_LDA(At, 0, 0); PG8_STAGE(PG8_SA(1, 1), a1 + hstep, voffA);
            PG8_WAIT_V(8); PG8_WAIT_L(0); PG8_BAR; PG8_MMA(0, 0, At, B0); PG8_MMA(0, 1, At, B1); PG8_BAR; PG8_SCHED;
            PG8_LDA(At, 0, 1); PG8_STAGE(PG8_SB(0, 0), b2, voffB); PG8_STAGE(PG8_SB(0, 1), b2 + hstep, voffB); PG8_STAGE(PG8_SA(0, 0), a2, voffA);
            PG8_WAIT_V(8); PG8_WAIT_L(0); PG8_BAR; PG8_MMA(1, 0, At, B0); PG8_MMA(1, 1, At, B1); PG8_BAR; PG8_SCHED;
            PG8_LDB(B0, 1, 0); PG8_LDB(B1, 1, 1); PG8_SCHED; PG8_LDA(At, 1, 0); PG8_STAGE(PG8_SA(0, 1), a2 + hstep, voffA);
            PG8_WAIT_V(8); PG8_WAIT_L(0); PG8_BAR; PG8_MMA(0, 0, At, B0); PG8_MMA(0, 1, At, B1); PG8_BAR; PG8_SCHED;
            PG8_LDA(At, 1, 1); PG8_STAGE(PG8_SB(1, 0), b3, voffB); PG8_STAGE(PG8_SB(1, 1), b3 + hstep, voffB); PG8_STAGE(PG8_SA(1, 0), a3, voffA);
            PG8_WAIT_V(8); PG8_WAIT_L(0); PG8_BAR; PG8_MMA(1, 0, At, B0); PG8_MMA(1, 1, At, B1); PG8_BAR; PG8_SCHED;
            } else {
            PG8_LDB(B0, 0, 0); PG8_SCHED; PG8_LDA(At, 0, 0); PG8_STAGE(PG8_SA(1, 1), a1 + hstep, voffA);
            PG8_WAIT_L(8); PG8_BAR; PG8_WAIT_L(0); PG8_MMA(0, 0, At, B0); PG8_BAR; PG8_SCHED;
            PG8_LDB(B1, 0, 1); PG8_STAGE(PG8_SB(0, 0), b2, voffB);
            PG8_BAR; PG8_WAIT_L(0); PG8_MMA(0, 1, At, B1); PG8_BAR;
            PG8_LDA(At, 0, 1); PG8_STAGE(PG8_SA(0, 0), a2, voffA);
            PG8_BAR; PG8_WAIT_L(0); PG8_MMA(1, 0, At, B0); PG8_BAR; PG8_SCHED;
            PG8_STAGE(PG8_SB(0, 1), b2 + hstep, voffB);
            PG8_WAIT_V(6); PG8_BAR; PG8_MMA(1, 1, At, B1); PG8_BAR;
            PG8_LDB(B0, 1, 0); PG8_SCHED; PG8_LDA(At, 1, 0); PG8_STAGE(PG8_SA(0, 1), a2 + hstep, voffA);
            PG8_WAIT_L(8); PG8_BAR; PG8_WAIT_L(0); PG8_MMA(0, 0, At, B0); PG8_BAR; PG8_SCHED;
            PG8_LDB(B1, 1, 1); PG8_STAGE(PG8_SB(1, 0), b3, voffB);
            PG8_BAR; PG8_WAIT_L(0); PG8_MMA(0, 1, At, B1); PG8_BAR;
            PG8_LDA(At, 1, 1); PG8_STAGE(PG8_SA(1, 0), a3, voffA);
            PG8_BAR; PG8_WAIT_L(0); PG8_MMA(1, 0, At, B0); PG8_BAR; PG8_SCHED;
            PG8_STAGE(PG8_SB(1, 1), b3 + hstep, voffB);
            PG8_WAIT_V(6); PG8_BAR; PG8_MMA(1, 1, At, B1); PG8_BAR;
            }
        }
        if constexpr (ALIGN_EPI) { if (wr == 0) PG8_BAR; }
        if constexpr (!Epi::AFTER_DRAIN) { E(acc, cur, wr, wc, fr, fq); S.done(cur); }
        if (!has_next) break;
#pragma unroll
        for (int a = 0; a < 2; ++a)
#pragma unroll
            for (int b = 0; b < 2; ++b)
#pragma unroll
                for (int m = 0; m < 4; ++m)
#pragma unroll
                    for (int n = 0; n < 2; ++n) acc[a][b][m][n] = (f32x4){0.f, 0.f, 0.f, 0.f};
        cur = nxt; cA = nA; cB = nB; cA2 = nA2; cB2 = nB2; ++ui;
        if constexpr (ALIGN_EPI) { if (wr == 1) PG8_BAR; }
    }
    PG8_WAIT_V(0);
    if constexpr (!ALIGN_EPI) { if (wr == 0) PG8_BAR; }
    PG8_BAR;
    if constexpr (Epi::AFTER_DRAIN) { E.fused(acc, cur, wr, wc, fr, fq, lds, wid, lane); S.done(cur); }
#undef PG8_SA
#undef PG8_SB
#undef PG8_STAGE
#undef PG8_LDA
#undef PG8_LDB
#undef PG8_MMA
#undef PG8_WAIT_V
#undef PG8_WAIT_L
#undef PG8_BAR
#undef PG8_SCHED
}
}
#define XB_TMO      128
#define XB_XCNT(j)  (256  + 64 * (j))
#define XB_XSUB(j)  (1280 + 64 * (j))
#define XB_XGEN(j)  (2304 + 64 * (j))
#define XB_TOP      3328
#define XB_TOPGEN   3392
#define XCD_BAR_WORDS 3456
#define XB_SPIN_CAP (1u << 18)

__device__ __forceinline__ unsigned xb_ld(unsigned* p)              { return __hip_atomic_load(p, __ATOMIC_RELAXED, __HIP_MEMORY_SCOPE_AGENT); }
__device__ __forceinline__ unsigned xb_add(unsigned* p, unsigned v) { return __hip_atomic_fetch_add(p, v, __ATOMIC_RELAXED, __HIP_MEMORY_SCOPE_AGENT); }
__device__ __forceinline__ unsigned xb_xcc_id() { return (unsigned)__builtin_amdgcn_s_getreg((3 << 11) | 20) & 0xFu; }
#define XB_SPIN(cond, bar) do { unsigned _sp = 0; while (cond) { __builtin_amdgcn_s_sleep(1); \
    if ((++_sp & 255u) == 0u) { if (xb_ld(&(bar)[XB_TMO])) break; if (_sp > XB_SPIN_CAP) { atomicAdd(&(bar)[XB_TMO], 1u); break; } } } } while (0)

struct XcdBarrier {
    unsigned* bar; unsigned x;
    volatile __attribute__((address_space(3))) unsigned* st;
};

__device__ __forceinline__ XcdBarrier xcd_barrier_post(unsigned* bar, volatile __attribute__((address_space(3))) unsigned* st) {
    XcdBarrier b; b.bar = bar; b.x = xb_xcc_id(); b.st = st;
    if (threadIdx.x == 0) (void)xb_add(&bar[XB_XCNT(b.x)], 1u);
    return b;
}
__device__ __forceinline__ void xcd_barrier_complete(unsigned* bar, unsigned x, unsigned& nloc, unsigned& nx) {
    const unsigned G = gridDim.x * gridDim.y * gridDim.z;
    unsigned sum, cnt, mine, sp = 0u;
    for (;;) {
        sum = 0u; cnt = 0u; mine = 0u;
#pragma unroll
        for (unsigned j = 0; j < 16; ++j) { const unsigned c = xb_ld(&bar[XB_XCNT(j)]); sum += c; cnt += (c > 0u) ? 1u : 0u; mine = (j == x) ? c : mine; }
        if (sum == G) break;
        __builtin_amdgcn_s_sleep(1);
        if ((++sp & 255u) == 0u) { if (xb_ld(&bar[XB_TMO])) break; if (sp > XB_SPIN_CAP) { atomicAdd(&bar[XB_TMO], 1u); break; } }
    }
    nloc = mine > 0u ? mine : 1u; nx = cnt > 0u ? cnt : 1u;
}

__device__ __forceinline__ void xcd_barrier(const XcdBarrier& b) {
    asm volatile("s_waitcnt vmcnt(0)" ::: "memory");
    __syncthreads();
    if (threadIdx.x == 0) {
        unsigned* bar = b.bar;
        __builtin_amdgcn_s_waitcnt(0);
        unsigned nloc = b.st[0], nx = b.st[1];
        if (nloc == 0u) { xcd_barrier_complete(bar, b.x, nloc, nx); b.st[0] = nloc; b.st[1] = nx; }
        const unsigned old = xb_add(&bar[XB_XSUB(b.x)], 1u);
        const unsigned gen = old / nloc;
        if (old + 1u == (gen + 1u) * nloc) {
            __builtin_amdgcn_fence(__ATOMIC_RELEASE, "agent");
            asm volatile("s_waitcnt vmcnt(0)" ::: "memory");
            const unsigned og = xb_add(&bar[XB_TOP], 1u);
            const unsigned tg = og / nx;
            if (og + 1u == (tg + 1u) * nx) xb_add(&bar[XB_TOPGEN], 1u);
            else XB_SPIN(xb_ld(&bar[XB_TOPGEN]) == tg, bar);
            __builtin_amdgcn_fence(__ATOMIC_ACQUIRE, "agent");
            xb_add(&bar[XB_XGEN(b.x)], 1u);
            asm volatile("s_waitcnt vmcnt(0)" ::: "memory");
        } else {
            XB_SPIN(xb_ld(&bar[XB_XGEN(b.x)]) == gen, bar);
            __builtin_amdgcn_fence(__ATOMIC_ACQUIRE, "agent");
            asm volatile("s_waitcnt vmcnt(0)" ::: "memory");
        }
    }
    __syncthreads();
}

typedef __attribute__((address_space(3))) unsigned char lds_u8;

template <class Epi, bool ATILED = false>
__device__ __forceinline__ void big_gemm(char* smem, const bf16_t* A, const bf16_t* Bt, int M, int N, int K, const Epi& E) {
    pg8::Gemm g{A, Bt, M, N, K, nullptr, nullptr}; pg8::StaticOrder S; S.init(M, N, (int)gridDim.x, (int)blockIdx.x);
    pg8::gemm_phase<Epi, pg8::StaticOrder, true, true, false, ATILED>((lds_u8*)smem, g, S, E);
}
template <class Epi, bool ATILED = false>
__device__ __forceinline__ void big_gemm_dual(char* smem, const bf16_t* A, const bf16_t* Bt, const bf16_t* A2, const bf16_t* Bt2, int M, int N, int K, const Epi& E) {
    pg8::Gemm g{A, Bt, M, N, K, A2, Bt2}; pg8::StaticOrder S; S.init(M, N, (int)gridDim.x, (int)blockIdx.x);
    pg8::gemm_phase<Epi, pg8::StaticOrder, true, true, true, ATILED>((lds_u8*)smem, g, S, E);
}

constexpr int LSTR = 72;
__device__ __forceinline__ void compress_phase(const Ptrs& P, char* smem, int vb, int nvb) {
    unsigned char* ws = P.ws;
    const int tid = opaque_tid(), lane = tid & 63, wave = __builtin_amdgcn_readfirstlane(tid >> 6), wm = wave >> 2, wn = wave & 3, fr = lane & 15, q = lane >> 4;
    constexpr int CBUF = (64 + 128) * LSTR;
    bf16_t* H = (bf16_t*)smem + 2 * CBUF;
    constexpr int HS = 136;
    const int sc = tid & 7, sr = tid >> 3;
    for (int t = vb; t < 128; t += nvb) {
        const int isv = t >> 6, m0 = (t & 63) * 64;
        const bf16_t* Ag = (const bf16_t*)(ws + (isv ? O_VCIN : O_KCIN)) + (size_t)m0 * 1024 + sc * 8;
        const bf16_t* Bg = (const bf16_t*)(ws + (isv ? O_WT_CV1 : O_WT_CK1)) + sc * 8;
        f32x4 b1r[2];
#pragma unroll
        for (int j = 0; j < 2; ++j) b1r[j] = *(const f32x4*)((const float*)(ws + (isv ? O_B1V : O_B1K)) + wn * 32 + 16 * j + 4 * q);
        bf16x8 w2r[4][4]; f32x4 gkr[4];
        {
            const bf16_t* W2t = (const bf16_t*)(ws + (isv ? O_WT_CV2 : O_WT_CK2));
#pragma unroll
            for (int ks = 0; ks < 4; ++ks)
#pragma unroll
                for (int j = 0; j < 4; ++j) w2r[ks][j] = *(const bf16x8*)(W2t + (size_t)(16 * j + fr) * 128 + ks * 32 + 8 * q);
        }
        f32x4 acc[2][2];
#pragma unroll
        for (int i = 0; i < 2; ++i)
#pragma unroll
            for (int j = 0; j < 2; ++j) acc[i][j] = (f32x4){0.f, 0.f, 0.f, 0.f};
        u32x4 ra[8], rb0[8], rb1[8];
#define C_LOAD(set, kt_) do { ra[set] = *(const u32x4*)(Ag + (size_t)sr * 1024 + (kt_) * 64); rb0[set] = *(const u32x4*)(Bg + (size_t)sr * 2048 + (kt_) * 64); \
                              rb1[set] = *(const u32x4*)(Bg + (size_t)(sr + 64) * 2048 + (kt_) * 64); } while (0)
#define C_STORE(set, buf_) do { bf16_t* An_ = (bf16_t*)smem + (buf_) * CBUF; bf16_t* Bn_ = An_ + 64 * LSTR; \
                                *(u32x4*)(An_ + sr * LSTR + sc * 8) = ra[set]; *(u32x4*)(Bn_ + sr * LSTR + sc * 8) = rb0[set]; *(u32x4*)(Bn_ + (sr + 64) * LSTR + sc * 8) = rb1[set]; } while (0)
        C_LOAD(0, 0); C_LOAD(1, 1); C_LOAD(2, 2); C_LOAD(3, 3); C_LOAD(4, 4); C_LOAD(5, 5); C_LOAD(6, 6); C_LOAD(7, 7);
        C_STORE(0, 0);
        C_LOAD(0, 8);
        __syncthreads();
#pragma unroll 1
        for (int kt8 = 0; kt8 < 32; kt8 += 8) {
#pragma unroll
            for (int u = 0; u < 8; ++u) {
                const int kt = kt8 + u;
                const bf16_t* As = (const bf16_t*)smem + (u & 1) * CBUF; const bf16_t* Bs = As + 64 * LSTR;
#pragma unroll
                for (int ks = 0; ks < 2; ++ks) {
                    bf16x8 a[2], b[2];
#pragma unroll
                    for (int i = 0; i < 2; ++i) a[i] = *(const bf16x8*)(As + (wm * 32 + 16 * i + fr) * LSTR + ks * 32 + 8 * q);
#pragma unroll
                    for (int j = 0; j < 2; ++j) b[j] = *(const bf16x8*)(Bs + (wn * 32 + 16 * j + fr) * LSTR + ks * 32 + 8 * q);
#pragma unroll
                    for (int i = 0; i < 2; ++i)
#pragma unroll
                        for (int j = 0; j < 2; ++j) acc[i][j] = __builtin_amdgcn_mfma_f32_16x16x32_bf16(b[j], a[i], acc[i][j], 0, 0, 0);
                }
                C_STORE((u + 1) & 7, (u + 1) & 1);
                C_LOAD((u + 1) & 7, (kt + 9 < 32) ? kt + 9 : 31);
                __syncthreads();
            }
        }
#undef C_LOAD
#undef C_STORE
#pragma unroll
        for (int j = 0; j < 4; ++j) gkr[j] = *(const f32x4*)(P.in[20] + 16 * j + 4 * q);
#pragma unroll
        for (int i = 0; i < 2; ++i)
#pragma unroll
            for (int j = 0; j < 2; ++j) { const f32x4 v = acc[i][j]; const int n = wn * 32 + 16 * j + 4 * q; const f32x4 bb = b1r[j];
                *(u32x2*)(H + (wm * 32 + 16 * i + fr) * HS + n) = (u32x2){pk2(gelu_tanh(v[0] + bb[0]), gelu_tanh(v[1] + bb[1])), pk2(gelu_tanh(v[2] + bb[2]), gelu_tanh(v[3] + bb[3]))}; }
        __syncthreads();
        if (wave < 4) {
            f32x4 o2[4];
#pragma unroll
            for (int j = 0; j < 4; ++j) o2[j] = (f32x4){0.f, 0.f, 0.f, 0.f};
#pragma unroll
            for (int ks = 0; ks < 4; ++ks) {
                const bf16x8 a = *(const bf16x8*)(H + (wave * 16 + fr) * HS + ks * 32 + 8 * q);
#pragma unroll
                for (int j = 0; j < 4; ++j) o2[j] = __builtin_amdgcn_mfma_f32_16x16x32_bf16(w2r[ks][j], a, o2[j], 0, 0, 0);
            }
            const int R = m0 + wave * 16 + fr;
            if (!isv) {
                float s = 0.f;
#pragma unroll
                for (int j = 0; j < 4; ++j) s += (o2[j][0] * o2[j][0] + o2[j][1] * o2[j][1]) + (o2[j][2] * o2[j][2] + o2[j][3] * o2[j][3]);
                s += __shfl_xor(s, 16); s += __shfl_xor(s, 32);
                const float rstd = rsqrtf(s * (1.0f / 64) + EPS);
                bf16_t* dst = (bf16_t*)(ws + O_KC);
#pragma unroll
                for (int j = 0; j < 4; ++j) *(u32x2*)(dst + (size_t)R * 64 + 16 * j + 4 * q) = pk4(o2[j] * gkr[j] * rstd);
            } else {
                bf16_t* dT0 = (bf16_t*)(ws + O_VCT) + (size_t)(R >> 9) * 64 * 512 + (R & 511);
#pragma unroll
                for (int j = 0; j < 4; ++j) { const u32x2 o = pk4(o2[j]); bf16_t* dT = dT0 + (size_t)(16 * j + 4 * q) * 512;
                    dT[0] = (bf16_t)(o[0] & 0xffff); dT[512] = (bf16_t)(o[0] >> 16); dT[1024] = (bf16_t)(o[1] & 0xffff); dT[1536] = (bf16_t)(o[1] >> 16); }
            }
        }
        __syncthreads();
    }
}

constexpr int S5_BU_STR = 132, S5_XB_STR = 136;
constexpr int S5_WAVE_LDS = 16 * S5_BU_STR * 4 + 16 * S5_XB_STR * 2;
template <bool ENDS_ONLY>
__device__ __forceinline__ void s5_phase(const Ptrs& P, char* smem, int vb, int nvb) {
    unsigned char* ws = P.ws;
    const int tid_ = opaque_tid(); const int lane = tid_ & 63, wave = __builtin_amdgcn_readfirstlane(tid_ >> 6), fr = lane & 15, q = lane >> 4;
    float* BU = (float*)(smem + wave * S5_WAVE_LDS);
    bf16_t* XB = (bf16_t*)(smem + wave * S5_WAVE_LDS + 16 * S5_BU_STR * 4);
    const bf16_t* U = (const bf16_t*)(ws + O_U);
    const float* ABAR = (const float*)(ws + O_ABAR); const float* AL = (const float*)(ws + O_AL);
    float* ENDS = (float*)(ws + O_ENDS);
    const int gw = vb * NWAVES + wave, ngw = nvb * NWAVES;
    for (int it = gw; it < NB * NSEG * 32; it += ngw) {
        const int g = it & 31, c = (it >> 5) & (NSEG - 1), b = it >> 9;
        if (ENDS_ONLY && c == NSEG - 1) continue;
        const float ar = ABAR[(g * 64 + lane) * 2], ai = ABAR[(g * 64 + lane) * 2 + 1];
        bf16x8 bb[8];
#pragma unroll
        for (int nt = 0; nt < 8; ++nt) {
            bb[nt] = (bf16x8){0, 0, 0, 0, 0, 0, 0, 0};
            if (q < 2) bb[nt] = *(const bf16x8*)((const bf16_t*)(ws + O_BBT) + ((size_t)g * 128 + 16 * nt + fr) * 16 + 8 * q);
        }
        bf16x8 ct[4];
        if (!ENDS_ONLY) {
#pragma unroll
            for (int ks = 0; ks < 4; ++ks) ct[ks] = *(const bf16x8*)((const bf16_t*)(ws + O_CT) + ((size_t)g * 16 + fr) * 128 + ks * 32 + 8 * q);
        }
        f32x4 dd = (f32x4){0.f, 0.f, 0.f, 0.f};
        if (!ENDS_ONLY) dd = *(const f32x4*)(P.in[10] + g * 16 + 4 * q);
        float xr = 0.f, xi = 0.f;
        if (!ENDS_ONLY) {
            const float alr = AL[(g * 64 + lane) * 2], ali = AL[(g * 64 + lane) * 2 + 1];
            f32x2_t e[NSEG - 1];
#pragma unroll
            for (int cp = 0; cp < NSEG - 1; ++cp) { e[cp] = (f32x2_t){0.f, 0.f}; if (cp < c) e[cp] = *(const f32x2_t*)(ENDS + (((size_t)(b * NSEG + cp) * 32 + g) * 64 + lane) * 2); }
#pragma unroll
            for (int cp = 0; cp < NSEG - 1; ++cp) if (cp < c) { const float nr = alr * xr - ali * xi + e[cp][0], ni = alr * xi + ali * xr + e[cp][1]; xr = nr; xi = ni; }
        }
        const size_t tok0 = (size_t)b * SEQ + (size_t)c * SEGT;
        bf16x8 ufr[2][4]; u32x2 uur[2][4];
#pragma unroll
        for (int j = 0; j < 4; ++j) {
            ufr[0][j] = (bf16x8){0, 0, 0, 0, 0, 0, 0, 0}; uur[0][j] = (u32x2){0u, 0u};
            if (q < 2) ufr[0][j] = *(const bf16x8*)(U + (tok0 + 16 * j + fr) * 512 + g * 16 + 8 * q);
            if (!ENDS_ONLY) uur[0][j] = *(const u32x2*)(U + (tok0 + 16 * j + fr) * 512 + g * 16 + 4 * q);
        }
#pragma unroll 2
        for (int grp = 0; grp < SEGT / 64; ++grp) {
            const int cur = grp & 1;
            if (grp + 1 < SEGT / 64) {
#pragma unroll
                for (int j = 0; j < 4; ++j) {
                    ufr[cur ^ 1][j] = (bf16x8){0, 0, 0, 0, 0, 0, 0, 0}; uur[cur ^ 1][j] = (u32x2){0u, 0u};
                    if (q < 2) ufr[cur ^ 1][j] = *(const bf16x8*)(U + (tok0 + 64 * (grp + 1) + 16 * j + fr) * 512 + g * 16 + 8 * q);
                    if (!ENDS_ONLY) uur[cur ^ 1][j] = *(const u32x2*)(U + (tok0 + 64 * (grp + 1) + 16 * j + fr) * 512 + g * 16 + 4 * q);
                }
            }
#pragma unroll
            for (int j = 0; j < 4; ++j) {
            const size_t tk = tok0 + 64 * grp + 16 * j;
            const bf16x8 uf = ufr[cur][j]; const u32x2 uu = uur[cur][j];
#pragma unroll
            for (int nt = 0; nt < 8; ++nt) {
                f32x4 d = __builtin_amdgcn_mfma_f32_16x16x32_bf16(bb[nt], uf, (f32x4){0.f, 0.f, 0.f, 0.f}, 0, 0, 0);
                *(f32x4*)(BU + fr * S5_BU_STR + 16 * nt + 4 * q) = d;
            }
            asm volatile("s_waitcnt lgkmcnt(0)" ::: "memory");
            f32x2_t bq[16];
#pragma unroll
            for (int s = 0; s < 16; ++s) bq[s] = *(const f32x2_t*)(BU + s * S5_BU_STR + 2 * lane);
#pragma unroll
            for (int s = 0; s < 16; ++s) {
                float t1 = __builtin_fmaf(-ai, xi, bq[s][0]), t2 = __builtin_fmaf(ai, xr, bq[s][1]);
                asm volatile("" : "+v"(t1), "+v"(t2));
                const float nr = __builtin_fmaf(ar, xr, t1), ni = __builtin_fmaf(ar, xi, t2); xr = nr; xi = ni;
                if (!ENDS_ONLY) *(unsigned*)(XB + s * S5_XB_STR + 2 * lane) = pk2(xr, xi);
            }
            asm volatile("s_waitcnt lgkmcnt(0)" ::: "memory");
            if (!ENDS_ONLY) {
                f32x4 y = (f32x4){0.f, 0.f, 0.f, 0.f};
#pragma unroll
                for (int ks = 0; ks < 4; ++ks) {
                    const bf16x8 xf = *(const bf16x8*)(XB + fr * S5_XB_STR + ks * 32 + 8 * q);
                    y = __builtin_amdgcn_mfma_f32_16x16x32_bf16(ct[ks], xf, y, 0, 0, 0);
                }
                const float y0 = gelu_tanh(y[0] + dd[0] * bflo(uu[0])), y1 = gelu_tanh(y[1] + dd[1] * bfhi(uu[0]));
                const float y2 = gelu_tanh(y[2] + dd[2] * bflo(uu[1])), y3 = gelu_tanh(y[3] + dd[3] * bfhi(uu[1]));
                *(u32x2*)((bf16_t*)(ws + O_YG) + ((((tk + fr) >> 4) * 16 + (size_t)(g >> 1)) << 9) + (((int)(tk + fr) & 15) << 5) + ((g & 1) * 16 + 4 * q)) = (u32x2){pk2(y0, y1), pk2(y2, y3)};
                asm volatile("s_waitcnt lgkmcnt(0)" ::: "memory");
            }
            }
        }
        if (ENDS_ONLY) *(f32x2_t*)(ENDS + (((size_t)(b * NSEG + c) * 32 + g) * 64 + lane) * 2) = (f32x2_t){xr, xi};
    }
}

constexpr int S5E_LDS = 65536 + NWAVES * 16 * S5_BU_STR * 4;
__device__ __forceinline__ void s5_ends_phase(const Ptrs& P, char* smem, int vb, int nvb) {
    unsigned char* ws = P.ws;
    const int tid_ = opaque_tid(); const int lane = tid_ & 63, wave = __builtin_amdgcn_readfirstlane(tid_ >> 6), fr = lane & 15, q = lane >> 4;
    bf16_t* EL = (bf16_t*)smem;
    float* BU = (float*)(smem + 65536 + wave * 16 * S5_BU_STR * 4);
    const bf16_t* U = (const bf16_t*)(ws + O_U);
    float* ENDS = (float*)(ws + O_ENDS);
    constexpr int NPAIR = NB * (NSEG - 1), NR = (NPAIR + NWAVES - 1) / NWAVES;
    for (int it = vb; it < 32 * NR; it += nvb) {
        const int xcd_ = it & 7, jj_ = it >> 3, cq_ = xcd_ + 8 * (jj_ >> 2);
        const int g = 4 * (cq_ & 7) + (jj_ & 3), r = cq_ >> 3, pi = r * NWAVES + wave;
        const bool act = pi < NPAIR;
        const int b = act ? pi / (NSEG - 1) : 0, c = act ? pi % (NSEG - 1) : 0;
        const size_t tok0 = (size_t)b * SEQ + (size_t)c * SEGT;
        bf16x8 uf[2][8];
#pragma unroll
        for (int half = 0; half < 2; ++half)
#pragma unroll
            for (int ks = 0; ks < 8; ++ks) uf[half][ks] = *(const bf16x8*)(U + (tok0 + 256 * half + 16 * fr + 2 * ks + (q >> 1)) * 512 + g * 16 + 8 * (q & 1));
        const float a16r = ((const float*)(ws + O_A16))[(g * 64 + lane) * 2], a16i = ((const float*)(ws + O_A16))[(g * 64 + lane) * 2 + 1];
        __syncthreads();
        { const bf16_t* E16 = (const bf16_t*)(ws + O_E16) + (size_t)g * 128 * 256; const int ch = tid_ & 31, r0 = tid_ >> 5;
#pragma unroll
          for (int j = 0; j < 8; ++j) { const int row = r0 + 16 * j; const u32x4 v = *(const u32x4*)(E16 + (size_t)row * 256 + ch * 8); *(u32x4*)(EL + row * 256 + ((ch ^ (row & 15)) * 8)) = v; } }
        __syncthreads();
        if (act) {
            float xr = 0.f, xi = 0.f;
#pragma unroll
            for (int half = 0; half < SEGT / 256; ++half) {
#pragma unroll
                for (int nt = 0; nt < 8; ++nt) {
                    f32x4 d = (f32x4){0.f, 0.f, 0.f, 0.f};
#pragma unroll
                    for (int ks = 0; ks < 8; ++ks) { const bf16x8 ef = *(const bf16x8*)(EL + (16 * nt + fr) * 256 + (((4 * ks + q) ^ fr) * 8)); d = __builtin_amdgcn_mfma_f32_16x16x32_bf16(ef, uf[half][ks], d, 0, 0, 0); }
                    *(f32x4*)(BU + fr * S5_BU_STR + 16 * nt + 4 * q) = d;
                }
                asm volatile("s_waitcnt lgkmcnt(0)" ::: "memory");
#pragma unroll 8
                for (int j = 0; j < 16; ++j) {
                    const f32x2_t e = *(const f32x2_t*)(BU + j * S5_BU_STR + 2 * lane);
                    const float nr = a16r * xr - a16i * xi + e[0], ni = a16r * xi + a16i * xr + e[1]; xr = nr; xi = ni;
                }
                asm volatile("s_waitcnt lgkmcnt(0)" ::: "memory");
            }
            *(f32x2_t*)(ENDS + (((size_t)(b * NSEG + c) * 32 + g) * 64 + lane) * 2) = (f32x2_t){xr, xi};
        }
    }
    __syncthreads();
}

constexpr int RT = 2;
constexpr int TQ = 4 * RT * NWAVES;
constexpr int KSTR = 64;
constexpr int KV_TILE = 64 * KSTR * 2;
constexpr int IMP_STR = 132;
struct AttL { static constexpr int K0 = 0, V0 = 2 * KV_TILE, IMP = 4 * KV_TILE, SELM = IMP + NWAVES * 4 * RT * IMP_STR * 4, UNI = SELM + NWAVES * 4 * RT * 16, YP = UNI + 64, TOTAL = YP + NWAVES * RT * 4 * 64 * 8; };
struct AttSrc { const bf16_t* k; const bf16_t* v; int vld; };

__device__ __forceinline__ void att_load(const AttSrc& s, u32x4& kr, u32x4& vr) {
    int tid = threadIdx.x; asm volatile("" : "+v"(tid));
    const __amdgpu_buffer_rsrc_t rk = __builtin_amdgcn_make_buffer_rsrc((void*)s.k, 0, 0x7fffffff, 0x00020000);
    const __amdgpu_buffer_rsrc_t rv = __builtin_amdgcn_make_buffer_rsrc((void*)s.v, 0, 0x7fffffff, 0x00020000);
    kr = __builtin_bit_cast(u32x4, __builtin_amdgcn_raw_buffer_load_b128(rk, tid * 16, 0, 0));
    vr = __builtin_bit_cast(u32x4, __builtin_amdgcn_raw_buffer_load_b128(rv, (tid >> 3) * (s.vld * 2) + (tid & 7) * 16, 0, 0));
}
__device__ __forceinline__ void att_store(char* smem, int buf, const u32x4& kr, const u32x4& vr) {
    int tid = threadIdx.x; asm volatile("" : "+v"(tid));
    const int row = tid >> 3, ch = tid & 7;
    *(u32x4*)((bf16_t*)(smem + AttL::K0 + buf * KV_TILE) + row * KSTR + ((ch ^ (row & 7)) * 8)) = kr;
    { const int g32 = ch >> 2, m = ch & 3, ce = 4 * g32 + 2 * (m & 1), wo = 4 * (m >> 1);
      bf16_t* vrow = (bf16_t*)(smem + AttL::V0 + buf * KV_TILE) + row * KSTR;
      *(u32x2*)(vrow + ((ce ^ (row & 7)) * 8) + wo) = (u32x2){vr[0], vr[1]};
      *(u32x2*)(vrow + (((ce + 1) ^ (row & 7)) * 8) + wo) = (u32x2){vr[2], vr[3]}; }
}

template <int MODE, bool MASKED>
__device__ __forceinline__ void att_block(const bf16_t* Ks, const bf16_t* Vs, const bf16x8 (&qf)[RT][2], f32x4 (&acc)[RT][4], f32x4 (&l)[RT],
                                          const float (&invl)[RT], const float (&g0)[RT], const float (&base0)[RT], const int (&hi0)[RT], int wlo,
                                          float sk, float* imp_w, int blk0, int fr, int q) {
    const float NEGB = -1e30f;
    bf16x8 kf[2][2]; bf16x8 vf[4]; f32x4 S[RT][2];
    int lofs = fr * (KSTR * 2) + ((q ^ (fr & 7)) * 16);
    float skl = sk;
    asm volatile("" : "+v"(lofs), "+v"(skl));
    const char* kb_ = (const char*)Ks + lofs; const char* vb_ = (const char*)Vs + lofs;
    const char* kb1_ = (const char*)Ks + (lofs ^ 64); const char* vb1_ = (const char*)Vs + (lofs ^ 64);
    auto loadk = [&](const int kt) {
#pragma unroll
        for (int ab = 0; ab < 2; ++ab) { kf[ab][0] = *(const bf16x8*)(kb_ + (32 * kt + 16 * ab) * (KSTR * 2)); kf[ab][1] = *(const bf16x8*)(kb1_ + (32 * kt + 16 * ab) * (KSTR * 2)); }
    };
    auto loadv = [&](const int kt) {
#pragma unroll
        for (int dt = 0; dt < 4; ++dt) vf[dt] = *(const bf16x8*)((kt ? vb1_ : vb_) + (16 * dt) * (KSTR * 2));
    };
    auto qk = [&](const int kt) {
        __builtin_amdgcn_s_setprio(1);
#pragma unroll
        for (int rt = 0; rt < RT; ++rt) {
            const float bl = base0[rt] + skl * (float)(32 * kt + 4 * q);
#pragma unroll
            for (int ab = 0; ab < 2; ++ab) {
#pragma unroll
                for (int r = 0; r < 4; ++r) S[rt][ab][r] = bl + skl * (float)(16 * ab + r);
                S[rt][ab] = __builtin_amdgcn_mfma_f32_16x16x32_bf16(kf[ab][0], qf[rt][0], S[rt][ab], 0, 0, 0);
                S[rt][ab] = __builtin_amdgcn_mfma_f32_16x16x32_bf16(kf[ab][1], qf[rt][1], S[rt][ab], 0, 0, 0);
            }
        }
        __builtin_amdgcn_s_setprio(0);
    };
    auto smpv = [&](const int kt) {
#pragma unroll
        for (int rt = 0; rt < RT; ++rt) {
            if (MASKED) {
                const int hi = hi0[rt] - (32 * kt + 4 * q), lo = hi - wlo;
#pragma unroll
                for (int ab = 0; ab < 2; ++ab)
#pragma unroll
                    for (int r = 0; r < 4; ++r) { const int c = 16 * ab + r; if (c > hi || c < lo) S[rt][ab][r] = NEGB; }
            }
#pragma unroll
            for (int ab = 0; ab < 2; ++ab)
#pragma unroll
                for (int r = 0; r < 4; ++r) S[rt][ab][r] = __builtin_amdgcn_exp2f(S[rt][ab][r]);
            if (MODE == 1) {
                const float il = invl[rt];
#pragma unroll
                for (int ab = 0; ab < 2; ++ab) {
                    S[rt][ab] = S[rt][ab] * il;
                    float cs = (S[rt][ab][0] + S[rt][ab][1]) + (S[rt][ab][2] + S[rt][ab][3]), last = S[rt][ab][3];
                    cs += __shfl_xor(cs, 1); cs += __shfl_xor(cs, 2); last += __shfl_xor(last, 1); last += __shfl_xor(last, 2);
                    const int blk = blk0 + 8 * kt + 4 * ab + q;
                    if ((fr & 3) == 0) { float* ip = imp_w + (4 * rt + (fr >> 2)) * IMP_STR + blk; atomicAdd(ip, cs); if (blk + 1 < 128) atomicAdd(ip + 1, last); }
                    S[rt][ab] = S[rt][ab] * g0[rt];
                }
            }
            const u32x4 pu = {pk2(S[rt][0][0], S[rt][0][1]), pk2(S[rt][0][2], S[rt][0][3]), pk2(S[rt][1][0], S[rt][1][1]), pk2(S[rt][1][2], S[rt][1][3])};
            const bf16x8 pf = __builtin_bit_cast(bf16x8, pu);
            __builtin_amdgcn_s_setprio(1);
            if (MODE != 1) { const unsigned one2 = (fr == 0) ? 0x3F803F80u : 0u; const u32x4 ou = {one2, one2, one2, one2};
                l[rt] = __builtin_amdgcn_mfma_f32_16x16x32_bf16(__builtin_bit_cast(bf16x8, ou), pf, l[rt], 0, 0, 0); }
            if (MODE != 0) {
#pragma unroll
                for (int dt = 0; dt < 4; ++dt) acc[rt][dt] = __builtin_amdgcn_mfma_f32_16x16x32_bf16(vf[dt], pf, acc[rt][dt], 0, 0, 0);
            }
            __builtin_amdgcn_s_setprio(0);
        }
    };
    loadk(0);
    if (MODE != 0) loadv(0);
    qk(0);
    __builtin_amdgcn_sched_barrier(0);
    loadk(1);
    smpv(0);
    __builtin_amdgcn_sched_barrier(0);
    if (MODE != 0) loadv(1);
    qk(1);
    __builtin_amdgcn_sched_barrier(0);
    smpv(1);
}
#define ATT_BLOCK(MODE, need_mask, ...) do { if (need_mask) att_block<MODE, true>(__VA_ARGS__); else att_block<MODE, false>(__VA_ARGS__); } while (0)

__device__ __forceinline__ void attn_phase(const Ptrs& P, char* smem, int vb, int nvb, size_t yoff = O_YNSA, int parts = 7) {
    typedef AttL L;
    unsigned char* ws = P.ws;
    const int tid = opaque_tid(), lane = tid & 63, wave = __builtin_amdgcn_readfirstlane(tid >> 6), fr = lane & 15, q = lane >> 4;
    constexpr int NQT = SEQ / TQ, TW = 4 * RT;
    float* imp_w = (float*)(smem + L::IMP) + wave * TW * IMP_STR;
    unsigned* selm_w = (unsigned*)(smem + L::SELM) + wave * TW * 4;
    unsigned* uni = (unsigned*)(smem + L::UNI);
    const float* M2 = (const float*)(ws + O_M2);
    const float LOG2E = 1.4426950408889634f;
    const float* G = (const float*)(ws + O_GATES);
    for (int it = vb; it < NB * 2 * NQT; it += nvb) {
        int qt, bg;
        if ((nvb % (NB * 2)) == 0 && (NQT % (nvb / (NB * 2))) == 0) {
            const int rnd = it / nvb, jj = it - rnd * nvb, per = nvb / (NB * 2), i_ = jj / (NB * 2);
            const int nr = NQT / per, lo_ = (nr - 1 - rnd) * per;
            bg = (jj + rnd) % (NB * 2); qt = (rnd & 1) ? (lo_ + i_) : (lo_ + per - 1 - i_);
        } else { qt = NQT - 1 - (it / (NB * 2)); bg = it % (NB * 2); }
        const int b = bg >> 1, g = bg & 1;
        const int qs = qt * TQ, t0 = qs + TW * wave;
        const int head = fr & 3, h = g * 4 + head;
        const float slope2 = exp2f(-(float)(h + 1)) * LOG2E;
        const int dz = (int)(160.0f / (exp2f(-(float)(g * 4 + 4)) * LOG2E)) + 1;
        const bf16_t* QN = (const bf16_t*)(ws + O_QN);
        bf16x8 qf[RT][2]; int tpos[RT];
#pragma unroll
        for (int rt = 0; rt < RT; ++rt) {
            tpos[rt] = t0 + 4 * rt + (fr >> 2);
            const size_t tok = (size_t)b * SEQ + tpos[rt];
#pragma unroll
            for (int ks = 0; ks < 2; ++ks) qf[rt][ks] = *(const bf16x8*)(QN + tok * 512 + h * 64 + 32 * ks + 8 * q);
        }
        for (int i = lane; i < TW * IMP_STR; i += 64) imp_w[i] = 0.f;
        { int tz = tid; asm volatile("" : "+v"(tz)); if (tz < 4) uni[tz] = 0u; }
        u32x2* yp_w = (u32x2*)(smem + L::YP) + wave * RT * 4 * 64 + lane;
#pragma unroll
        for (int rt = 0; rt < RT; ++rt)
#pragma unroll
            for (int dt = 0; dt < 4; ++dt) yp_w[(rt * 4 + dt) * 64] = (u32x2){0u, 0u};
        f32x4 O[RT][4];
#pragma unroll
        for (int rt = 0; rt < RT; ++rt)
#pragma unroll
            for (int dt = 0; dt < 4; ++dt) O[rt][dt] = (f32x4){0.f, 0.f, 0.f, 0.f};
        f32x4 l[RT]; float invl[RT], g0[RT], base0[RT]; int hi0[RT];
        float gs_[RT], gw_[RT];
#pragma unroll
        for (int rt = 0; rt < RT; ++rt) { l[rt] = (f32x4){0.f, 0.f, 0.f, 0.f}; invl[rt] = 0.f; const float* gp = G + ((size_t)b * SEQ + tpos[rt]) * 24 + h; g0[rt] = gp[0]; gs_[rt] = gp[8]; gw_[rt] = gp[16]; }
        u32x4 kr, vr;
        __syncthreads();
        if (parts & 1) {
            const int jm_tile = (qs + TQ - 1 - 31) >> 4;
            const int nkb = (jm_tile >> 6) + 1;
            int kb0c = 0; { const int jc = (qs - 31 - dz) >> 4; if (jc > 0) kb0c = jc >> 6; }
            const int jm_lo = (t0 - 31) >> 4, jm_hi = (t0 + TW - 1 - 31) >> 4;
            const float m2 = M2[0];
            const bf16_t* KC = (const bf16_t*)(ws + O_KC) + (size_t)bg * 512 * 64;
            const bf16_t* VCT = (const bf16_t*)(ws + O_VCT) + (size_t)bg * 64 * 512;
            int jmax[RT];
#pragma unroll
            for (int rt = 0; rt < RT; ++rt) jmax[rt] = (tpos[rt] - 31) >> 4;
#define CMP_STEP(MODEV, MASKV) do { \
                      \
                    if (kb + 1 < nkb) { att_store(smem, (kb + 1) & 1, kr, vr); \
                        if (kb + 2 < nkb) { AttSrc s1{KC + (size_t)(kb + 2) * 64 * 64, VCT + (kb + 2) * 64, 512}; att_load(s1, kr, vr); } } \
                    if (64 * kb <= jm_hi) { \
                        _Pragma("unroll") for (int rt = 0; rt < RT; ++rt) { base0[rt] = -m2 - slope2 * (float)(tpos[rt] - 31 - 1024 * kb); hi0[rt] = jmax[rt] - 64 * kb; } \
                        const bf16_t* Ks = (const bf16_t*)(smem + L::K0 + (kb & 1) * KV_TILE); const bf16_t* Vs = (const bf16_t*)(smem + L::V0 + (kb & 1) * KV_TILE); \
                        att_block<MODEV, MASKV>(Ks, Vs, qf, O, l, invl, g0, base0, hi0, 1 << 28, slope2 * 16.f, imp_w, 16 * kb, fr, q); \
                    } \
                    __syncthreads(); } while (0)
#define CMP_PASS(MODEV) do { \
                { AttSrc s0{KC + (size_t)kb0c * 64 * 64, VCT + kb0c * 64, 512}; att_load(s0, kr, vr); att_store(smem, kb0c & 1, kr, vr); } \
                if (kb0c + 1 < nkb) { AttSrc s1{KC + (size_t)(kb0c + 1) * 64 * 64, VCT + (kb0c + 1) * 64, 512}; att_load(s1, kr, vr); } \
                __syncthreads(); \
                int kb = kb0c; \
                _Pragma("unroll 1") for (; kb < nkb - 2; ++kb) CMP_STEP(MODEV, false); \
                _Pragma("unroll 1") for (; kb < nkb; ++kb) CMP_STEP(MODEV, true); } while (0)
            CMP_PASS(0);
#pragma unroll
            for (int rt = 0; rt < RT; ++rt) { float s = l[rt][0]; s += __shfl_xor(s, 16); s += __shfl_xor(s, 32); invl[rt] = s > 0.f ? 1.0f / s : 0.f; l[rt] = (f32x4){0.f, 0.f, 0.f, 0.f}; }
            CMP_PASS(1);
#undef CMP_PASS
#undef CMP_STEP
#pragma unroll
            for (int rt = 0; rt < RT; ++rt)
#pragma unroll
                for (int dt = 0; dt < 4; ++dt) { yp_w[(rt * 4 + dt) * 64] = pk4(O[rt][dt]); O[rt][dt] = (f32x4){0.f, 0.f, 0.f, 0.f}; }
        }
        if (parts & 2) {
            asm volatile("s_waitcnt lgkmcnt(0)" ::: "memory");
            const int tl = lane >> 3, part = lane & 7, t = t0 + tl, cur = t >> 6;
            const float* my = imp_w + tl * IMP_STR + 16 * part;
            unsigned key[16];
#pragma unroll
            for (int i4 = 0; i4 < 4; ++i4) { const f32x4 v = *(const f32x4*)(my + 4 * i4);
#pragma unroll
                for (int c = 0; c < 4; ++c) { const int blk = 16 * part + 4 * i4 + c;
                    const bool valid = blk <= cur, forced = (blk == 0) || (blk == cur) || (blk == cur - 1);
                    const float vv = v[c] + (forced ? 1e4f : 0.f);
                    key[4 * i4 + c] = ((valid ? (__float_as_uint(vv) & ~127u) : 0u) | (unsigned)(127 - blk)) + 1u; } }
#pragma unroll 1
            for (int r = 0; r < 16; ++r) {
                unsigned m = key[0];
#pragma unroll
                for (int i = 1; i < 16; ++i) m = max(m, key[i]);
                m = max(m, (unsigned)__builtin_amdgcn_update_dpp(0, (int)m, 0xB1, 0xF, 0xF, true));
                m = max(m, (unsigned)__builtin_amdgcn_update_dpp(0, (int)m, 0x4E, 0xF, 0xF, true));
                m = max(m, (unsigned)__builtin_amdgcn_update_dpp(0, (int)m, 0x141, 0xF, 0xF, true));
#pragma unroll
                for (int i = 0; i < 16; ++i) key[i] = (key[i] == m) ? 0u : key[i];
            }
            unsigned bits = 0u;
#pragma unroll
            for (int i = 0; i < 16; ++i) bits |= (key[i] == 0u) ? (1u << i) : 0u;
            bits <<= 16 * (part & 1);
            unsigned m0 = ((part >> 1) == 0) ? bits : 0u, m1 = ((part >> 1) == 1) ? bits : 0u, m2_ = ((part >> 1) == 2) ? bits : 0u, m3 = ((part >> 1) == 3) ? bits : 0u;
#define OR8(x) do { x |= (unsigned)__builtin_amdgcn_update_dpp(0, (int)x, 0xB1, 0xF, 0xF, true); x |= (unsigned)__builtin_amdgcn_update_dpp(0, (int)x, 0x4E, 0xF, 0xF, true); \
                    x |= (unsigned)__builtin_amdgcn_update_dpp(0, (int)x, 0x141, 0xF, 0xF, true); } while (0)
            OR8(m0); OR8(m1); OR8(m2_); OR8(m3);
#undef OR8
            if (part == 0) { selm_w[tl * 4 + 0] = m0; selm_w[tl * 4 + 1] = m1; selm_w[tl * 4 + 2] = m2_; selm_w[tl * 4 + 3] = m3; }
#pragma unroll
            for (int o = 8; o < 64; o <<= 1) { m0 |= __shfl_xor(m0, o); m1 |= __shfl_xor(m1, o); m2_ |= __shfl_xor(m2_, o); m3 |= __shfl_xor(m3, o); }
            if (lane == 0) { atomicOr(uni + 0, m0); atomicOr(uni + 1, m1); atomicOr(uni + 2, m2_); atomicOr(uni + 3, m3); }
            __syncthreads();
            const unsigned wu0 = __builtin_amdgcn_readfirstlane(m0), wu1 = __builtin_amdgcn_readfirstlane(m1), wu2 = __builtin_amdgcn_readfirstlane(m2_), wu3 = __builtin_amdgcn_readfirstlane(m3);
            unsigned bu0 = __builtin_amdgcn_readfirstlane(uni[0]), bu1 = __builtin_amdgcn_readfirstlane(uni[1]), bu2 = __builtin_amdgcn_readfirstlane(uni[2]), bu3 = __builtin_amdgcn_readfirstlane(uni[3]);
            { const int bc = (qs - dz - 63) >> 6;
              if (bc > 0) { const unsigned long long lo64 = (bc >= 64) ? ~0ull : ((1ull << bc) - 1ull), hi64 = (bc <= 64) ? 0ull : ((bc >= 128) ? ~0ull : ((1ull << (bc - 64)) - 1ull));
                  bu0 &= ~(unsigned)lo64; bu1 &= ~(unsigned)(lo64 >> 32); bu2 &= ~(unsigned)hi64; bu3 &= ~(unsigned)(hi64 >> 32); } }
            const float m2s = M2[1];
            const bf16_t* KS = (const bf16_t*)(ws + O_KS) + (size_t)bg * SEQ * 64;
            const bf16_t* VST = (const bf16_t*)(ws + O_VST) + (size_t)bg * 64 * SEQ;
            { const unsigned long long klo = (qt >= 63) ? ~0ull : ((1ull << (qt + 1)) - 1ull), khi = (qt < 64) ? 0ull : ((qt >= 127) ? ~0ull : ((1ull << (qt - 63)) - 1ull));
              bu0 &= (unsigned)klo; bu1 &= (unsigned)(klo >> 32); bu2 &= (unsigned)khi; bu3 &= (unsigned)(khi >> 32); }
            const int nsel = __popc(bu0) + __popc(bu1) + __popc(bu2) + __popc(bu3);
            int cw = 0; unsigned cbits = bu0;
#define NEXT_BLK(dst) do { while (cbits == 0u) { ++cw; cbits = (cw == 1) ? bu1 : (cw == 2) ? bu2 : bu3; } const int bpos_ = __ffs(cbits) - 1; cbits &= cbits - 1u; dst = cw * 32 + bpos_; } while (0)
#define SEL_STEP(MASKV) do { \
                    if (i + 1 < nsel) { att_store(smem, (i + 1) & 1, kr, vr);        \
                        if (i + 2 < nsel) { NEXT_BLK(blk_nx2); AttSrc s1{KS + (size_t)blk_nx2 * 64 * 64, VST + blk_nx2 * 64, SEQ}; att_load(s1, kr, vr); } } \
                    const int blk = blk_cur, kb0 = 64 * blk; \
                    const unsigned wword = (blk < 32) ? wu0 : (blk < 64) ? wu1 : (blk < 96) ? wu2 : wu3; \
                    if (((wword >> (blk & 31)) & 1u) && kb0 <= t0 + TW - 1) { \
                        _Pragma("unroll") for (int rt = 0; rt < RT; ++rt) { \
                            const unsigned w_ = selm_w[(4 * rt + (fr >> 2)) * 4 + (blk >> 5)]; \
                            const bool sel = (w_ >> (blk & 31)) & 1u; \
                            base0[rt] = sel ? (-m2s - slope2 * (float)(tpos[rt] - kb0)) : -1e30f;     \
                            hi0[rt] = tpos[rt] - kb0; \
                        } \
                        const bf16_t* Ks = (const bf16_t*)(smem + L::K0 + (i & 1) * KV_TILE); const bf16_t* Vs = (const bf16_t*)(smem + L::V0 + (i & 1) * KV_TILE); \
                        att_block<2, MASKV>(Ks, Vs, qf, O, l, invl, g0, base0, hi0, 1 << 28, slope2, imp_w, 0, fr, q); \
                    } \
                    blk_cur = blk_nxt; blk_nxt = blk_nx2; \
                    __syncthreads(); } while (0)
            int blk_cur = 0, blk_nxt = 0, blk_nx2 = 0;
            if (nsel > 0) {
                NEXT_BLK(blk_cur);
                { AttSrc s0{KS + (size_t)blk_cur * 64 * 64, VST + blk_cur * 64, SEQ}; att_load(s0, kr, vr); att_store(smem, 0, kr, vr); }
                if (nsel > 1) { NEXT_BLK(blk_nxt); AttSrc s1{KS + (size_t)blk_nxt * 64 * 64, VST + blk_nxt * 64, SEQ}; att_load(s1, kr, vr); }
                __syncthreads();
                int i = 0;
#pragma unroll 1
                for (; i < nsel - 1; ++i) SEL_STEP(false);
                SEL_STEP(true);
            }
#undef SEL_STEP
#undef NEXT_BLK
#pragma unroll
            for (int rt = 0; rt < RT; ++rt) {
                float s = l[rt][0]; s += __shfl_xor(s, 16); s += __shfl_xor(s, 32);
                const float cf = (s > 0.f) ? gs_[rt] / s : 0.f; l[rt] = (f32x4){0.f, 0.f, 0.f, 0.f};
#pragma unroll
                for (int dt = 0; dt < 4; ++dt) { const u32x2 yp = yp_w[(rt * 4 + dt) * 64]; const f32x4 yv = {bflo(yp[0]), bfhi(yp[0]), bflo(yp[1]), bfhi(yp[1])};
                    yp_w[(rt * 4 + dt) * 64] = pk4(yv + O[rt][dt] * cf); O[rt][dt] = (f32x4){0.f, 0.f, 0.f, 0.f}; }
            }
        }
        if (parts & 4) {
            const float m2w = M2[2];
            const bf16_t* KW = (const bf16_t*)(ws + O_KW) + (size_t)bg * SEQ * 64;
            const bf16_t* VWT = (const bf16_t*)(ws + O_VWT) + (size_t)bg * 64 * SEQ;
            const int wlast = (qs + TQ - 1) >> 6; int wfirst = (qs - 511) >> 6; if (wfirst < 0) wfirst = 0;
            const int nwb = wlast - wfirst + 1;
            { AttSrc s0{KW + (size_t)wfirst * 64 * 64, VWT + wfirst * 64, SEQ}; att_load(s0, kr, vr); att_store(smem, 0, kr, vr); }
            if (nwb > 1) { AttSrc s1{KW + (size_t)(wfirst + 1) * 64 * 64, VWT + (wfirst + 1) * 64, SEQ}; att_load(s1, kr, vr); }
            __syncthreads();
#define WIN_STEP(MASKV) do { \
                const int wb = wfirst + i, kb0 = 64 * wb; \
                if (i + 1 < nwb) { att_store(smem, (i + 1) & 1, kr, vr);        \
                    if (i + 2 < nwb) { AttSrc s1{KW + (size_t)(wb + 2) * 64 * 64, VWT + (wb + 2) * 64, SEQ}; att_load(s1, kr, vr); } } \
                if (kb0 <= t0 + TW - 1 && kb0 + 63 >= t0 - 511) { \
                    _Pragma("unroll") for (int rt = 0; rt < RT; ++rt) { base0[rt] = -m2w - slope2 * (float)(tpos[rt] - kb0); hi0[rt] = tpos[rt] - kb0; } \
                    const bf16_t* Ks = (const bf16_t*)(smem + L::K0 + (i & 1) * KV_TILE); const bf16_t* Vs = (const bf16_t*)(smem + L::V0 + (i & 1) * KV_TILE); \
                    att_block<2, MASKV>(Ks, Vs, qf, O, l, invl, g0, base0, hi0, 511, slope2, imp_w, 0, fr, q); \
                } \
                __syncthreads(); } while (0)
            int i = 0;
            WIN_STEP(true);
            i = 1;
#pragma unroll 1
            for (; i < nwb - 1; ++i) WIN_STEP(false);
            if (i < nwb) WIN_STEP(true);
#undef WIN_STEP
        }
        bf16_t* YN = (bf16_t*)(ws + yoff);
        int hq = h * 64 + 4 * q; asm volatile("" : "+v"(hq));
#pragma unroll
        for (int rt = 0; rt < RT; ++rt) {
            float s = l[rt][0]; s += __shfl_xor(s, 16); s += __shfl_xor(s, 32);
            const size_t tok = (size_t)b * SEQ + tpos[rt];
            const float cf = (s > 0.f) ? gw_[rt] / s : 0.f;
#pragma unroll
            for (int dt = 0; dt < 4; ++dt) { const u32x2 yp = yp_w[(rt * 4 + dt) * 64]; const f32x4 yv = {bflo(yp[0]), bfhi(yp[0]), bflo(yp[1]), bfhi(yp[1])};
                *(u32x2*)(YN + ((((tok >> 4) * 16) + (size_t)((hq + 16 * dt) >> 5)) << 9) + (((int)tok & 15) << 5) + ((hq + 16 * dt) & 31)) = pk4(yv + O[rt][dt] * cf); }
        }
        __syncthreads();
    }
}

constexpr int SMEM_MAIN = 136 * 1024, SMEM_BYTES = SMEM_MAIN + 64;
static_assert(AttL::TOTAL <= SMEM_MAIN && NWAVES * S5_WAVE_LDS <= SMEM_MAIN && pg8::STAGE_BYTES <= SMEM_MAIN && S5E_LDS <= SMEM_MAIN, "LDS budget");

__global__ void __launch_bounds__(NTHR) k_mega(Ptrs P, TrTable tt, TrTable tt2) {
    extern __shared__ __attribute__((aligned(16))) char smem[];
    const int vb = blockIdx.x, nvb = gridDim.x;
    unsigned long long ts_a = 0ull, ts_b = 0ull; int ts_n = 0;
#define STAMP() do { if (PROBE_STAMP >= 0) { const unsigned long long t_ = __builtin_amdgcn_s_memrealtime(); if (ts_n == PROBE_STAMP) ts_a = t_; if (ts_n == PROBE_STAMP + 1) ts_b = t_; ++ts_n; } } while (0)
    unsigned char* ws = P.ws;
    volatile __attribute__((address_space(3))) unsigned* bst = (volatile __attribute__((address_space(3))) unsigned*)((__attribute__((address_space(3))) char*)smem + SMEM_MAIN);
    if (threadIdx.x < 2) bst[threadIdx.x] = 0u;
    __syncthreads();
    const XcdBarrier xbar = xcd_barrier_post((unsigned*)(ws + O_BAR), bst);
    STAMP();
    transpose_phase(tt, smem, vb, nvb);
    if (PROBE_REP & 64) transpose_phase(tt, smem, vb, nvb);
    consts_phase(P, vb, nvb);
    rmsnorm1_phase(P, vb, nvb);
    if (PROBE_REP & 64) rmsnorm1_phase(P, vb, nvb);
#define GRID_BAR() do { xcd_barrier(xbar); STAMP(); } while (0)
    GRID_BAR();
    { pg8::EpiIn E{ws, P.in[19], P.in[20]}; big_gemm(smem, (const bf16_t*)(ws + O_XN), (const bf16_t*)(ws + O_WT_IN), NTOK, NIN, DM, E);
      if (PROBE_REP & 1) big_gemm(smem, (const bf16_t*)(ws + O_XN), (const bf16_t*)(ws + O_WT_IN), NTOK, NIN, DM, E); }
    GRID_BAR();
    compress_phase(P, smem, vb, nvb);
    if (PROBE_REP & 128) { __syncthreads(); compress_phase(P, smem, vb, nvb); }
    s5_ends_phase(P, smem, nvb - 1 - vb, nvb);
    if (PROBE_REP & 256) s5_ends_phase(P, smem, nvb - 1 - vb, nvb);
    __syncthreads();
    if (nvb >= 256) { if (vb >= 128) transpose_phase(tt2, smem, vb - 128, nvb - 128); }
    else transpose_phase(tt2, smem, vb, nvb);
    if (PROBE_REP & 512) { const int nslot = 128 + 2 * (nvb - 128); if (vb < 128) transpose_phase(tt2, smem, vb, nslot); else { transpose_phase(tt2, smem, 128 + 2 * (vb - 128), nslot); transpose_phase(tt2, smem, 129 + 2 * (vb - 128), nslot); } }
    GRID_BAR();
#if PROBE_CLK == 3
    const unsigned long long ck0 = __builtin_amdgcn_s_memtime(), rk0 = __builtin_amdgcn_s_memrealtime();
#endif
    attn_phase(P, smem, vb, nvb);
#if PROBE_CLK == 3
    { const unsigned long long ck1 = __builtin_amdgcn_s_memtime(), rk1 = __builtin_amdgcn_s_memrealtime(); if (vb == 7 && threadIdx.x == 0) *(float*)(ws + O_M2 + 128) = (float)(ck1 - ck0) / (float)(rk1 - rk0); }
#endif
    if (PROBE_REP & 2) attn_phase(P, smem, vb, nvb, O_MERGED, PROBE_PARTS);
    s5_phase<false>(P, smem, vb, nvb);
    if (PROBE_REP & 4) s5_phase<false>(P, smem, vb, nvb);
    GRID_BAR();
    { pg8::EpiGlu E{(const bf16_t*)(ws + O_YG), (bf16_t*)(ws + O_YSSM), P.in[12]}; big_gemm<pg8::EpiGlu, true>(smem, (const bf16_t*)(ws + O_YG), (const bf16_t*)(ws + O_WT_GLU), NTOK, 512, 512, E); }
    GRID_BAR();
    { pg8::EpiMergeDual E{(const bf16_t*)(ws + O_MG), (bf16_t*)(ws + O_MERGED)};
      big_gemm_dual<pg8::EpiMergeDual, true>(smem, (const bf16_t*)(ws + O_YSSM), (const bf16_t*)(ws + O_WT_PS), (const bf16_t*)(ws + O_YNSA), (const bf16_t*)(ws + O_WT_PN), NTOK, 1024, 512, E); }
    GRID_BAR();
    { pg8::EpiOut E{P.in[0], (bf16_t*)(ws + O_X1B), (float*)(ws + O_SSQ)}; big_gemm<pg8::EpiOut, true>(smem, (const bf16_t*)(ws + O_MERGED), (const bf16_t*)(ws + O_WT_OUT), NTOK, 1024, 1024, E); }
    GRID_BAR();
#if PROBE_CLK == 7
    const unsigned long long ck0 = __builtin_amdgcn_s_memtime(), rk0 = __builtin_amdgcn_s_memrealtime();
#endif
    { pg8::EpiUp E{(bf16_t*)(ws + O_FF), (const float*)(ws + O_SSQ)}; big_gemm<pg8::EpiUp, true>(smem, (const bf16_t*)(ws + O_X1B), (const bf16_t*)(ws + O_WT_UP), NTOK, DFF, DM, E); }
#if PROBE_CLK == 7
    { const unsigned long long ck1 = __builtin_amdgcn_s_memtime(), rk1 = __builtin_amdgcn_s_memrealtime(); if (vb == 7 && threadIdx.x == 0) *(float*)(ws + O_M2 + 128) = (float)(ck1 - ck0) / (float)(rk1 - rk0); }
#endif
    GRID_BAR();
    { pg8::EpiDown E{(const bf16_t*)(ws + O_X1B), P.out}; big_gemm<pg8::EpiDown, true>(smem, (const bf16_t*)(ws + O_FF), (const bf16_t*)(ws + O_WT_DOWN), NTOK, DM, DFF, E); }
#if PROBE_CLK
    xcd_barrier(xbar); if (vb == 0 && threadIdx.x == 0) P.out[0] += 10.0f * (float)(int)(*(const float*)(ws + O_M2 + 128) + 0.5f);
#endif
    if (PROBE_STAMP >= 0) { xcd_barrier(xbar); STAMP(); if (vb == 0 && threadIdx.x == 0) P.out[0] += 8.0f * (float)(int)((float)(ts_b - ts_a) * 0.01f * 0.125f + 0.5f); }
}

static void add_tr(TrTable& tt, int& n, const float* src, bf16_t* dst, const float* kscale, int K, int N, int ldsrc, int mode) {
    TrDesc& d = tt.d[n]; d.src = src; d.dst = dst; d.kscale = kscale; d.K = K; d.N = N; d.ldsrc = ldsrc; d.mode = mode; d.tiles_n = N / 64; d.tile0 = tt.total;
    tt.total += (K / 64) * (N / 64); ++n;
}

extern "C" void kernel_launch(void* const* d_in, const int* in_sizes, int n_in, void* d_out, int out_size, void* d_ws, size_t ws_size, hipStream_t stream) {
    if (n_in != 27 || ws_size < WS_END) { fprintf(stderr, "kernel_launch: unexpected n_in %d or ws_size %zu (need %zu)\n", n_in, ws_size, (size_t)WS_END); return; }
    Ptrs P{};
    for (int i = 0; i < 27; ++i) P.in[i] = (const float*)d_in[i];
    P.out = (float*)d_out; P.ws = (unsigned char*)d_ws;
    unsigned char* ws = P.ws;
    TrTable tt{}, tt2{}; int n = 0, n2 = 0;
    add_tr(tt, n, P.in[2], (bf16_t*)(ws + O_WT_IN), nullptr, 1024, NIN, 3864, 1);
    add_tr(tt, n, P.in[15], (bf16_t*)(ws + O_WT_CK1), nullptr, 2048, 128, 128, 0);
    add_tr(tt, n, P.in[17], (bf16_t*)(ws + O_WT_CV1), nullptr, 2048, 128, 128, 0);
    add_tr(tt, n, P.in[16], (bf16_t*)(ws + O_WT_CK2), nullptr, 128, 64, 64, 0);
    add_tr(tt, n, P.in[18], (bf16_t*)(ws + O_WT_CV2), nullptr, 128, 64, 64, 0);
    add_tr(tt2, n2, P.in[25], (bf16_t*)(ws + O_WT_UP), P.in[24], 1024, 4096, 4096, 0);
    add_tr(tt2, n2, P.in[26], (bf16_t*)(ws + O_WT_DOWN), nullptr, 4096, 1024, 1024, 0);
    add_tr(tt2, n2, P.in[23], (bf16_t*)(ws + O_WT_OUT), nullptr, 1024, 1024, 1024, 0);
    add_tr(tt2, n2, P.in[21], (bf16_t*)(ws + O_WT_PS), nullptr, 512, 1024, 1024, 0);
    add_tr(tt2, n2, P.in[22], (bf16_t*)(ws + O_WT_PN), nullptr, 512, 1024, 1024, 0);
    add_tr(tt2, n2, P.in[11], (bf16_t*)(ws + O_WT_GLU), nullptr, 512, 512, 512, 0);
    tt.n = n; tt2.n = n2;
    static int grid_blocks = 0;
    if (!grid_blocks) {
        int dev = 0, cus = 0, per_cu = 0;
        (void)hipGetDevice(&dev);
        (void)hipDeviceGetAttribute(&cus, hipDeviceAttributeMultiprocessorCount, dev);
        (void)hipFuncSetAttribute((const void*)k_mega, hipFuncAttributeMaxDynamicSharedMemorySize, SMEM_BYTES);
        (void)hipOccupancyMaxActiveBlocksPerMultiprocessor(&per_cu, k_mega, NTHR, SMEM_BYTES);
        if (per_cu < 1) { fprintf(stderr, "kernel_launch: occupancy query returned %d\n", per_cu); per_cu = 1; }
        grid_blocks = cus;
    }
    (void)hipMemsetAsync(ws + O_BAR, 0, XCD_BAR_WORDS * sizeof(unsigned), stream);
    void* args[] = {(void*)&P, (void*)&tt, (void*)&tt2};
    const hipError_t e = hipLaunchCooperativeKernel((void*)k_mega, dim3(grid_blocks), dim3(NTHR), args, SMEM_BYTES, stream);
    if (e != hipSuccess) fprintf(stderr, "cooperative launch failed: %s (grid %d)\n", hipGetErrorString(e), grid_blocks);
}
```

```cpp
#include <hip/hip_runtime.h>
#include <cstdio>
#include <cstdint>

typedef unsigned short bf16_t;
typedef short bf16x8 __attribute__((ext_vector_type(8)));
typedef float f32x4 __attribute__((ext_vector_type(4)));
typedef unsigned u32x4 __attribute__((ext_vector_type(4)));
typedef unsigned u32x2 __attribute__((ext_vector_type(2)));

#ifndef PROBE_CLK
#define PROBE_CLK 0
#endif
#ifndef PROBE_STAMP
#define PROBE_STAMP -1
#endif
#ifndef PROBE_PARTS
#define PROBE_PARTS 7
#endif
#ifndef PROBE_REP
#define PROBE_REP 0
#endif

constexpr int NB = 4, SEQ = 8192, DM = 1024, NTOK = NB * SEQ;
constexpr int NIN = 4096;
constexpr int DFF = 4096;
constexpr int SEGT = 512, NSEG = SEQ / SEGT;
constexpr float EPS = 1e-6f;
constexpr int NWAVES = 8, NTHR = 512;
constexpr float C1 = 0.18033688011112042f;

constexpr size_t MiB = 1024 * 1024;
constexpr size_t al256(size_t x) { return (x + 255) & ~(size_t)255; }
constexpr size_t O_WT_IN = 0;
constexpr size_t O_WT_GLU = O_WT_IN + (size_t)NIN * 1024 * 2;
constexpr size_t O_WT_PS = O_WT_GLU + 512 * 512 * 2;
constexpr size_t O_WT_PN = O_WT_PS + 1024 * 512 * 2;
constexpr size_t O_WT_OUT = O_WT_PN + 1024 * 512 * 2;
constexpr size_t O_WT_UP = O_WT_OUT + 1024 * 1024 * 2;
constexpr size_t O_WT_DOWN = O_WT_UP + (size_t)4096 * 1024 * 2;
constexpr size_t O_WT_CK1 = O_WT_DOWN + (size_t)4096 * 1024 * 2;
constexpr size_t O_WT_CV1 = O_WT_CK1 + 128 * 2048 * 2;
constexpr size_t O_WT_CK2 = O_WT_CV1 + 128 * 2048 * 2;
constexpr size_t O_WT_CV2 = O_WT_CK2 + 64 * 128 * 2;
constexpr size_t O_B1K = O_WT_CV2 + 64 * 128 * 2;
constexpr size_t O_B1V = O_B1K + 512;
constexpr size_t O_ABAR = O_B1V + 512;
constexpr size_t O_AL = O_ABAR + 32 * 64 * 2 * 4;
constexpr size_t O_BBT = O_AL + 32 * 64 * 2 * 4;
constexpr size_t O_CT = O_BBT + 32 * 128 * 16 * 2;
constexpr size_t O_ENDS = O_CT + 32 * 16 * 128 * 2;
constexpr size_t O_SSQ = O_ENDS + (size_t)NB * NSEG * 32 * 64 * 2 * 4;
constexpr size_t O_GATES = O_SSQ + (size_t)NTOK * 4;
constexpr size_t O_KC = O_GATES + (size_t)NTOK * 24 * 4;
constexpr size_t O_VCT = O_KC + 8 * 512 * 64 * 2;
constexpr size_t O_M2 = O_VCT + 8 * 512 * 64 * 2;
constexpr size_t O_BAR = O_M2 + 4096;
constexpr size_t O_E16 = O_BAR + 16384;
constexpr size_t O_A16 = O_E16 + 32 * 128 * 256 * 2;
constexpr size_t O_REGA = al256(O_A16 + 32 * 64 * 2 * 4);
constexpr size_t O_XN = O_REGA;
constexpr size_t O_YSSM = O_XN;
constexpr size_t O_YNSA = O_XN + 32 * MiB;
constexpr size_t O_U = O_XN + 64 * MiB;
constexpr size_t O_QN = O_U + 32 * MiB;
constexpr size_t O_KCIN = O_QN + 32 * MiB;
constexpr size_t O_VCIN = O_KCIN + 8 * MiB;
constexpr size_t O_KS = O_VCIN + 8 * MiB;
constexpr size_t O_KW = O_KS + 8 * MiB;
constexpr size_t O_YG = O_KW + 8 * MiB;
constexpr size_t O_VST = O_YG + 32 * MiB;
constexpr size_t O_VWT = O_VST + 8 * MiB;
constexpr size_t O_FF = O_REGA;
constexpr size_t O_REGB = O_REGA + 256 * MiB;
constexpr size_t O_MG = O_REGB;
constexpr size_t O_X1B = O_REGB;
constexpr size_t O_MERGED = O_REGB + 128 * MiB;
constexpr size_t WS_END = O_MERGED + 64 * MiB;
static_assert(O_VWT + 8 * MiB <= O_REGB, "region A overflow");

__device__ __forceinline__ float bf2f(bf16_t h) { return __uint_as_float(((unsigned)h) << 16); }
__device__ __forceinline__ float bflo(unsigned w) { return __uint_as_float(w << 16); }
__device__ __forceinline__ float bfhi(unsigned w) { return __uint_as_float(w & 0xffff0000u); }
__device__ __forceinline__ bf16_t f2bf(float f) { unsigned u = __float_as_uint(f); u += 0x7fffu + ((u >> 16) & 1u); return (bf16_t)(u >> 16); }
typedef __bf16 bf16x2_t __attribute__((ext_vector_type(2)));
typedef float f32x2_t __attribute__((ext_vector_type(2)));
__device__ __forceinline__ unsigned pk2(float lo, float hi) { const f32x2_t f = {lo, hi}; const bf16x2_t v = __builtin_convertvector(f, bf16x2_t); return __builtin_bit_cast(unsigned, v); }
__device__ __forceinline__ u32x2 pk4(const f32x4 v) { return (u32x2){pk2(v[0], v[1]), pk2(v[2], v[3])}; }
__device__ __forceinline__ float sigmoidf_(float x) { return __builtin_amdgcn_rcpf(1.0f + __builtin_amdgcn_exp2f(x * -1.4426950408889634f)); }
__device__ __forceinline__ float gelu_tanh(float x) { const float w = __builtin_fmaf(x * x, -0.10294324f, -2.3022082f); return x * __builtin_amdgcn_rcpf(1.0f + __builtin_amdgcn_exp2f(x * w)); }
__device__ __forceinline__ float wave_sum(float v) {
#pragma unroll
    for (int o = 1; o < 64; o <<= 1) v += __shfl_xor(v, o);
    return v;
}

__device__ __forceinline__ int opaque_tid() { int t = threadIdx.x; asm volatile("" : "+v"(t)); return t; }

struct Ptrs {
    const float* in[27];
    float* out;
    unsigned char* ws;
};

struct TrDesc { const float* src; bf16_t* dst; const float* kscale; int K, N, ldsrc, mode, tiles_n, tile0; };
constexpr int NTR = 11;
struct TrTable { TrDesc d[NTR]; int total; int n; };

__device__ __forceinline__ int in_col(int n) {
    const int T = n >> 8, p = n & 255, bj = p >> 7, wc = (p >> 5) & 3, dlo = p & 31;
    int L = 64 * (4 * T + wc) + 32 * bj + dlo;
    { const int sg = 4 * T + wc; if (sg >= 28 && sg < 60) L = 1792 + bj * 1024 + 32 * (sg - 28) + dlo; }
    if (L < 1792) return L;
    if (L < 3840) return L + 24;
    if (L < 3864) return L - 3840 + 1792;
    return -1;
}

__device__ __forceinline__ void tr_load(const TrTable& tt, int it, int tid, f32x4 (&v)[2], float (&ks)[2]) {
    int di = 0;
#pragma unroll
    for (int i = 1; i < NTR; ++i) if (i < tt.n && it >= tt.d[i].tile0) di = i;
    const TrDesc& d = tt.d[di];
    const int lt = it - d.tile0, tn = lt % d.tiles_n, tk = lt / d.tiles_n, k0 = tk * 64, n0 = tn * 64;
#pragma unroll
    for (int i = 0; i < 2; ++i) {
        const int kk = (tid >> 4) + 32 * i, nn = (tid & 15) * 4;
        int col = n0 + nn; if (d.mode == 1) col = in_col(col);
        v[i] = (f32x4){0.f, 0.f, 0.f, 0.f};
        if (col >= 0) v[i] = __builtin_nontemporal_load((const f32x4*)(d.src + (size_t)(k0 + kk) * d.ldsrc + col));
        ks[i] = 1.0f; if (d.kscale) ks[i] = d.kscale[k0 + kk];
    }
}
template <int TRD = 3>
__device__ __forceinline__ void transpose_phase(const TrTable& tt, char* smem, int first, int step, bool pair = false) {
    const int tid = opaque_tid();
#define TR_IT(j_) (pair ? first + ((j_) & 1) + ((j_) >> 1) * step : first + (j_) * step)
    f32x4 vq[TRD][2]; float sq[TRD][2];
#pragma unroll
    for (int t = 0; t < TRD; ++t) {
#pragma unroll
        for (int i = 0; i < 2; ++i) { vq[t][i] = (f32x4){0.f, 0.f, 0.f, 0.f}; sq[t][i] = 1.f; }
        if (TR_IT(t) < tt.total) tr_load(tt, TR_IT(t), tid, vq[t], sq[t]);
    }
    for (int j = 0; TR_IT(j) < tt.total; ++j) {
        const int it = TR_IT(j);
        float* tile = (float*)smem + (j & 1) * (64 * 65 + 32);
        int di = 0;
#pragma unroll
        for (int i = 1; i < NTR; ++i) if (i < tt.n && it >= tt.d[i].tile0) di = i;
        const TrDesc& d = tt.d[di];
        const int lt = it - d.tile0, tn = lt % d.tiles_n, tk = lt / d.tiles_n, k0 = tk * 64, n0 = tn * 64;
#pragma unroll
        for (int i = 0; i < 2; ++i) { const int kk = (tid >> 4) + 32 * i, nn = (tid & 15) * 4; float* tp = tile + kk * 65 + nn; const f32x4 w = vq[0][i] * sq[0][i]; tp[0] = w[0]; tp[1] = w[1]; tp[2] = w[2]; tp[3] = w[3]; }
#pragma unroll
        for (int t = 0; t + 1 < TRD; ++t)
#pragma unroll
            for (int i = 0; i < 2; ++i) { vq[t][i] = vq[t + 1][i]; sq[t][i] = sq[t + 1][i]; }
        if (TR_IT(j + TRD) < tt.total) tr_load(tt, TR_IT(j + TRD), tid, vq[TRD - 1], sq[TRD - 1]);
        __syncthreads();
        {
            const int nn = tid >> 3, kc = (tid & 7) * 8; const float* tp = tile + kc * 65 + nn;
            const u32x4 o = {pk2(tp[0], tp[65]), pk2(tp[2 * 65], tp[3 * 65]), pk2(tp[4 * 65], tp[5 * 65]), pk2(tp[6 * 65], tp[7 * 65])};
            *(u32x4*)(d.dst + (size_t)(n0 + nn) * d.K + k0 + kc) = o;
        }
    }
#undef TR_IT
    __syncthreads();
}

__device__ __forceinline__ void consts_phase(const Ptrs& P, int vb, int nvb) {
    const int tid_ = opaque_tid(); const int gt = vb * NTHR + tid_, ngt = nvb * NTHR;
    unsigned char* ws = P.ws;
    for (int i = vb + nvb * tid_; i < 32 * 64; i += ngt) {
        const int g = i >> 6, p = i & 63;
        const float ar = P.in[3][i], ai = P.in[4][i], dt = expf(P.in[5][g]);
        const float mag = expf(ar * dt), abr = mag * cosf(ai * dt), abi = mag * sinf(ai * dt);
        const float den = ar * ar + ai * ai, nr = abr - 1.0f;
        const float fr = (nr * ar + abi * ai) / den, fi = (abi * ar - nr * ai) / den;
        float* ABAR = (float*)(ws + O_ABAR); float* AL = (float*)(ws + O_AL);
        ABAR[i * 2] = abr; ABAR[i * 2 + 1] = abi;
        double pr = (double)abr, pi = (double)abi;
        for (int s = 0; s < 9; ++s) { const double nr2 = pr * pr - pi * pi, ni2 = 2.0 * pr * pi; pr = nr2; pi = ni2; }
        AL[i * 2] = (float)pr; AL[i * 2 + 1] = (float)pi;
        bf16_t* BBT = (bf16_t*)(ws + O_BBT);
        for (int c = 0; c < 16; ++c) {
            const float br = P.in[6][(size_t)i * 16 + c], bi = P.in[7][(size_t)i * 16 + c];
            BBT[((size_t)g * 128 + 2 * p) * 16 + c] = f2bf(fr * br - fi * bi);
            BBT[((size_t)g * 128 + 2 * p + 1) * 16 + c] = f2bf(fr * bi + fi * br);
        }
        bf16_t* CT = (bf16_t*)(ws + O_CT);
        for (int c = 0; c < 16; ++c) {
            CT[((size_t)g * 16 + c) * 128 + 2 * p] = f2bf(P.in[8][((size_t)g * 16 + c) * 64 + p]);
            CT[((size_t)g * 16 + c) * 128 + 2 * p + 1] = f2bf(-P.in[9][((size_t)g * 16 + c) * 64 + p]);
        }
    }
    for (int it = gt; it < 32 * 64 * 16; it += ngt) {
        const int i = it >> 4, s = it & 15, g = i >> 6, p = i & 63;
        const float ar = P.in[3][i], ai = P.in[4][i], dt = expf(P.in[5][g]);
        const float mag = expf(ar * dt), abr = mag * cosf(ai * dt), abi = mag * sinf(ai * dt);
        const float den = ar * ar + ai * ai, nr = abr - 1.0f;
        const float fr = (nr * ar + abi * ai) / den, fi = (abi * ar - nr * ai) / den;
        float wr_ = 1.f, wi_ = 0.f;
        for (int k = 0; k < 15 - s; ++k) { const float nwr = wr_ * abr - wi_ * abi, nwi = wr_ * abi + wi_ * abr; wr_ = nwr; wi_ = nwi; }
        bf16_t* E16 = (bf16_t*)(ws + O_E16) + ((size_t)g * 128 + 2 * p) * 256 + 16 * s;
        for (int c = 0; c < 16; ++c) {
            const float br = P.in[6][(size_t)i * 16 + c], bi = P.in[7][(size_t)i * 16 + c];
            const float bbr = fr * br - fi * bi, bbi = fr * bi + fi * br;
            E16[c] = f2bf(wr_ * bbr - wi_ * bbi); E16[256 + c] = f2bf(wr_ * bbi + wi_ * bbr);
        }
        if (s == 0) { const float nwr = wr_ * abr - wi_ * abi, nwi = wr_ * abi + wi_ * abr; ((float*)(ws + O_A16))[i * 2] = nwr; ((float*)(ws + O_A16))[i * 2 + 1] = nwi; }
    }
    if (gt < 3) {
        float gq = 0.f, gk = 0.f;
        for (int d = 0; d < 64; ++d) { gq = fmaxf(gq, fabsf(P.in[19][d])); gk = fmaxf(gk, fabsf(P.in[20][gt * 64 + d])); }
        ((float*)(ws + O_M2))[gt] = 64.0f * C1 * gq * gk;
    }
    float* SSQ = (float*)(ws + O_SSQ);
    for (int i = gt; i < NTOK; i += ngt) SSQ[i] = 0.f;
    if ((tid_ >> 6) == 0) {
        const int lane = tid_ & 63;
        for (int o = vb; o < 256; o += nvb) {
            const int isv = o >> 7, n = o & 127;
            const float* pe = P.in[isv ? 14 : 13]; const float* w1 = P.in[isv ? 17 : 15];
            float wv[32], pv[32];
#pragma unroll
            for (int i = 0; i < 32; ++i) { wv[i] = w1[(size_t)(lane + 64 * i) * 128 + n]; pv[i] = pe[lane + 64 * i]; }
            float s_ = 0.f;
#pragma unroll
            for (int i = 0; i < 32; ++i) s_ += pv[i] * bflo(pk2(wv[i], 0.f));
            s_ = wave_sum(s_);
            if (lane == 0) ((float*)(ws + (isv ? O_B1V : O_B1K)))[n] = s_;
        }
    }
}

__device__ __forceinline__ void rmsnorm1_phase(const Ptrs& P, int vb, int nvb) {
    const int tid_ = opaque_tid(); const int lane = tid_ & 63, gw = vb * NWAVES + (tid_ >> 6), ngw = nvb * NWAVES;
    const float* x = P.in[0]; const float* g = P.in[1]; bf16_t* XN = (bf16_t*)(P.ws + O_XN);
    f32x4 gg[4];
#pragma unroll
    for (int j = 0; j < 4; ++j) gg[j] = ((const f32x4*)g)[j * 64 + lane];
    f32x4 r0[4], r1[4], r2[4];
    const int nrow = (NTOK - gw + ngw - 1) / ngw;
#define RMS_LOAD(dst, k) do { if ((k) < nrow) { _Pragma("unroll") for (int j = 0; j < 4; ++j) dst[j] = __builtin_nontemporal_load((const f32x4*)(x + (size_t)(gw + (k) * ngw) * DM) + j * 64 + lane); } } while (0)
#define RMS_ROW(src, k) do { if ((k) < nrow) { const int row = gw + (k) * ngw; float ss = 0.f; \
        _Pragma("unroll") for (int j = 0; j < 4; ++j) { const f32x4 v = src[j]; ss += v[0] * v[0] + v[1] * v[1] + v[2] * v[2] + v[3] * v[3]; } \
        ss = wave_sum(ss); const float rstd = rsqrtf(ss * (1.0f / DM) + EPS); \
          \
        bf16_t* xt_ = XN + ((size_t)(row >> 8) << 18) + (size_t)(lane >> 4) * 16384 + (row & 255) * 64 + 4 * (lane & 15); \
        _Pragma("unroll") for (int j = 0; j < 4; ++j) *(u32x2*)(xt_ + j * 4 * 16384) = pk4(src[j] * gg[j] * rstd); } } while (0)
    RMS_LOAD(r0, 0); RMS_LOAD(r1, 1);
    for (int k = 0; k < nrow; k += 3) {
        RMS_LOAD(r2, k + 2); RMS_ROW(r0, k);
        RMS_LOAD(r0, k + 3); RMS_ROW(r1, k + 1);
        RMS_LOAD(r1, k + 4); RMS_ROW(r2, k + 2);
    }
#undef RMS_LOAD
#undef RMS_ROW
}

namespace pg8 {
#define PG8_LAS __attribute__((address_space(3)))
typedef unsigned short bf16_t;
typedef short bf16x8 __attribute__((ext_vector_type(8)));
typedef float f32x4 __attribute__((ext_vector_type(4)));
typedef unsigned u32x4 __attribute__((ext_vector_type(4)));
constexpr int BM = 256, BK = 64, HALF = 128, HTB = HALF * BK * 2  , STAGE_BYTES = 8 * HTB, NXCD = 8, WGM = 8;

__host__ __device__ __forceinline__ int lds_byte(int r, int c) { const int st = (r >> 4) * 2 + (c >> 5), rr = r & 15, cc = c & 31, ob = rr * 64 + cc * 2; return st * 1024 + (ob ^ (((ob >> 9) & 1) << 5)); }
__host__ __device__ __forceinline__ void stage_rc(int b, int& R, int& C) { const int st = b / 1024, sb = b % 1024, swz = sb ^ (((sb >> 9) & 1) << 5); R = (st >> 1) * 16 + swz / 64; C = (st & 1) * 32 + (swz % 64) / 2; }
__host__ __device__ __forceinline__ int perm32(int rho) { const int n = rho >> 4, i = rho & 15; return 8 * (i >> 2) + 4 * n + (i & 3); }

struct Unit { int pm, pn; };
struct Gemm { const bf16_t* A; const bf16_t* Bt; int M, N, K; const bf16_t* A2; const bf16_t* Bt2; };

struct StaticOrder {
    int nM, nN, nwg, G, c;
    __host__ __device__ void init(int M, int N, int G_, int c_) { nM = M / BM; nN = N / BM; nwg = nM * nN; G = G_; c = c_; }
    __host__ __device__ bool next(int i, Unit& u) const {
        const long L = (long)i * G + c; if (L >= nwg) return false;
        int wgid = (int)L; { const int q = nwg / NXCD, r = nwg % NXCD, xcd = wgid % NXCD, off = wgid / NXCD; wgid = (xcd < r ? xcd * (q + 1) : r * (q + 1) + (xcd - r) * q) + off; }
        if (nN == 16 && nM == 128 && nwg == 2048) {
            const int x = wgid >> 8, off = wgid & 255, rnd = off >> 5, w = off & 31;
            u.pm = 16 * x + 8 * (((rnd + 1) >> 1) & 1) + (w & 7); u.pn = 4 * (rnd >> 1) + (w >> 3); return true;
        }
        const int nig = WGM * nN, gid = wgid / nig, fm = gid * WGM, gsz = (nM - fm) < WGM ? (nM - fm) : WGM;
        u.pm = fm + ((wgid % nig) % gsz); u.pn = (wgid % nig) / gsz; return true;
    }
    __device__ __forceinline__ void a_ready(const Unit&) const {}
    __device__ __forceinline__ void done(const Unit&) const {}
};
__device__ __forceinline__ float pg_row_ssq(const f32x4 (&acc)[2][2][4][2], int ai, int m) {
    float s = 0.f;
#pragma unroll
    for (int bj = 0; bj < 2; ++bj)
#pragma unroll
        for (int n = 0; n < 2; ++n) { const f32x4 v = acc[ai][bj][m][n]; s += (v[0] * v[0] + v[1] * v[1]) + (v[2] * v[2] + v[3] * v[3]); }
    s += __shfl_xor(s, 16); s += __shfl_xor(s, 32);
    return s;
}
__device__ __forceinline__ size_t tiled_off(int row, int col, int N) { return (((size_t)(row >> 4) * (size_t)(N >> 5) + (size_t)(col >> 5)) << 9) + (size_t)(((row & 15) << 5) + (col & 31)); }
__device__ __forceinline__ unsigned tiled_lane(int wr, int wc, int fr, int fq, int N) { return (unsigned)(((4 * wr) * (N >> 5) + wc) << 9) + (unsigned)(fr * 32 + 8 * fq); }
__device__ __forceinline__ constexpr unsigned tiled_sub(int ai, int m, int bj, int N) { return (unsigned)(((8 * ai + m) * (N >> 5) + 4 * bj) << 9); }
__device__ __forceinline__ ::u32x4 pk8(const f32x4 a, const f32x4 b) { const ::u32x2 x = pk4(a), y = pk4(b); return (::u32x4){x[0], x[1], y[0], y[1]}; }
struct EpiIn {
    static constexpr bool PERM = true, AFTER_DRAIN = false;
    unsigned char* ws; const float* gq; const float* gk;
    __device__ __forceinline__ void operator()(const f32x4 (&acc)[2][2][4][2], const Unit& u, int wr, int wc, int fr, int fq) const {
        const int seg = 4 * u.pn + wc, L0 = 64 * seg, row0 = u.pm * BM + wr * 64 + fr;
        if (L0 < 512) {
            ::bf16_t* U = (::bf16_t*)(ws + O_U);
#pragma unroll
            for (int ai = 0; ai < 2; ++ai)
#pragma unroll
                for (int m = 0; m < 4; ++m) { ::bf16_t* rp = U + (size_t)(row0 + ai * HALF + m * 16) * 512 + L0 + 8 * fq;
#pragma unroll
                    for (int bj = 0; bj < 2; ++bj) *(::u32x4*)(rp + 32 * bj) = pk8(acc[ai][bj][m][0], acc[ai][bj][m][1]); }
        } else if (L0 < 1024) {
            ::bf16_t* QN = (::bf16_t*)(ws + O_QN);
            f32x4 gqr[2][2];
#pragma unroll
            for (int bj = 0; bj < 2; ++bj) { gqr[bj][0] = *(const f32x4*)(gq + 32 * bj + 8 * fq); gqr[bj][1] = *(const f32x4*)(gq + 32 * bj + 8 * fq + 4); }
#pragma unroll
            for (int ai = 0; ai < 2; ++ai)
#pragma unroll
                for (int m = 0; m < 4; ++m) { const float rs = rsqrtf(pg_row_ssq(acc, ai, m) * (1.0f / 64) + EPS) * C1;
                    ::bf16_t* rp = QN + (size_t)(row0 + ai * HALF + m * 16) * 512 + (L0 - 512) + 8 * fq;
#pragma unroll
                    for (int bj = 0; bj < 2; ++bj) *(::u32x4*)(rp + 32 * bj) = pk8(acc[ai][bj][m][0] * gqr[bj][0] * rs, acc[ai][bj][m][1] * gqr[bj][1] * rs); }
        } else if (L0 < 1792) {
            const int idx = (L0 - 1024) >> 6, br = idx >> 2, isv = (idx >> 1) & 1, g = idx & 1;
            if (!isv || br == 0) {
                ::bf16_t* dst = (::bf16_t*)(ws + (br == 0 ? (isv ? O_VCIN : O_KCIN) : (br == 1 ? O_KS : O_KW)));
                const bool donorm = br > 0; const float* gkk = gk + br * 64;
                f32x4 gkr_[2][2];
#pragma unroll
                for (int bj = 0; bj < 2; ++bj) { gkr_[bj][0] = *(const f32x4*)(gkk + 32 * bj + 8 * fq); gkr_[bj][1] = *(const f32x4*)(gkk + 32 * bj + 8 * fq + 4); }
#pragma unroll
                for (int ai = 0; ai < 2; ++ai)
#pragma unroll
                    for (int m = 0; m < 4; ++m) { const int r = row0 + ai * HALF + m * 16, b = r >> 13, s = r & 8191;
                        float rs = 1.f; if (donorm) rs = rsqrtf(pg_row_ssq(acc, ai, m) * (1.0f / 64) + EPS);
                        ::bf16_t* rp = dst + ((size_t)(b * 2 + g) * SEQ + s) * 64 + 8 * fq;
#pragma unroll
                        for (int bj = 0; bj < 2; ++bj) { f32x4 v0 = acc[ai][bj][m][0], v1 = acc[ai][bj][m][1];
                            if (donorm) { v0 = v0 * gkr_[bj][0] * rs; v1 = v1 * gkr_[bj][1] * rs; }
                            *(::u32x4*)(rp + 32 * bj) = pk8(v0, v1); } }
            } else {
                ::bf16_t* dst = (::bf16_t*)(ws + (br == 1 ? O_VST : O_VWT));
#pragma unroll
                for (int ai = 0; ai < 2; ++ai)
#pragma unroll
                    for (int m = 0; m < 4; ++m) { const int r = row0 + ai * HALF + m * 16, b = r >> 13, s = r & 8191;
#pragma unroll
                        for (int bj = 0; bj < 2; ++bj)
#pragma unroll
                            for (int n = 0; n < 2; ++n) { const ::u32x2 o = pk4(acc[ai][bj][m][n]); ::bf16_t* dT = dst + ((size_t)(b * 2 + g) * 64 + 32 * bj + 8 * fq + 4 * n) * SEQ + s;
                                dT[0] = (::bf16_t)(o[0] & 0xffff); dT[SEQ] = (::bf16_t)(o[0] >> 16); dT[2 * SEQ] = (::bf16_t)(o[1] & 0xffff); dT[3 * SEQ] = (::bf16_t)(o[1] >> 16); } }
            }
        } else if (L0 < 3840) {
            ::bf16_t* MG = (::bf16_t*)(ws + O_MG);
            const int c0 = 32 * (seg - 28) + 8 * fq;
#pragma unroll
            for (int ai = 0; ai < 2; ++ai)
#pragma unroll
                for (int m = 0; m < 4; ++m) { ::bf16_t* rp = MG + (size_t)(row0 + ai * HALF + m * 16) * 2048 + c0;
                    f32x4 rr[2], g1s[2];
#pragma unroll
                    for (int n = 0; n < 2; ++n)
#pragma unroll
                        for (int r = 0; r < 4; ++r) { const float e0 = __builtin_amdgcn_exp2f(acc[ai][0][m][n][r] * -1.4426950408889634f), e1 = fminf(__builtin_amdgcn_exp2f(acc[ai][1][m][n][r] * -1.4426950408889634f), 1e30f);
                            rr[n][r] = (1.0f + e1) * __builtin_amdgcn_rcpf(1.0f + e0); g1s[n][r] = __builtin_amdgcn_rcpf(1.0f + e1); }
                    *(::u32x4*)rp = pk8(rr[0], rr[1]); *(::u32x4*)(rp + 1024) = pk8(g1s[0], g1s[1]); }
        } else if (L0 == 3840) {
            float* G = (float*)(ws + O_GATES);
#pragma unroll
            for (int ai = 0; ai < 2; ++ai)
#pragma unroll
                for (int m = 0; m < 4; ++m)
#pragma unroll
                    for (int n = 0; n < 2; ++n) { const int c = 8 * fq + 4 * n;
                        if (c < 24) { const f32x4 v = acc[ai][0][m][n]; *(f32x4*)(G + (size_t)(row0 + ai * HALF + m * 16) * 24 + c) = (f32x4){sigmoidf_(v[0]), sigmoidf_(v[1]), sigmoidf_(v[2]), sigmoidf_(v[3])}; } }
        }
    }
};
#define PG_EPI_LOOP(...) \
    _Pragma("unroll") for (int ai = 0; ai < 2; ++ai) _Pragma("unroll") for (int m = 0; m < 4; ++m) { const int row = u.pm * BM + ai * HALF + wr * 64 + m * 16 + fr; \
        _Pragma("unroll") for (int bj = 0; bj < 2; ++bj) _Pragma("unroll") for (int n = 0; n < 2; ++n) { const int col = u.pn * BM + bj * HALF + wc * 32 + 8 * fq + 4 * n; const f32x4 v = acc[ai][bj][m][n]; __VA_ARGS__ } }
struct EpiGlu {
    static constexpr bool PERM = true, AFTER_DRAIN = false;
    const ::bf16_t* YG; ::bf16_t* YS; const float* bias;
    __device__ __forceinline__ void operator()(const f32x4 (&acc)[2][2][4][2], const Unit& u, int wr, int wc, int fr, int fq) const {
        const size_t ub_ = tiled_off(u.pm * BM, u.pn * BM, 512); const ::bf16_t* ygb_ = YG + ub_; ::bf16_t* ysb_ = YS + ub_; const unsigned gl_ = tiled_lane(wr, wc, fr, fq, 512);
        f32x4 br_[2][2];
#pragma unroll
        for (int bj = 0; bj < 2; ++bj) { const int col = u.pn * BM + bj * HALF + wc * 32 + 8 * fq; br_[bj][0] = *(const f32x4*)(bias + col); br_[bj][1] = *(const f32x4*)(bias + col + 4); }
#pragma unroll
        for (int ai = 0; ai < 2; ++ai)
#pragma unroll
            for (int m = 0; m < 4; ++m) { const int row = u.pm * BM + ai * HALF + wr * 64 + m * 16 + fr;
#pragma unroll
                for (int bj = 0; bj < 2; ++bj) { const int col = u.pn * BM + bj * HALF + wc * 32 + 8 * fq;
                    const unsigned off = gl_ + tiled_sub(ai, m, bj, 512); const ::u32x4 yy = *(const ::u32x4*)(ygb_ + off);
                    const f32x4 b0 = br_[bj][0], b1 = br_[bj][1]; const f32x4 v0 = acc[ai][bj][m][0], v1 = acc[ai][bj][m][1];
                    *(::u32x4*)(ysb_ + off) = (::u32x4){pk2(bflo(yy[0]) * sigmoidf_(v0[0] + b0[0]), bfhi(yy[0]) * sigmoidf_(v0[1] + b0[1])), pk2(bflo(yy[1]) * sigmoidf_(v0[2] + b0[2]), bfhi(yy[1]) * sigmoidf_(v0[3] + b0[3])),
                                                     pk2(bflo(yy[2]) * sigmoidf_(v1[0] + b1[0]), bfhi(yy[2]) * sigmoidf_(v1[1] + b1[1])), pk2(bflo(yy[3]) * sigmoidf_(v1[2] + b1[2]), bfhi(yy[3]) * sigmoidf_(v1[3] + b1[3]))}; } }
    }
};
struct EpiMergeDual {
    static constexpr bool PERM = true, AFTER_DRAIN = false;
    const ::bf16_t* MG; ::bf16_t* ME;
    __device__ __forceinline__ void mid(f32x4 (&acc)[2][2][4][2], const Unit& u, int wr, int wc, int fr, int fq) const {
#pragma unroll
        for (int ai = 0; ai < 2; ++ai)
#pragma unroll
            for (int m = 0; m < 4; ++m) { const int row = u.pm * BM + ai * HALF + wr * 64 + m * 16 + fr;
#pragma unroll
                for (int bj = 0; bj < 2; ++bj) { const int colb = u.pn * BM + bj * HALF + wc * 32 + 8 * fq;
                    const ::u32x4 rw = *(const ::u32x4*)(MG + (size_t)row * 2048 + colb);
                    acc[ai][bj][m][0] = acc[ai][bj][m][0] * (f32x4){bflo(rw[0]), bfhi(rw[0]), bflo(rw[1]), bfhi(rw[1])};
                    acc[ai][bj][m][1] = acc[ai][bj][m][1] * (f32x4){bflo(rw[2]), bfhi(rw[2]), bflo(rw[3]), bfhi(rw[3])}; } }
    }
    __device__ __forceinline__ void operator()(const f32x4 (&acc)[2][2][4][2], const Unit& u, int wr, int wc, int fr, int fq) const {
#pragma unroll
        for (int ai = 0; ai < 2; ++ai)
#pragma unroll
            for (int m = 0; m < 4; ++m) { const int row = u.pm * BM + ai * HALF + wr * 64 + m * 16 + fr;
#pragma unroll
                for (int bj = 0; bj < 2; ++bj) { const int col = u.pn * BM + bj * HALF + wc * 32 + 8 * fq;
                    const ::u32x4 g1 = *(const ::u32x4*)(MG + (size_t)row * 2048 + 1024 + col); const f32x4 v = acc[ai][bj][m][0], w = acc[ai][bj][m][1];
                    const f32x4 o0 = {bflo(g1[0]) * v[0], bfhi(g1[0]) * v[1], bflo(g1[1]) * v[2], bfhi(g1[1]) * v[3]}, o1 = {bflo(g1[2]) * w[0], bfhi(g1[2]) * w[1], bflo(g1[3]) * w[2], bfhi(g1[3]) * w[3]};
                    *(::u32x4*)(ME + tiled_off(row, col, 1024)) = pk8(o0, o1); } }
    }
};
struct EpiOut {
    static constexpr bool PERM = true, AFTER_DRAIN = false;
    const float* x; ::bf16_t* X1B; float* SSQ;
    __device__ __forceinline__ void operator()(const f32x4 (&acc)[2][2][4][2], const Unit& u, int wr, int wc, int fr, int fq) const {
#pragma unroll
        for (int ai = 0; ai < 2; ++ai)
#pragma unroll
            for (int m = 0; m < 4; ++m) { const int row = u.pm * BM + ai * HALF + wr * 64 + m * 16 + fr; float s = 0.f;
#pragma unroll
                for (int bj = 0; bj < 2; ++bj) { const size_t off = (size_t)row * 1024 + u.pn * BM + bj * HALF + wc * 32 + 8 * fq;
                    const f32x4 o0 = acc[ai][bj][m][0] + *(const f32x4*)(x + off), o1 = acc[ai][bj][m][1] + *(const f32x4*)(x + off + 4);
                    const ::u32x2 p0 = pk4(o0), p1 = pk4(o1); *(::u32x4*)(X1B + ((size_t)u.pm << 18) + (size_t)(((u.pn * 4 + bj * 2 + (wc >> 1)) * 16 + (ai * 8 + wr * 4 + m)) * 2 + (wc & 1)) * 512 + fr * 32 + 8 * fq) = (::u32x4){p0[0], p0[1], p1[0], p1[1]};
                    s += ((o0[0] * o0[0] + o0[1] * o0[1]) + (o0[2] * o0[2] + o0[3] * o0[3])) + ((o1[0] * o1[0] + o1[1] * o1[1]) + (o1[2] * o1[2] + o1[3] * o1[3])); }
                s += __shfl_xor(s, 16); s += __shfl_xor(s, 32);
                if (fq == 0) atomicAdd(SSQ + row, s); }
    }
};
struct EpiUp {
    static constexpr bool PERM = true, AFTER_DRAIN = false;
    ::bf16_t* FF; const float* SSQ;
    __device__ __forceinline__ void operator()(const f32x4 (&acc)[2][2][4][2], const Unit& u, int wr, int wc, int fr, int fq) const {
#pragma unroll
        for (int ai = 0; ai < 2; ++ai)
#pragma unroll
            for (int m = 0; m < 4; ++m) { const int row = u.pm * BM + ai * HALF + wr * 64 + m * 16 + fr;
#pragma unroll
                for (int bj = 0; bj < 2; ++bj) { f32x4 v0 = acc[ai][bj][m][0], v1 = acc[ai][bj][m][1];
#pragma unroll
                    for (int r = 0; r < 4; ++r) { const float a = fmaxf(v0[r], 0.f), b_ = fmaxf(v1[r], 0.f); v0[r] = a * a; v1[r] = b_ * b_; }
                    *(::u32x4*)(FF + ((size_t)u.pm << 20) + (size_t)(((u.pn * 4 + bj * 2 + (wc >> 1)) * 16 + (ai * 8 + wr * 4 + m)) * 2 + (wc & 1)) * 512 + fr * 32 + 8 * fq) = pk8(v0, v1); } }
    }
};
struct EpiDown {
    static constexpr bool PERM = true, AFTER_DRAIN = false;
    const ::bf16_t* X1B; float* out; const float* SSQ;
    __device__ __forceinline__ void operator()(const f32x4 (&acc)[2][2][4][2], const Unit& u, int wr, int wc, int fr, int fq) const {
#pragma unroll
        for (int ai = 0; ai < 2; ++ai)
#pragma unroll
            for (int m = 0; m < 4; ++m) { const int row = u.pm * BM + ai * HALF + wr * 64 + m * 16 + fr; const float rs2 = __builtin_amdgcn_rcpf(SSQ[row] * (1.0f / DM) + EPS);
#pragma unroll
                for (int bj = 0; bj < 2; ++bj) { const size_t off = (size_t)row * 1024 + u.pn * BM + bj * HALF + wc * 32 + 8 * fq; const ::u32x4 xx = *(const ::u32x4*)(X1B + ((size_t)u.pm << 18) + (size_t)(((u.pn * 4 + bj * 2 + (wc >> 1)) * 16 + (ai * 8 + wr * 4 + m)) * 2 + (wc & 1)) * 512 + fr * 32 + 8 * fq);
                    *(f32x4*)(out + off) = acc[ai][bj][m][0] * rs2 + (f32x4){bflo(xx[0]), bfhi(xx[0]), bflo(xx[1]), bfhi(xx[1])};
                    *(f32x4*)(out + off + 4) = acc[ai][bj][m][1] * rs2 + (f32x4){bflo(xx[2]), bfhi(xx[2]), bflo(xx[3]), bfhi(xx[3])}; } }
    }
};

template <class Epi, class Sched, bool ALIGN_EPI = false, bool SP2 = false, bool DUAL = false, int ATILED = 0>
__device__ __forceinline__ void gemm_phase(PG8_LAS unsigned char* lds, const Gemm g, const Sched& S, const Epi& E) {
    const int tid = opaque_tid(), wid = __builtin_amdgcn_readfirstlane(tid >> 6), lane = tid & 63, wr = wid >> 2, wc = wid & 3, fr = lane & 15, fq = lane >> 4;
    const int K = g.K, hK = K / BK, nt = DUAL ? 2 * hK : hK;
    unsigned voffA[2], voffB[2];
#pragma unroll
    for (int i = 0; i < 2; ++i) { int R, C; stage_rc(tid * 16 + i * 8192, R, C); const int Rb = Epi::PERM ? ((R & ~31) + perm32(R & 31)) : R;
        voffA[i] = ATILED == 3 ? (unsigned)(R * 128 + C * 2)
                 : ATILED == 2 ? (unsigned)(((R >> 4) * 2 + (C >> 5)) * 1024 + ((R & 15) * 32 + (C & 31)) * 2)
                 : ATILED ? (unsigned)(((R >> 4) * (K >> 5) + (C >> 5)) * 1024 + ((R & 15) * 32 + (C & 31)) * 2) : (unsigned)(R * K + C) * 2u; voffB[i] = (unsigned)(Rb * K + C) * 2u; }
    const size_t kstep = (size_t)(BK * 2);
    const size_t kstepA = ATILED >= 2 ? (size_t)32768 : (ATILED ? (size_t)2048 : kstep);
    const size_t hstepA = ATILED >= 2 ? (size_t)16384 : (size_t)HALF * K * 2;
    const size_t hstep = (size_t)HALF * K * 2;
    const size_t tstep = 2 * hstep;
    const unsigned ldsw = (unsigned)wid * 1024u;
    const int aoff = lds_byte(wr * 64 + fr, fq * 8), boff = lds_byte(wc * 32 + fr, fq * 8);
#define PG8_SA(b, h) (((b) * 2 + (h)) * HTB)
#define PG8_SB(b, h) ((4 + (b) * 2 + (h)) * HTB)
#define PG8_STAGE(bufoff, gbase, voff) do { _Pragma("unroll") for (int _i = 0; _i < 2; ++_i) \
        __builtin_amdgcn_global_load_lds((const unsigned*)((const char*)(gbase) + (voff)[_i]), (PG8_LAS unsigned*)(lds + (bufoff) + ldsw + _i * 8192), 16, 0, 0); } while (0)
#define PG8_LDA(dst, b, h) do { _Pragma("unroll") for (int m = 0; m < 4; ++m) _Pragma("unroll") for (int k = 0; k < 2; ++k) dst[m][k] = *(const PG8_LAS bf16x8*)(lds + PG8_SA(b, h) + aoff + m * 2048 + k * 1024); } while (0)
#define PG8_LDB(dst, b, h) do { _Pragma("unroll") for (int n = 0; n < 2; ++n) _Pragma("unroll") for (int k = 0; k < 2; ++k) dst[n][k] = *(const PG8_LAS bf16x8*)(lds + PG8_SB(b, h) + boff + n * 2048 + k * 1024); } while (0)
#define PG8_MMA(ai, bj, At, Bt) do { __builtin_amdgcn_s_setprio(1); _Pragma("unroll") for (int m = 0; m < 4; ++m) _Pragma("unroll") for (int n = 0; n < 2; ++n) _Pragma("unroll") for (int k = 0; k < 2; ++k) \
        acc[ai][bj][m][n] = __builtin_amdgcn_mfma_f32_16x16x32_bf16(Bt[n][k], At[m][k], acc[ai][bj][m][n], 0, 0, 0); __builtin_amdgcn_s_setprio(0); } while (0)
#define PG8_WAIT_V(n) asm volatile("s_waitcnt vmcnt(" #n ")" ::: "memory")
#define PG8_WAIT_L(n) asm volatile("s_waitcnt lgkmcnt(" #n ")" ::: "memory")
#define PG8_BAR __builtin_amdgcn_s_barrier()
#define PG8_SCHED __builtin_amdgcn_sched_barrier(0)
    Unit cur, nxt; int ui = 0;
    if (!S.next(0, cur)) return;
    f32x4 acc[2][2][4][2];
#pragma unroll
    for (int a = 0; a < 2; ++a)
#pragma unroll
        for (int b = 0; b < 2; ++b)
#pragma unroll
            for (int m = 0; m < 4; ++m)
#pragma unroll
                for (int n = 0; n < 2; ++n) acc[a][b][m][n] = (f32x4){0.f, 0.f, 0.f, 0.f};
    bf16x8 At[4][2], B0[2][2], B1[2][2];
    const char* cA = (const char*)g.A + (size_t)cur.pm * tstep; const char* cB = (const char*)g.Bt + (size_t)cur.pn * tstep;
    const char* cA2 = DUAL ? (const char*)g.A2 + (size_t)cur.pm * tstep : cA; const char* cB2 = DUAL ? (const char*)g.Bt2 + (size_t)cur.pn * tstep : cB;
    S.a_ready(cur);
    if constexpr (SP2) {
        PG8_STAGE(PG8_SB(0, 0), cB, voffB); PG8_STAGE(PG8_SB(0, 1), cB + hstep, voffB); PG8_STAGE(PG8_SA(0, 0), cA, voffA); PG8_STAGE(PG8_SA(0, 1), cA + hstepA, voffA);
        if (wr == 1) PG8_BAR;
        PG8_WAIT_V(2); PG8_BAR;
        PG8_STAGE(PG8_SB(1, 0), cB + kstep, voffB); PG8_STAGE(PG8_SA(1, 0), cA + kstepA, voffA); PG8_STAGE(PG8_SB(1, 1), cB + hstep + kstep, voffB);
        PG8_WAIT_V(6); PG8_BAR;
    } else {
        PG8_STAGE(PG8_SB(0, 0), cB, voffB); PG8_STAGE(PG8_SA(0, 0), cA, voffA); PG8_STAGE(PG8_SB(0, 1), cB + hstep, voffB); PG8_STAGE(PG8_SA(0, 1), cA + hstepA, voffA);
        if (wr == 1) PG8_BAR;
        PG8_WAIT_V(4); PG8_BAR;
        PG8_STAGE(PG8_SB(1, 0), cB + kstep, voffB); PG8_STAGE(PG8_SA(1, 0), cA + kstepA, voffA); PG8_STAGE(PG8_SB(1, 1), cB + hstep + kstep, voffB);
        PG8_WAIT_V(6); PG8_BAR;
    }
    for (;;) {
        const bool has_next = S.next(ui + 1, nxt);
        const char* nA = has_next ? (const char*)g.A + (size_t)nxt.pm * tstep : cA; const char* nB = has_next ? (const char*)g.Bt + (size_t)nxt.pn * tstep : cB;
        const char* nA2 = (DUAL && has_next) ? (const char*)g.A2 + (size_t)nxt.pm * tstep : cA2; const char* nB2 = (DUAL && has_next) ? (const char*)g.Bt2 + (size_t)nxt.pn * tstep : cB2;
        for (int t = 0; t < nt; t += 2) {
            const bool last = (t == nt - 2);
            if constexpr (DUAL) { if (t == hK) E.mid(acc, cur, wr, wc, fr, fq); }
            const bool p2a = DUAL && (t >= hK), p2b = DUAL && (t + 2 >= hK);
            const char* a1 = p2a ? cA2 + (size_t)(t + 1 - hK) * kstepA : cA + (size_t)(t + 1) * kstepA;
            const char* a2 = last ? nA : (p2b ? cA2 + (size_t)(t + 2 - hK) * kstepA : cA + (size_t)(t + 2) * kstepA);
            const char* b2 = last ? nB : (p2b ? cB2 + (size_t)(t + 2 - hK) * kstep : cB + (size_t)(t + 2) * kstep);
            const char* a3 = a2 + kstepA; const char* b3 = b2 + kstep;
            if (last && has_next) S.a_ready(nxt);
            if constexpr (SP2) {
            PG8_LDB(B0, 0, 0); PG8_LDB(B1, 0, 1); PG8_SCHED; PG8_LDA(At, 0, 0); PG8_STAGE(PG8_SA(1, 1), a1 + hstepA, voffA);
            PG8_WAIT_V(8); PG8_WAIT_L(0); PG8_BAR; PG8_MMA(0, 0, At, B0); PG8_MMA(0, 1, At, B1); PG8_BAR; PG8_SCHED;
            PG8_LDA(At, 0, 1); PG8_STAGE(PG8_SB(0, 0), b2, voffB); PG8_STAGE(PG8_SB(0, 1), b2 + hstep, voffB); PG8_STAGE(PG8_SA(0, 0), a2, voffA);
            PG8_WAIT_V(8); PG8_WAIT_L(0); PG8_BAR; PG8_MMA(1, 0, At, B0); PG8_MMA(1, 1, At, B1); PG8_BAR; PG8_SCHED;
            PG8_LDB(B0, 1, 0); PG8_LDB(B1, 1, 1); PG8_SCHED; PG8_LDA(At, 1, 0); PG8_STAGE(PG8_SA(0, 1), a2 + hstepA, voffA);
            PG8_WAIT_V(8); PG8_WAIT_L(0); PG8_BAR; PG8_MMA(0, 0, At, B0); PG8_MMA(0, 1, At, B1); PG8_BAR; PG8_SCHED;
            PG8_LDA(At, 1, 1); PG8_STAGE(PG8_SB(1, 0), b3, voffB); PG8_STAGE(PG8_SB(1, 1), b3 + hstep, voffB); PG8_STAGE(PG8_SA(1, 0), a3, voffA);
            PG8_WAIT_V(8); PG8_WAIT_L(0); PG8_BAR; PG8_MMA(1, 0, At, B0); PG8_MMA(1, 1, At, B1); PG8_BAR; PG8_SCHED;
            } else {
            PG8_LDB(B0, 0, 0); PG8_SCHED; PG8_LDA(At, 0, 0); PG8_STAGE(PG8_SA(1, 1), a1 + hstepA, voffA);
            PG8_WAIT_L(8); PG8_BAR; PG8_WAIT_L(0); PG8_MMA(0, 0, At, B0); PG8_BAR; PG8_SCHED;
            PG8_LDB(B1, 0, 1); PG8_STAGE(PG8_SB(0, 0), b2, voffB);
            PG8_BAR; PG8_WAIT_L(0); PG8_MMA(0, 1, At, B1); PG8_BAR;
            PG8_LDA(At, 0, 1); PG8_STAGE(PG8_SA(0, 0), a2, voffA);
            PG8_BAR; PG8_WAIT_L(0); PG8_MMA(1, 0, At, B0); PG8_BAR; PG8_SCHED;
            PG8_STAGE(PG8_SB(0, 1), b2 + hstep, voffB);
            PG8_WAIT_V(6); PG8_BAR; PG8_MMA(1, 1, At, B1); PG8_BAR;
            PG8_LDB(B0, 1, 0); PG8_SCHED; PG8_LDA(At, 1, 0); PG8_STAGE(PG8_SA(0, 1), a2 + hstepA, voffA);
            PG8_WAIT_L(8); PG8_BAR; PG8_WAIT_L(0); PG8_MMA(0, 0, At, B0); PG8_BAR; PG8_SCHED;
            PG8_LDB(B1, 1, 1); PG8_STAGE(PG8_SB(1, 0), b3, voffB);
            PG8_BAR; PG8_WAIT_L(0); PG8_MMA(0, 1, At, B1); PG8_BAR;
            PG8_LDA(At, 1, 1); PG8_STAGE(PG8_SA(1, 0), a3, voffA);
            PG8_BAR; PG8_WAIT_L(0); PG8_MMA(1, 0, At, B0); PG8_BAR; PG8_SCHED;
            PG8_STAGE(PG8_SB(1, 1), b3 + hstep, voffB);
            PG8_WAIT_V(6); PG8_BAR; PG8_MMA(1, 1, At, B1); PG8_BAR;
            }
        }
        if constexpr (ALIGN_EPI) { if (wr == 0) PG8_BAR; }
        if constexpr (!Epi::AFTER_DRAIN) { E(acc, cur, wr, wc, fr, fq); S.done(cur); }
        if (!has_next) break;
#pragma unroll
        for (int a = 0; a < 2; ++a)
#pragma unroll
            for (int b = 0; b < 2; ++b)
#pragma unroll
                for (int m = 0; m < 4; ++m)
#pragma unroll
                    for (int n = 0; n < 2; ++n) acc[a][b][m][n] = (f32x4){0.f, 0.f, 0.f, 0.f};
        cur = nxt; cA = nA; cB = nB; cA2 = nA2; cB2 = nB2; ++ui;
        if constexpr (ALIGN_EPI) { if (wr == 1) PG8_BAR; }
    }
    PG8_WAIT_V(0);
    if constexpr (!ALIGN_EPI) { if (wr == 0) PG8_BAR; }
    PG8_BAR;
    if constexpr (Epi::AFTER_DRAIN) { E.fused(acc, cur, wr, wc, fr, fq, lds, wid, lane); S.done(cur); }
#undef PG8_SA
#undef PG8_SB
#undef PG8_STAGE
#undef PG8_LDA
#undef PG8_LDB
#undef PG8_MMA
#undef PG8_WAIT_V
#undef PG8_WAIT_L
#undef PG8_BAR
#undef PG8_SCHED
}
}
#define XB_TMO      128
#define XB_XCNT(j)  (256  + 64 * (j))
#define XB_XSUB(j)  (1280 + 64 * (j))
#define XB_XGEN(j)  (2304 + 64 * (j))
#define XB_TOP      3328
#define XB_TOPGEN   3392
#define XCD_BAR_WORDS 3456
#define XB_SPIN_CAP (1u << 18)

__device__ __forceinline__ unsigned xb_ld(unsigned* p)              { return __hip_atomic_load(p, __ATOMIC_RELAXED, __HIP_MEMORY_SCOPE_AGENT); }
__device__ __forceinline__ unsigned xb_add(unsigned* p, unsigned v) { return __hip_atomic_fetch_add(p, v, __ATOMIC_RELAXED, __HIP_MEMORY_SCOPE_AGENT); }
__device__ __forceinline__ unsigned xb_xcc_id() { return (unsigned)__builtin_amdgcn_s_getreg((3 << 11) | 20) & 0xFu; }
#define XB_SPIN(cond, bar) do { unsigned _sp = 0; while (cond) { __builtin_amdgcn_s_sleep(1); \
    if ((++_sp & 255u) == 0u) { if (xb_ld(&(bar)[XB_TMO])) break; if (_sp > XB_SPIN_CAP) { atomicAdd(&(bar)[XB_TMO], 1u); break; } } } } while (0)

struct XcdBarrier {
    unsigned* bar; unsigned x;
    volatile __attribute__((address_space(3))) unsigned* st;
};

__device__ __forceinline__ XcdBarrier xcd_barrier_post(unsigned* bar, volatile __attribute__((address_space(3))) unsigned* st) {
    XcdBarrier b; b.bar = bar; b.x = xb_xcc_id(); b.st = st;
    if (threadIdx.x == 0) (void)xb_add(&bar[XB_XCNT(b.x)], 1u);
    return b;
}
__device__ __forceinline__ void xcd_barrier_complete(unsigned* bar, unsigned x, unsigned& nloc, unsigned& nx) {
    const unsigned G = gridDim.x * gridDim.y * gridDim.z;
    unsigned sum, cnt, mine, sp = 0u;
    for (;;) {
        sum = 0u; cnt = 0u; mine = 0u;
#pragma unroll
        for (unsigned j = 0; j < 16; ++j) { const unsigned c = xb_ld(&bar[XB_XCNT(j)]); sum += c; cnt += (c > 0u) ? 1u : 0u; mine = (j == x) ? c : mine; }
        if (sum == G) break;
        __builtin_amdgcn_s_sleep(1);
        if ((++sp & 255u) == 0u) { if (xb_ld(&bar[XB_TMO])) break; if (sp > XB_SPIN_CAP) { atomicAdd(&bar[XB_TMO], 1u); break; } }
    }
    nloc = mine > 0u ? mine : 1u; nx = cnt > 0u ? cnt : 1u;
}

__device__ __forceinline__ void xcd_barrier(const XcdBarrier& b) {
    asm volatile("s_waitcnt vmcnt(0)" ::: "memory");
    __syncthreads();
    if (threadIdx.x == 0) {
        unsigned* bar = b.bar;
        __builtin_amdgcn_s_waitcnt(0);
        unsigned nloc = b.st[0], nx = b.st[1];
        if (nloc == 0u) { xcd_barrier_complete(bar, b.x, nloc, nx); b.st[0] = nloc; b.st[1] = nx; }
        const unsigned old = xb_add(&bar[XB_XSUB(b.x)], 1u);
        const unsigned gen = old / nloc;
        if (old + 1u == (gen + 1u) * nloc) {
            __builtin_amdgcn_fence(__ATOMIC_RELEASE, "agent");
            asm volatile("s_waitcnt vmcnt(0)" ::: "memory");
            const unsigned og = xb_add(&bar[XB_TOP], 1u);
            const unsigned tg = og / nx;
            if (og + 1u == (tg + 1u) * nx) xb_add(&bar[XB_TOPGEN], 1u);
            else XB_SPIN(xb_ld(&bar[XB_TOPGEN]) == tg, bar);
            __builtin_amdgcn_fence(__ATOMIC_ACQUIRE, "agent");
            xb_add(&bar[XB_XGEN(b.x)], 1u);
            asm volatile("s_waitcnt vmcnt(0)" ::: "memory");
        } else {
            XB_SPIN(xb_ld(&bar[XB_XGEN(b.x)]) == gen, bar);
            __builtin_amdgcn_fence(__ATOMIC_ACQUIRE, "agent");
            asm volatile("s_waitcnt vmcnt(0)" ::: "memory");
        }
    }
    __syncthreads();
}

typedef __attribute__((address_space(3))) unsigned char lds_u8;

template <class Epi, int ATILED = 0>
__device__ __forceinline__ void big_gemm(char* smem, const bf16_t* A, const bf16_t* Bt, int M, int N, int K, const Epi& E) {
    pg8::Gemm g{A, Bt, M, N, K, nullptr, nullptr}; pg8::StaticOrder S; S.init(M, N, (int)gridDim.x, (int)blockIdx.x);
    pg8::gemm_phase<Epi, pg8::StaticOrder, true, true, false, ATILED>((lds_u8*)smem, g, S, E);
}
template <class Epi, int ATILED = 0>
__device__ __forceinline__ void big_gemm_dual(char* smem, const bf16_t* A, const bf16_t* Bt, const bf16_t* A2, const bf16_t* Bt2, int M, int N, int K, const Epi& E) {
    pg8::Gemm g{A, Bt, M, N, K, A2, Bt2}; pg8::StaticOrder S; S.init(M, N, (int)gridDim.x, (int)blockIdx.x);
    pg8::gemm_phase<Epi, pg8::StaticOrder, true, true, true, ATILED>((lds_u8*)smem, g, S, E);
}

constexpr int LSTR = 72;
__device__ __forceinline__ void compress_phase(const Ptrs& P, char* smem, int vb, int nvb) {
    unsigned char* ws = P.ws;
    const int tid = opaque_tid(), lane = tid & 63, wave = __builtin_amdgcn_readfirstlane(tid >> 6), wm = wave >> 2, wn = wave & 3, fr = lane & 15, q = lane >> 4;
    constexpr int CBUF = (64 + 128) * LSTR;
    bf16_t* H = (bf16_t*)smem + 2 * CBUF;
    constexpr int HS = 136;
    const int sc = tid & 7, sr = tid >> 3;
    for (int t = vb; t < 128; t += nvb) {
        const int isv = t >> 6, m0 = (t & 63) * 64;
        const bf16_t* Ag = (const bf16_t*)(ws + (isv ? O_VCIN : O_KCIN)) + (size_t)m0 * 1024 + sc * 8;
        const bf16_t* Bg = (const bf16_t*)(ws + (isv ? O_WT_CV1 : O_WT_CK1)) + sc * 8;
        f32x4 b1r[2];
#pragma unroll
        for (int j = 0; j < 2; ++j) b1r[j] = *(const f32x4*)((const float*)(ws + (isv ? O_B1V : O_B1K)) + wn * 32 + 16 * j + 4 * q);
        bf16x8 w2r[4][4]; f32x4 gkr[4];
        {
            const bf16_t* W2t = (const bf16_t*)(ws + (isv ? O_WT_CV2 : O_WT_CK2));
#pragma unroll
            for (int ks = 0; ks < 4; ++ks)
#pragma unroll
                for (int j = 0; j < 4; ++j) w2r[ks][j] = *(const bf16x8*)(W2t + (size_t)(16 * j + fr) * 128 + ks * 32 + 8 * q);
        }
        f32x4 acc[2][2];
#pragma unroll
        for (int i = 0; i < 2; ++i)
#pragma unroll
            for (int j = 0; j < 2; ++j) acc[i][j] = (f32x4){0.f, 0.f, 0.f, 0.f};
        u32x4 ra[8], rb0[8], rb1[8];
#define C_LOAD(set, kt_) do { ra[set] = *(const u32x4*)(Ag + (size_t)sr * 1024 + (kt_) * 64); rb0[set] = *(const u32x4*)(Bg + (size_t)sr * 2048 + (kt_) * 64); \
                              rb1[set] = *(const u32x4*)(Bg + (size_t)(sr + 64) * 2048 + (kt_) * 64); } while (0)
#define C_STORE(set, buf_) do { bf16_t* An_ = (bf16_t*)smem + (buf_) * CBUF; bf16_t* Bn_ = An_ + 64 * LSTR; \
                                *(u32x4*)(An_ + sr * LSTR + sc * 8) = ra[set]; *(u32x4*)(Bn_ + sr * LSTR + sc * 8) = rb0[set]; *(u32x4*)(Bn_ + (sr + 64) * LSTR + sc * 8) = rb1[set]; } while (0)
        C_LOAD(0, 0); C_LOAD(1, 1); C_LOAD(2, 2); C_LOAD(3, 3); C_LOAD(4, 4); C_LOAD(5, 5); C_LOAD(6, 6); C_LOAD(7, 7);
        C_STORE(0, 0);
        C_LOAD(0, 8);
        __syncthreads();
#pragma unroll 1
        for (int kt8 = 0; kt8 < 32; kt8 += 8) {
#pragma unroll
            for (int u = 0; u < 8; ++u) {
                const int kt = kt8 + u;
                const bf16_t* As = (const bf16_t*)smem + (u & 1) * CBUF; const bf16_t* Bs = As + 64 * LSTR;
#pragma unroll
                for (int ks = 0; ks < 2; ++ks) {
                    bf16x8 a[2], b[2];
#pragma unroll
                    for (int i = 0; i < 2; ++i) a[i] = *(const bf16x8*)(As + (wm * 32 + 16 * i + fr) * LSTR + ks * 32 + 8 * q);
#pragma unroll
                    for (int j = 0; j < 2; ++j) b[j] = *(const bf16x8*)(Bs + (wn * 32 + 16 * j + fr) * LSTR + ks * 32 + 8 * q);
#pragma unroll
                    for (int i = 0; i < 2; ++i)
#pragma unroll
                        for (int j = 0; j < 2; ++j) acc[i][j] = __builtin_amdgcn_mfma_f32_16x16x32_bf16(b[j], a[i], acc[i][j], 0, 0, 0);
                }
                C_STORE((u + 1) & 7, (u + 1) & 1);
                C_LOAD((u + 1) & 7, (kt + 9 < 32) ? kt + 9 : 31);
                __syncthreads();
            }
        }
#undef C_LOAD
#undef C_STORE
#pragma unroll
        for (int j = 0; j < 4; ++j) gkr[j] = *(const f32x4*)(P.in[20] + 16 * j + 4 * q);
#pragma unroll
        for (int i = 0; i < 2; ++i)
#pragma unroll
            for (int j = 0; j < 2; ++j) { const f32x4 v = acc[i][j]; const int n = wn * 32 + 16 * j + 4 * q; const f32x4 bb = b1r[j];
                *(u32x2*)(H + (wm * 32 + 16 * i + fr) * HS + n) = (u32x2){pk2(gelu_tanh(v[0] + bb[0]), gelu_tanh(v[1] + bb[1])), pk2(gelu_tanh(v[2] + bb[2]), gelu_tanh(v[3] + bb[3]))}; }
        __syncthreads();
        if (wave < 4) {
            f32x4 o2[4];
#pragma unroll
            for (int j = 0; j < 4; ++j) o2[j] = (f32x4){0.f, 0.f, 0.f, 0.f};
#pragma unroll
            for (int ks = 0; ks < 4; ++ks) {
                const bf16x8 a = *(const bf16x8*)(H + (wave * 16 + fr) * HS + ks * 32 + 8 * q);
#pragma unroll
                for (int j = 0; j < 4; ++j) o2[j] = __builtin_amdgcn_mfma_f32_16x16x32_bf16(w2r[ks][j], a, o2[j], 0, 0, 0);
            }
            const int R = m0 + wave * 16 + fr;
            if (!isv) {
                float s = 0.f;
#pragma unroll
                for (int j = 0; j < 4; ++j) s += (o2[j][0] * o2[j][0] + o2[j][1] * o2[j][1]) + (o2[j][2] * o2[j][2] + o2[j][3] * o2[j][3]);
                s += __shfl_xor(s, 16); s += __shfl_xor(s, 32);
                const float rstd = rsqrtf(s * (1.0f / 64) + EPS);
                bf16_t* dst = (bf16_t*)(ws + O_KC);
#pragma unroll
                for (int j = 0; j < 4; ++j) *(u32x2*)(dst + (size_t)R * 64 + 16 * j + 4 * q) = pk4(o2[j] * gkr[j] * rstd);
            } else {
                bf16_t* dT0 = (bf16_t*)(ws + O_VCT) + (size_t)(R >> 9) * 64 * 512 + (R & 511);
#pragma unroll
                for (int j = 0; j < 4; ++j) { const u32x2 o = pk4(o2[j]); bf16_t* dT = dT0 + (size_t)(16 * j + 4 * q) * 512;
                    dT[0] = (bf16_t)(o[0] & 0xffff); dT[512] = (bf16_t)(o[0] >> 16); dT[1024] = (bf16_t)(o[1] & 0xffff); dT[1536] = (bf16_t)(o[1] >> 16); }
            }
        }
        __syncthreads();
    }
}

constexpr int S5_BU_STR = 132, S5_XB_STR = 136;
constexpr int S5_WAVE_LDS = 16 * S5_BU_STR * 4 + 16 * S5_XB_STR * 2;
template <bool ENDS_ONLY>
__device__ __forceinline__ void s5_phase(const Ptrs& P, char* smem, int vb, int nvb) {
    unsigned char* ws = P.ws;
    const int tid_ = opaque_tid(); const int lane = tid_ & 63, wave = __builtin_amdgcn_readfirstlane(tid_ >> 6), fr = lane & 15, q = lane >> 4;
    float* BU = (float*)(smem + wave * S5_WAVE_LDS);
    bf16_t* XB = (bf16_t*)(smem + wave * S5_WAVE_LDS + 16 * S5_BU_STR * 4);
    const bf16_t* U = (const bf16_t*)(ws + O_U);
    const float* ABAR = (const float*)(ws + O_ABAR); const float* AL = (const float*)(ws + O_AL);
    float* ENDS = (float*)(ws + O_ENDS);
    const int gw = vb * NWAVES + wave, ngw = nvb * NWAVES;
    for (int it = gw; it < NB * NSEG * 32; it += ngw) {
        const int g = it & 31, c = (it >> 5) & (NSEG - 1), b = it >> 9;
        if (ENDS_ONLY && c == NSEG - 1) continue;
        const float ar = ABAR[(g * 64 + lane) * 2], ai = ABAR[(g * 64 + lane) * 2 + 1];
        bf16x8 bb[8];
#pragma unroll
        for (int nt = 0; nt < 8; ++nt) {
            bb[nt] = (bf16x8){0, 0, 0, 0, 0, 0, 0, 0};
            if (q < 2) bb[nt] = *(const bf16x8*)((const bf16_t*)(ws + O_BBT) + ((size_t)g * 128 + 16 * nt + fr) * 16 + 8 * q);
        }
        bf16x8 ct[4];
        if (!ENDS_ONLY) {
#pragma unroll
            for (int ks = 0; ks < 4; ++ks) ct[ks] = *(const bf16x8*)((const bf16_t*)(ws + O_CT) + ((size_t)g * 16 + fr) * 128 + ks * 32 + 8 * q);
        }
        f32x4 dd = (f32x4){0.f, 0.f, 0.f, 0.f};
        if (!ENDS_ONLY) dd = *(const f32x4*)(P.in[10] + g * 16 + 4 * q);
        float xr = 0.f, xi = 0.f;
        if (!ENDS_ONLY) {
            const float alr = AL[(g * 64 + lane) * 2], ali = AL[(g * 64 + lane) * 2 + 1];
            f32x2_t e[NSEG - 1];
#pragma unroll
            for (int cp = 0; cp < NSEG - 1; ++cp) { e[cp] = (f32x2_t){0.f, 0.f}; if (cp < c) e[cp] = *(const f32x2_t*)(ENDS + (((size_t)(b * NSEG + cp) * 32 + g) * 64 + lane) * 2); }
#pragma unroll
            for (int cp = 0; cp < NSEG - 1; ++cp) if (cp < c) { const float nr = alr * xr - ali * xi + e[cp][0], ni = alr * xi + ali * xr + e[cp][1]; xr = nr; xi = ni; }
        }
        const size_t tok0 = (size_t)b * SEQ + (size_t)c * SEGT;
        bf16x8 ufr[2][4]; u32x2 uur[2][4];
#pragma unroll
        for (int j = 0; j < 4; ++j) {
            ufr[0][j] = (bf16x8){0, 0, 0, 0, 0, 0, 0, 0}; uur[0][j] = (u32x2){0u, 0u};
            if (q < 2) ufr[0][j] = *(const bf16x8*)(U + (tok0 + 16 * j + fr) * 512 + g * 16 + 8 * q);
            if (!ENDS_ONLY) uur[0][j] = *(const u32x2*)(U + (tok0 + 16 * j + fr) * 512 + g * 16 + 4 * q);
        }
#pragma unroll 2
        for (int grp = 0; grp < SEGT / 64; ++grp) {
            const int cur = grp & 1;
            if (grp + 1 < SEGT / 64) {
#pragma unroll
                for (int j = 0; j < 4; ++j) {
                    ufr[cur ^ 1][j] = (bf16x8){0, 0, 0, 0, 0, 0, 0, 0}; uur[cur ^ 1][j] = (u32x2){0u, 0u};
                    if (q < 2) ufr[cur ^ 1][j] = *(const bf16x8*)(U + (tok0 + 64 * (grp + 1) + 16 * j + fr) * 512 + g * 16 + 8 * q);
                    if (!ENDS_ONLY) uur[cur ^ 1][j] = *(const u32x2*)(U + (tok0 + 64 * (grp + 1) + 16 * j + fr) * 512 + g * 16 + 4 * q);
                }
            }
#pragma unroll
            for (int j = 0; j < 4; ++j) {
            const size_t tk = tok0 + 64 * grp + 16 * j;
            const bf16x8 uf = ufr[cur][j]; const u32x2 uu = uur[cur][j];
#pragma unroll
            for (int nt = 0; nt < 8; ++nt) {
                f32x4 d = __builtin_amdgcn_mfma_f32_16x16x32_bf16(bb[nt], uf, (f32x4){0.f, 0.f, 0.f, 0.f}, 0, 0, 0);
                *(f32x4*)(BU + fr * S5_BU_STR + 16 * nt + 4 * q) = d;
            }
            asm volatile("s_waitcnt lgkmcnt(0)" ::: "memory");
            f32x2_t bq[16];
#pragma unroll
            for (int s = 0; s < 16; ++s) bq[s] = *(const f32x2_t*)(BU + s * S5_BU_STR + 2 * lane);
#pragma unroll
            for (int s = 0; s < 16; ++s) {
                float t1 = __builtin_fmaf(-ai, xi, bq[s][0]), t2 = __builtin_fmaf(ai, xr, bq[s][1]);
                asm volatile("" : "+v"(t1), "+v"(t2));
                const float nr = __builtin_fmaf(ar, xr, t1), ni = __builtin_fmaf(ar, xi, t2); xr = nr; xi = ni;
                if (!ENDS_ONLY) *(unsigned*)(XB + s * S5_XB_STR + 2 * lane) = pk2(xr, xi);
            }
            asm volatile("s_waitcnt lgkmcnt(0)" ::: "memory");
            if (!ENDS_ONLY) {
                f32x4 y = (f32x4){0.f, 0.f, 0.f, 0.f};
#pragma unroll
                for (int ks = 0; ks < 4; ++ks) {
                    const bf16x8 xf = *(const bf16x8*)(XB + fr * S5_XB_STR + ks * 32 + 8 * q);
                    y = __builtin_amdgcn_mfma_f32_16x16x32_bf16(ct[ks], xf, y, 0, 0, 0);
                }
                const float y0 = gelu_tanh(y[0] + dd[0] * bflo(uu[0])), y1 = gelu_tanh(y[1] + dd[1] * bfhi(uu[0]));
                const float y2 = gelu_tanh(y[2] + dd[2] * bflo(uu[1])), y3 = gelu_tanh(y[3] + dd[3] * bfhi(uu[1]));
                *(u32x2*)((bf16_t*)(ws + O_YG) + ((((tk + fr) >> 4) * 16 + (size_t)(g >> 1)) << 9) + (((int)(tk + fr) & 15) << 5) + ((g & 1) * 16 + 4 * q)) = (u32x2){pk2(y0, y1), pk2(y2, y3)};
                asm volatile("s_waitcnt lgkmcnt(0)" ::: "memory");
            }
            }
        }
        if (ENDS_ONLY) *(f32x2_t*)(ENDS + (((size_t)(b * NSEG + c) * 32 + g) * 64 + lane) * 2) = (f32x2_t){xr, xi};
    }
}

constexpr int S5E_LDS = 65536 + NWAVES * 16 * S5_BU_STR * 4;
__device__ __forceinline__ void s5_ends_phase(const Ptrs& P, char* smem, int vb, int nvb) {
    unsigned char* ws = P.ws;
    const int tid_ = opaque_tid(); const int lane = tid_ & 63, wave = __builtin_amdgcn_readfirstlane(tid_ >> 6), fr = lane & 15, q = lane >> 4;
    bf16_t* EL = (bf16_t*)smem;
    float* BU = (float*)(smem + 65536 + wave * 16 * S5_BU_STR * 4);
    const bf16_t* U = (const bf16_t*)(ws + O_U);
    float* ENDS = (float*)(ws + O_ENDS);
    constexpr int NPAIR = NB * (NSEG - 1), NR = (NPAIR + NWAVES - 1) / NWAVES;
    for (int it = vb; it < 32 * NR; it += nvb) {
        const int xcd_ = it & 7, jj_ = it >> 3, cq_ = xcd_ + 8 * (jj_ >> 2);
        const int g = 4 * (cq_ & 7) + (jj_ & 3), r = cq_ >> 3, pi = r * NWAVES + wave;
        const bool act = pi < NPAIR;
        const int b = act ? pi / (NSEG - 1) : 0, c = act ? pi % (NSEG - 1) : 0;
        const size_t tok0 = (size_t)b * SEQ + (size_t)c * SEGT;
        bf16x8 uf[2][8];
#pragma unroll
        for (int half = 0; half < 2; ++half)
#pragma unroll
            for (int ks = 0; ks < 8; ++ks) uf[half][ks] = *(const bf16x8*)(U + (tok0 + 256 * half + 16 * fr + 2 * ks + (q >> 1)) * 512 + g * 16 + 8 * (q & 1));
        const float a16r = ((const float*)(ws + O_A16))[(g * 64 + lane) * 2], a16i = ((const float*)(ws + O_A16))[(g * 64 + lane) * 2 + 1];
        __syncthreads();
        { const bf16_t* E16 = (const bf16_t*)(ws + O_E16) + (size_t)g * 128 * 256; const int ch = tid_ & 31, r0 = tid_ >> 5;
#pragma unroll
          for (int j = 0; j < 8; ++j) { const int row = r0 + 16 * j; const u32x4 v = *(const u32x4*)(E16 + (size_t)row * 256 + ch * 8); *(u32x4*)(EL + row * 256 + ((ch ^ (row & 15)) * 8)) = v; } }
        __syncthreads();
        if (act) {
            float xr = 0.f, xi = 0.f;
#pragma unroll
            for (int half = 0; half < SEGT / 256; ++half) {
#pragma unroll
                for (int nt = 0; nt < 8; ++nt) {
                    f32x4 d = (f32x4){0.f, 0.f, 0.f, 0.f};
#pragma unroll
                    for (int ks = 0; ks < 8; ++ks) { const bf16x8 ef = *(const bf16x8*)(EL + (16 * nt + fr) * 256 + (((4 * ks + q) ^ fr) * 8)); d = __builtin_amdgcn_mfma_f32_16x16x32_bf16(ef, uf[half][ks], d, 0, 0, 0); }
                    *(f32x4*)(BU + fr * S5_BU_STR + 16 * nt + 4 * q) = d;
                }
                asm volatile("s_waitcnt lgkmcnt(0)" ::: "memory");
#pragma unroll 8
                for (int j = 0; j < 16; ++j) {
                    const f32x2_t e = *(const f32x2_t*)(BU + j * S5_BU_STR + 2 * lane);
                    const float nr = a16r * xr - a16i * xi + e[0], ni = a16r * xi + a16i * xr + e[1]; xr = nr; xi = ni;
                }
                asm volatile("s_waitcnt lgkmcnt(0)" ::: "memory");
            }
            *(f32x2_t*)(ENDS + (((size_t)(b * NSEG + c) * 32 + g) * 64 + lane) * 2) = (f32x2_t){xr, xi};
        }
    }
    __syncthreads();
}

constexpr int RT = 2;
constexpr int TQ = 4 * RT * NWAVES;
constexpr int KSTR = 64;
constexpr int KV_TILE = 64 * KSTR * 2;
constexpr int IMP_STR = 132;
struct AttL { static constexpr int K0 = 0, V0 = 2 * KV_TILE, IMP = 4 * KV_TILE, SELM = IMP + NWAVES * 4 * RT * IMP_STR * 4, UNI = SELM + NWAVES * 4 * RT * 16, YP = UNI + 64, TOTAL = YP + NWAVES * RT * 4 * 64 * 8; };
struct AttSrc { const bf16_t* k; const bf16_t* v; int vld; };

__device__ __forceinline__ void att_load(const AttSrc& s, u32x4& kr, u32x4& vr) {
    int tid = threadIdx.x; asm volatile("" : "+v"(tid));
    const int row = tid >> 3, ch = tid & 7;
    kr = *(const u32x4*)(s.k + (size_t)row * 64 + ch * 8);
    vr = *(const u32x4*)(s.v + (size_t)row * s.vld + ch * 8);
}
__device__ __forceinline__ void att_store(char* smem, int buf, const u32x4& kr, const u32x4& vr) {
    int tid = threadIdx.x; asm volatile("" : "+v"(tid));
    const int row = tid >> 3, ch = tid & 7;
    *(u32x4*)((bf16_t*)(smem + AttL::K0 + buf * KV_TILE) + row * KSTR + ((ch ^ (row & 7)) * 8)) = kr;
    { const int g32 = ch >> 2, m = ch & 3, ce = 4 * g32 + 2 * (m & 1), wo = 4 * (m >> 1);
      bf16_t* vrow = (bf16_t*)(smem + AttL::V0 + buf * KV_TILE) + row * KSTR;
      *(u32x2*)(vrow + ((ce ^ (row & 7)) * 8) + wo) = (u32x2){vr[0], vr[1]};
      *(u32x2*)(vrow + (((ce + 1) ^ (row & 7)) * 8) + wo) = (u32x2){vr[2], vr[3]}; }
}

template <int MODE, bool MASKED>
__device__ __forceinline__ void att_block(const bf16_t* Ks, const bf16_t* Vs, const bf16x8 (&qf)[RT][2], f32x4 (&acc)[RT][4], f32x4 (&l)[RT],
                                          const float (&invl)[RT], const float (&g0)[RT], const float (&base0)[RT], const int (&hi0)[RT], int wlo,
                                          float sk, float* imp_w, int blk0, int fr, int q) {
    const float NEGB = -1e30f;
    bf16x8 kf[2][2]; bf16x8 vf[4]; f32x4 S[RT][2];
    int lofs = fr * (KSTR * 2) + ((q ^ (fr & 7)) * 16);
    float skl = sk;
    asm volatile("" : "+v"(lofs), "+v"(skl));
    const char* kb_ = (const char*)Ks + lofs; const char* vb_ = (const char*)Vs + lofs;
    const char* kb1_ = (const char*)Ks + (lofs ^ 64); const char* vb1_ = (const char*)Vs + (lofs ^ 64);
    auto loadk = [&](const int kt) {
#pragma unroll
        for (int ab = 0; ab < 2; ++ab) { kf[ab][0] = *(const bf16x8*)(kb_ + (32 * kt + 16 * ab) * (KSTR * 2)); kf[ab][1] = *(const bf16x8*)(kb1_ + (32 * kt + 16 * ab) * (KSTR * 2)); }
    };
    auto loadv = [&](const int kt) {
#pragma unroll
        for (int dt = 0; dt < 4; ++dt) vf[dt] = *(const bf16x8*)((kt ? vb1_ : vb_) + (16 * dt) * (KSTR * 2));
    };
    auto qk = [&](const int kt) {
        __builtin_amdgcn_s_setprio(1);
#pragma unroll
        for (int rt = 0; rt < RT; ++rt) {
            const float bl = base0[rt] + skl * (float)(32 * kt + 4 * q);
#pragma unroll
            for (int ab = 0; ab < 2; ++ab) {
#pragma unroll
                for (int r = 0; r < 4; ++r) S[rt][ab][r] = bl + skl * (float)(16 * ab + r);
                S[rt][ab] = __builtin_amdgcn_mfma_f32_16x16x32_bf16(kf[ab][0], qf[rt][0], S[rt][ab], 0, 0, 0);
                S[rt][ab] = __builtin_amdgcn_mfma_f32_16x16x32_bf16(kf[ab][1], qf[rt][1], S[rt][ab], 0, 0, 0);
            }
        }
        __builtin_amdgcn_s_setprio(0);
    };
    auto smpv = [&](const int kt) {
#pragma unroll
        for (int rt = 0; rt < RT; ++rt) {
            if (MASKED) {
                const int hi = hi0[rt] - (32 * kt + 4 * q), lo = hi - wlo;
#pragma unroll
                for (int ab = 0; ab < 2; ++ab)
#pragma unroll
                    for (int r = 0; r < 4; ++r) { const int c = 16 * ab + r; if (c > hi || c < lo) S[rt][ab][r] = NEGB; }
            }
#pragma unroll
            for (int ab = 0; ab < 2; ++ab)
#pragma unroll
                for (int r = 0; r < 4; ++r) S[rt][ab][r] = __builtin_amdgcn_exp2f(S[rt][ab][r]);
            if (MODE == 1) {
                const float il = invl[rt];
#pragma unroll
                for (int ab = 0; ab < 2; ++ab) {
                    S[rt][ab] = S[rt][ab] * il;
                    float cs = (S[rt][ab][0] + S[rt][ab][1]) + (S[rt][ab][2] + S[rt][ab][3]), last = S[rt][ab][3];
                    cs += __shfl_xor(cs, 1); cs += __shfl_xor(cs, 2); last += __shfl_xor(last, 1); last += __shfl_xor(last, 2);
                    const int blk = blk0 + 8 * kt + 4 * ab + q;
                    if ((fr & 3) == 0) { float* ip = imp_w + (4 * rt + (fr >> 2)) * IMP_STR + blk; atomicAdd(ip, cs); if (blk + 1 < 128) atomicAdd(ip + 1, last); }
                    S[rt][ab] = S[rt][ab] * g0[rt];
                }
            }
            const u32x4 pu = {pk2(S[rt][0][0], S[rt][0][1]), pk2(S[rt][0][2], S[rt][0][3]), pk2(S[rt][1][0], S[rt][1][1]), pk2(S[rt][1][2], S[rt][1][3])};
            const bf16x8 pf = __builtin_bit_cast(bf16x8, pu);
            __builtin_amdgcn_s_setprio(1);
            if (MODE != 1) { const unsigned one2 = (fr == 0) ? 0x3F803F80u : 0u; const u32x4 ou = {one2, one2, one2, one2};
                l[rt] = __builtin_amdgcn_mfma_f32_16x16x32_bf16(__builtin_bit_cast(bf16x8, ou), pf, l[rt], 0, 0, 0); }
            if (MODE != 0) {
#pragma unroll
                for (int dt = 0; dt < 4; ++dt) acc[rt][dt] = __builtin_amdgcn_mfma_f32_16x16x32_bf16(vf[dt], pf, acc[rt][dt], 0, 0, 0);
            }
            __builtin_amdgcn_s_setprio(0);
        }
    };
    if (MASKED) {
        bool sk[2];
#pragma unroll
        for (int kt = 0; kt < 2; ++kt) {
            bool dead = true;
#pragma unroll
            for (int rt = 0; rt < RT; ++rt) dead = dead && ((hi0[rt] < 32 * kt) || (hi0[rt] - wlo > 32 * kt + 31));
            sk[kt] = __all(dead);
        }
        if (!sk[0]) { loadk(0); if (MODE != 0) loadv(0); qk(0); smpv(0); }
        if (!sk[1]) { loadk(1); if (MODE != 0) loadv(1); qk(1); smpv(1); }
    } else {
        loadk(0);
        if (MODE != 0) loadv(0);
        qk(0);
        __builtin_amdgcn_sched_barrier(0);
        loadk(1);
        smpv(0);
        __builtin_amdgcn_sched_barrier(0);
        if (MODE != 0) loadv(1);
        qk(1);
        __builtin_amdgcn_sched_barrier(0);
        smpv(1);
    }
}
#define ATT_BLOCK(MODE, need_mask, ...) do { if (need_mask) att_block<MODE, true>(__VA_ARGS__); else att_block<MODE, false>(__VA_ARGS__); } while (0)

__device__ __forceinline__ void attn_phase(const Ptrs& P, char* smem, int vb, int nvb, size_t yoff = O_YNSA, int parts = 7) {
    typedef AttL L;
    unsigned char* ws = P.ws;
    const int tid = opaque_tid(), lane = tid & 63, wave = __builtin_amdgcn_readfirstlane(tid >> 6), fr = lane & 15, q = lane >> 4;
    constexpr int NQT = SEQ / TQ, TW = 4 * RT;
    float* imp_w = (float*)(smem + L::IMP) + wave * TW * IMP_STR;
    unsigned* selm_w = (unsigned*)(smem + L::SELM) + wave * TW * 4;
    unsigned* uni = (unsigned*)(smem + L::UNI);
    const float* M2 = (const float*)(ws + O_M2);
    const float LOG2E = 1.4426950408889634f;
    const float* G = (const float*)(ws + O_GATES);
    for (int it = vb; it < NB * 2 * NQT; it += nvb) {
        int qt, bg;
        if ((nvb % (NB * 2)) == 0 && (NQT % (nvb / (NB * 2))) == 0) {
            const int rnd = it / nvb, jj = it - rnd * nvb, per = nvb / (NB * 2), i_ = jj / (NB * 2);
            const int nr = NQT / per, lo_ = (nr - 1 - rnd) * per;
            bg = (jj + rnd) % (NB * 2); qt = (rnd & 1) ? (lo_ + i_) : (lo_ + per - 1 - i_);
        } else { qt = NQT - 1 - (it / (NB * 2)); bg = it % (NB * 2); }
        const int b = bg >> 1, g = bg & 1;
        const int qs = qt * TQ, t0 = qs + TW * wave;
        const int head = fr & 3, h = g * 4 + head;
        const float slope2 = exp2f(-(float)(h + 1)) * LOG2E;
        const int dz = (int)(160.0f / (exp2f(-(float)(g * 4 + 4)) * LOG2E)) + 1;
        const bf16_t* QN = (const bf16_t*)(ws + O_QN);
        bf16x8 qf[RT][2]; int tpos[RT];
#pragma unroll
        for (int rt = 0; rt < RT; ++rt) {
            tpos[rt] = t0 + 4 * rt + (fr >> 2);
            const size_t tok = (size_t)b * SEQ + tpos[rt];
#pragma unroll
            for (int ks = 0; ks < 2; ++ks) qf[rt][ks] = *(const bf16x8*)(QN + tok * 512 + h * 64 + 32 * ks + 8 * q);
        }
        for (int i = lane; i < TW * IMP_STR; i += 64) imp_w[i] = 0.f;
        { int tz = tid; asm volatile("" : "+v"(tz)); if (tz < 4) uni[tz] = 0u; }
        u32x2* yp_w = (u32x2*)(smem + L::YP) + wave * RT * 4 * 64 + lane;
#pragma unroll
        for (int rt = 0; rt < RT; ++rt)
#pragma unroll
            for (int dt = 0; dt < 4; ++dt) yp_w[(rt * 4 + dt) * 64] = (u32x2){0u, 0u};
        f32x4 O[RT][4];
#pragma unroll
        for (int rt = 0; rt < RT; ++rt)
#pragma unroll
            for (int dt = 0; dt < 4; ++dt) O[rt][dt] = (f32x4){0.f, 0.f, 0.f, 0.f};
        f32x4 l[RT]; float invl[RT], g0[RT], base0[RT]; int hi0[RT];
        float gs_[RT], gw_[RT];
#pragma unroll
        for (int rt = 0; rt < RT; ++rt) { l[rt] = (f32x4){0.f, 0.f, 0.f, 0.f}; invl[rt] = 0.f; const float* gp = G + ((size_t)b * SEQ + tpos[rt]) * 24 + h; g0[rt] = gp[0]; gs_[rt] = gp[8]; gw_[rt] = gp[16]; }
        u32x4 kr, vr;
        __syncthreads();
        if (parts & 1) {
            const int jm_tile = (qs + TQ - 1 - 31) >> 4;
            const int nkb = (jm_tile >> 6) + 1;
            int kb0c = 0; { const int jc = (qs - 31 - dz) >> 4; if (jc > 0) kb0c = jc >> 6; }
            const int jm_lo = (t0 - 31) >> 4, jm_hi = (t0 + TW - 1 - 31) >> 4;
            const float m2 = M2[0];
            const bf16_t* KC = (const bf16_t*)(ws + O_KC) + (size_t)bg * 512 * 64;
            const bf16_t* VCT = (const bf16_t*)(ws + O_VCT) + (size_t)bg * 64 * 512;
            int jmax[RT];
#pragma unroll
            for (int rt = 0; rt < RT; ++rt) jmax[rt] = (tpos[rt] - 31) >> 4;
#define CMP_STEP(MODEV, MASKV) do { \
                    if (kb + 1 < nkb) { AttSrc s1{KC + (size_t)(kb + 1) * 64 * 64, VCT + (kb + 1) * 64, 512}; att_load(s1, kr, vr); } \
                    if (64 * kb <= jm_hi) { \
                        _Pragma("unroll") for (int rt = 0; rt < RT; ++rt) { base0[rt] = -m2 - slope2 * (float)(tpos[rt] - 31 - 1024 * kb); hi0[rt] = jmax[rt] - 64 * kb; } \
                        const bf16_t* Ks = (const bf16_t*)(smem + L::K0 + (kb & 1) * KV_TILE); const bf16_t* Vs = (const bf16_t*)(smem + L::V0 + (kb & 1) * KV_TILE); \
                        att_block<MODEV, MASKV>(Ks, Vs, qf, O, l, invl, g0, base0, hi0, 1 << 28, slope2 * 16.f, imp_w, 16 * kb, fr, q); \
                    } \
                    if (kb + 1 < nkb) att_store(smem, (kb + 1) & 1, kr, vr); \
                    __syncthreads(); } while (0)
#define CMP_PASS(MODEV) do { \
                { AttSrc s0{KC + (size_t)kb0c * 64 * 64, VCT + kb0c * 64, 512}; att_load(s0, kr, vr); att_store(smem, kb0c & 1, kr, vr); } \
                __syncthreads(); \
                int kb = kb0c; \
                _Pragma("unroll 1") for (; kb < nkb - 2; ++kb) CMP_STEP(MODEV, false); \
                _Pragma("unroll 1") for (; kb < nkb; ++kb) CMP_STEP(MODEV, true); } while (0)
            CMP_PASS(0);
#pragma unroll
            for (int rt = 0; rt < RT; ++rt) { float s = l[rt][0]; s += __shfl_xor(s, 16); s += __shfl_xor(s, 32); invl[rt] = s > 0.f ? 1.0f / s : 0.f; l[rt] = (f32x4){0.f, 0.f, 0.f, 0.f}; }
            CMP_PASS(1);
#undef CMP_PASS
#undef CMP_STEP
#pragma unroll
            for (int rt = 0; rt < RT; ++rt)
#pragma unroll
                for (int dt = 0; dt < 4; ++dt) { yp_w[(rt * 4 + dt) * 64] = pk4(O[rt][dt]); O[rt][dt] = (f32x4){0.f, 0.f, 0.f, 0.f}; }
        }
        if (parts & 2) {
            asm volatile("s_waitcnt lgkmcnt(0)" ::: "memory");
            const int tl = lane >> 3, part = lane & 7, t = t0 + tl, cur = t >> 6;
            const float* my = imp_w + tl * IMP_STR + 16 * part;
            unsigned key[16];
#pragma unroll
            for (int i4 = 0; i4 < 4; ++i4) { const f32x4 v = *(const f32x4*)(my + 4 * i4);
#pragma unroll
                for (int c = 0; c < 4; ++c) { const int blk = 16 * part + 4 * i4 + c;
                    const bool valid = blk <= cur, forced = (blk == 0) || (blk == cur) || (blk == cur - 1);
                    const float vv = v[c] + (forced ? 1e4f : 0.f);
                    key[4 * i4 + c] = ((valid ? (__float_as_uint(vv) & ~127u) : 0u) | (unsigned)(127 - blk)) + 1u; } }
#pragma unroll 1
            for (int r = 0; r < 16; ++r) {
                unsigned m = key[0];
#pragma unroll
                for (int i = 1; i < 16; ++i) m = max(m, key[i]);
                m = max(m, (unsigned)__builtin_amdgcn_update_dpp(0, (int)m, 0xB1, 0xF, 0xF, true));
                m = max(m, (unsigned)__builtin_amdgcn_update_dpp(0, (int)m, 0x4E, 0xF, 0xF, true));
                m = max(m, (unsigned)__builtin_amdgcn_update_dpp(0, (int)m, 0x141, 0xF, 0xF, true));
#pragma unroll
                for (int i = 0; i < 16; ++i) key[i] = (key[i] == m) ? 0u : key[i];
            }
            unsigned bits = 0u;
#pragma unroll
            for (int i = 0; i < 16; ++i) bits |= (key[i] == 0u) ? (1u << i) : 0u;
            bits <<= 16 * (part & 1);
            unsigned m0 = ((part >> 1) == 0) ? bits : 0u, m1 = ((part >> 1) == 1) ? bits : 0u, m2_ = ((part >> 1) == 2) ? bits : 0u, m3 = ((part >> 1) == 3) ? bits : 0u;
#define OR8(x) do { x |= (unsigned)__builtin_amdgcn_update_dpp(0, (int)x, 0xB1, 0xF, 0xF, true); x |= (unsigned)__builtin_amdgcn_update_dpp(0, (int)x, 0x4E, 0xF, 0xF, true); \
                    x |= (unsigned)__builtin_amdgcn_update_dpp(0, (int)x, 0x141, 0xF, 0xF, true); } while (0)
            OR8(m0); OR8(m1); OR8(m2_); OR8(m3);
#undef OR8
            if (part == 0) { selm_w[tl * 4 + 0] = m0; selm_w[tl * 4 + 1] = m1; selm_w[tl * 4 + 2] = m2_; selm_w[tl * 4 + 3] = m3; }
#pragma unroll
            for (int o = 8; o < 64; o <<= 1) { m0 |= __shfl_xor(m0, o); m1 |= __shfl_xor(m1, o); m2_ |= __shfl_xor(m2_, o); m3 |= __shfl_xor(m3, o); }
            if (lane == 0) { atomicOr(uni + 0, m0); atomicOr(uni + 1, m1); atomicOr(uni + 2, m2_); atomicOr(uni + 3, m3); }
            __syncthreads();
            const unsigned wu0 = __builtin_amdgcn_readfirstlane(m0), wu1 = __builtin_amdgcn_readfirstlane(m1), wu2 = __builtin_amdgcn_readfirstlane(m2_), wu3 = __builtin_amdgcn_readfirstlane(m3);
            unsigned bu0 = __builtin_amdgcn_readfirstlane(uni[0]), bu1 = __builtin_amdgcn_readfirstlane(uni[1]), bu2 = __builtin_amdgcn_readfirstlane(uni[2]), bu3 = __builtin_amdgcn_readfirstlane(uni[3]);
            { const int bc = (qs - dz - 63) >> 6;
              if (bc > 0) { const unsigned long long lo64 = (bc >= 64) ? ~0ull : ((1ull << bc) - 1ull), hi64 = (bc <= 64) ? 0ull : ((bc >= 128) ? ~0ull : ((1ull << (bc - 64)) - 1ull));
                  bu0 &= ~(unsigned)lo64; bu1 &= ~(unsigned)(lo64 >> 32); bu2 &= ~(unsigned)hi64; bu3 &= ~(unsigned)(hi64 >> 32); } }
            const float m2s = M2[1];
            const bf16_t* KS = (const bf16_t*)(ws + O_KS) + (size_t)bg * SEQ * 64;
            const bf16_t* VST = (const bf16_t*)(ws + O_VST) + (size_t)bg * 64 * SEQ;
            { const unsigned long long klo = (qt >= 63) ? ~0ull : ((1ull << (qt + 1)) - 1ull), khi = (qt < 64) ? 0ull : ((qt >= 127) ? ~0ull : ((1ull << (qt - 63)) - 1ull));
              bu0 &= (unsigned)klo; bu1 &= (unsigned)(klo >> 32); bu2 &= (unsigned)khi; bu3 &= (unsigned)(khi >> 32); }
            const int nsel = __popc(bu0) + __popc(bu1) + __popc(bu2) + __popc(bu3);
            int cw = 0; unsigned cbits = bu0;
#define NEXT_BLK(dst) do { while (cbits == 0u) { ++cw; cbits = (cw == 1) ? bu1 : (cw == 2) ? bu2 : bu3; } const int bpos_ = __ffs(cbits) - 1; cbits &= cbits - 1u; dst = cw * 32 + bpos_; } while (0)
#define SEL_STEP(MASKV) do { \
                    if (i + 1 < nsel) { NEXT_BLK(blk_nxt); AttSrc s1{KS + (size_t)blk_nxt * 64 * 64, VST + blk_nxt * 64, SEQ}; att_load(s1, kr, vr); } \
                    const int blk = blk_cur, kb0 = 64 * blk; \
                    const unsigned wword = (blk < 32) ? wu0 : (blk < 64) ? wu1 : (blk < 96) ? wu2 : wu3; \
                    if (((wword >> (blk & 31)) & 1u) && kb0 <= t0 + TW - 1) { \
                        _Pragma("unroll") for (int rt = 0; rt < RT; ++rt) { \
                            const unsigned w_ = selm_w[(4 * rt + (fr >> 2)) * 4 + (blk >> 5)]; \
                            const bool sel = (w_ >> (blk & 31)) & 1u; \
                            base0[rt] = sel ? (-m2s - slope2 * (float)(tpos[rt] - kb0)) : -1e30f;     \
                            hi0[rt] = tpos[rt] - kb0; \
                        } \
                        const bf16_t* Ks = (const bf16_t*)(smem + L::K0 + (i & 1) * KV_TILE); const bf16_t* Vs = (const bf16_t*)(smem + L::V0 + (i & 1) * KV_TILE); \
                        att_block<2, MASKV>(Ks, Vs, qf, O, l, invl, g0, base0, hi0, 1 << 28, slope2, imp_w, 0, fr, q); \
                    } \
                    if (i + 1 < nsel) att_store(smem, (i + 1) & 1, kr, vr); \
                    blk_cur = blk_nxt; \
                    __syncthreads(); } while (0)
            int blk_cur = 0, blk_nxt = 0;
            if (nsel > 0) {
                NEXT_BLK(blk_cur);
                { AttSrc s0{KS + (size_t)blk_cur * 64 * 64, VST + blk_cur * 64, SEQ}; att_load(s0, kr, vr); att_store(smem, 0, kr, vr); }
                __syncthreads();
                int i = 0;
#pragma unroll 1
                for (; i < nsel - 1; ++i) SEL_STEP(false);
                SEL_STEP(true);
            }
#undef SEL_STEP
#undef NEXT_BLK
#pragma unroll
            for (int rt = 0; rt < RT; ++rt) {
                float s = l[rt][0]; s += __shfl_xor(s, 16); s += __shfl_xor(s, 32);
                const float cf = (s > 0.f) ? gs_[rt] / s : 0.f; l[rt] = (f32x4){0.f, 0.f, 0.f, 0.f};
#pragma unroll
                for (int dt = 0; dt < 4; ++dt) { const u32x2 yp = yp_w[(rt * 4 + dt) * 64]; const f32x4 yv = {bflo(yp[0]), bfhi(yp[0]), bflo(yp[1]), bfhi(yp[1])};
                    yp_w[(rt * 4 + dt) * 64] = pk4(yv + O[rt][dt] * cf); O[rt][dt] = (f32x4){0.f, 0.f, 0.f, 0.f}; }
            }
        }
        if (parts & 4) {
            const float m2w = M2[2];
            const bf16_t* KW = (const bf16_t*)(ws + O_KW) + (size_t)bg * SEQ * 64;
            const bf16_t* VWT = (const bf16_t*)(ws + O_VWT) + (size_t)bg * 64 * SEQ;
            const int wlast = (qs + TQ - 1) >> 6; int wfirst = (qs - 511) >> 6; if (wfirst < 0) wfirst = 0;
            const int nwb = wlast - wfirst + 1;
            { AttSrc s0{KW + (size_t)wfirst * 64 * 64, VWT + wfirst * 64, SEQ}; att_load(s0, kr, vr); att_store(smem, 0, kr, vr); }
            __syncthreads();
#define WIN_STEP(MASKV) do { \
                const int wb = wfirst + i, kb0 = 64 * wb; \
                if (i + 1 < nwb) { AttSrc s1{KW + (size_t)(wb + 1) * 64 * 64, VWT + (wb + 1) * 64, SEQ}; att_load(s1, kr, vr); } \
                if (kb0 <= t0 + TW - 1 && kb0 + 63 >= t0 - 511) { \
                    _Pragma("unroll") for (int rt = 0; rt < RT; ++rt) { base0[rt] = -m2w - slope2 * (float)(tpos[rt] - kb0); hi0[rt] = tpos[rt] - kb0; } \
                    const bf16_t* Ks = (const bf16_t*)(smem + L::K0 + (i & 1) * KV_TILE); const bf16_t* Vs = (const bf16_t*)(smem + L::V0 + (i & 1) * KV_TILE); \
                    att_block<2, MASKV>(Ks, Vs, qf, O, l, invl, g0, base0, hi0, 511, slope2, imp_w, 0, fr, q); \
                } \
                if (i + 1 < nwb) att_store(smem, (i + 1) & 1, kr, vr); \
                __syncthreads(); } while (0)
            int i = 0;
            WIN_STEP(true);
            i = 1;
#pragma unroll 1
            for (; i < nwb - 1; ++i) WIN_STEP(false);
            if (i < nwb) WIN_STEP(true);
#undef WIN_STEP
        }
        bf16_t* YN = (bf16_t*)(ws + yoff);
        int hq = h * 64 + 4 * q; asm volatile("" : "+v"(hq));
#pragma unroll
        for (int rt = 0; rt < RT; ++rt) {
            float s = l[rt][0]; s += __shfl_xor(s, 16); s += __shfl_xor(s, 32);
            const size_t tok = (size_t)b * SEQ + tpos[rt];
            const float cf = (s > 0.f) ? gw_[rt] / s : 0.f;
#pragma unroll
            for (int dt = 0; dt < 4; ++dt) { const u32x2 yp = yp_w[(rt * 4 + dt) * 64]; const f32x4 yv = {bflo(yp[0]), bfhi(yp[0]), bflo(yp[1]), bfhi(yp[1])};
                *(u32x2*)(YN + ((((tok >> 4) * 16) + (size_t)((hq + 16 * dt) >> 5)) << 9) + (((int)tok & 15) << 5) + ((hq + 16 * dt) & 31)) = pk4(yv + O[rt][dt] * cf); }
        }
        __syncthreads();
    }
}

constexpr int SMEM_MAIN = 136 * 1024, SMEM_BYTES = SMEM_MAIN + 64;
static_assert(AttL::TOTAL <= SMEM_MAIN && NWAVES * S5_WAVE_LDS <= SMEM_MAIN && pg8::STAGE_BYTES <= SMEM_MAIN && S5E_LDS <= SMEM_MAIN, "LDS budget");

__global__ void __launch_bounds__(NTHR) k_mega(Ptrs P, TrTable tt, TrTable tt2) {
    extern __shared__ __attribute__((aligned(16))) char smem[];
    const int vb = blockIdx.x, nvb = gridDim.x;
    unsigned long long ts_a = 0ull, ts_b = 0ull; int ts_n = 0;
#define STAMP() do { if (PROBE_STAMP >= 0) { const unsigned long long t_ = __builtin_amdgcn_s_memrealtime(); if (ts_n == PROBE_STAMP) ts_a = t_; if (ts_n == PROBE_STAMP + 1) ts_b = t_; ++ts_n; } } while (0)
    unsigned char* ws = P.ws;
    volatile __attribute__((address_space(3))) unsigned* bst = (volatile __attribute__((address_space(3))) unsigned*)((__attribute__((address_space(3))) char*)smem + SMEM_MAIN);
    if (threadIdx.x < 2) bst[threadIdx.x] = 0u;
    __syncthreads();
    const XcdBarrier xbar = xcd_barrier_post((unsigned*)(ws + O_BAR), bst);
    STAMP();
    transpose_phase<5>(tt, smem, vb, nvb);
    if (PROBE_REP & 64) transpose_phase(tt, smem, vb, nvb);
    consts_phase(P, vb, nvb);
    rmsnorm1_phase(P, vb, nvb);
    if (PROBE_REP & 64) rmsnorm1_phase(P, vb, nvb);
#define GRID_BAR() do { xcd_barrier(xbar); STAMP(); } while (0)
    GRID_BAR();
    { pg8::EpiIn E{ws, P.in[19], P.in[20]}; big_gemm<pg8::EpiIn, 3>(smem, (const bf16_t*)(ws + O_XN), (const bf16_t*)(ws + O_WT_IN), NTOK, NIN, DM, E); }
    GRID_BAR();
    compress_phase(P, smem, vb, nvb);
    if (PROBE_REP & 128) { __syncthreads(); compress_phase(P, smem, vb, nvb); }
    s5_ends_phase(P, smem, nvb - 1 - vb, nvb);
    if (PROBE_REP & 256) s5_ends_phase(P, smem, nvb - 1 - vb, nvb);
    __syncthreads();
    if (nvb >= 256) { if (vb >= 128) transpose_phase<6>(tt2, smem, vb - 128, nvb - 128); }
    else transpose_phase(tt2, smem, vb, nvb);
    if (PROBE_REP & 512) { const int nslot = 128 + 2 * (nvb - 128); if (vb < 128) transpose_phase(tt2, smem, vb, nslot); else { transpose_phase(tt2, smem, 128 + 2 * (vb - 128), nslot); transpose_phase(tt2, smem, 129 + 2 * (vb - 128), nslot); } }
    GRID_BAR();
#if PROBE_CLK == 3
    const unsigned long long ck0 = __builtin_amdgcn_s_memtime(), rk0 = __builtin_amdgcn_s_memrealtime();
#endif
    attn_phase(P, smem, vb, nvb);
#if PROBE_CLK == 3
    { const unsigned long long ck1 = __builtin_amdgcn_s_memtime(), rk1 = __builtin_amdgcn_s_memrealtime(); if (vb == 7 && threadIdx.x == 0) *(float*)(ws + O_M2 + 128) = (float)(ck1 - ck0) / (float)(rk1 - rk0); }
#endif
    if (PROBE_REP & 2) attn_phase(P, smem, vb, nvb, O_MERGED, PROBE_PARTS);
    s5_phase<false>(P, smem, vb, nvb);
    if (PROBE_REP & 4) s5_phase<false>(P, smem, vb, nvb);
    GRID_BAR();
    { pg8::EpiGlu E{(const bf16_t*)(ws + O_YG), (bf16_t*)(ws + O_YSSM), P.in[12]}; big_gemm<pg8::EpiGlu, true>(smem, (const bf16_t*)(ws + O_YG), (const bf16_t*)(ws + O_WT_GLU), NTOK, 512, 512, E); }
    GRID_BAR();
    { pg8::EpiMergeDual E{(const bf16_t*)(ws + O_MG), (bf16_t*)(ws + O_MERGED)};
      big_gemm_dual<pg8::EpiMergeDual, true>(smem, (const bf16_t*)(ws + O_YSSM), (const bf16_t*)(ws + O_WT_PS), (const bf16_t*)(ws + O_YNSA), (const bf16_t*)(ws + O_WT_PN), NTOK, 1024, 512, E); }
    GRID_BAR();
    { pg8::EpiOut E{P.in[0], (bf16_t*)(ws + O_X1B), (float*)(ws + O_SSQ)}; big_gemm<pg8::EpiOut, true>(smem, (const bf16_t*)(ws + O_MERGED), (const bf16_t*)(ws + O_WT_OUT), NTOK, 1024, 1024, E); }
    GRID_BAR();
#if PROBE_CLK == 7
    const unsigned long long ck0 = __builtin_amdgcn_s_memtime(), rk0 = __builtin_amdgcn_s_memrealtime();
#endif
    { pg8::EpiUp E{(bf16_t*)(ws + O_FF), (const float*)(ws + O_SSQ)}; big_gemm<pg8::EpiUp, 2>(smem, (const bf16_t*)(ws + O_X1B), (const bf16_t*)(ws + O_WT_UP), NTOK, DFF, DM, E); }
#if PROBE_CLK == 7
    { const unsigned long long ck1 = __builtin_amdgcn_s_memtime(), rk1 = __builtin_amdgcn_s_memrealtime(); if (vb == 7 && threadIdx.x == 0) *(float*)(ws + O_M2 + 128) = (float)(ck1 - ck0) / (float)(rk1 - rk0); }
#endif
    GRID_BAR();
    { pg8::EpiDown E{(const bf16_t*)(ws + O_X1B), P.out, (const float*)(ws + O_SSQ)}; big_gemm<pg8::EpiDown, 2>(smem, (const bf16_t*)(ws + O_FF), (const bf16_t*)(ws + O_WT_DOWN), NTOK, DM, DFF, E); }
#if PROBE_CLK
    xcd_barrier(xbar); if (vb == 0 && threadIdx.x == 0) P.out[0] += 10.0f * (float)(int)(*(const float*)(ws + O_M2 + 128) + 0.5f);
#endif
    if (PROBE_STAMP >= 0) { xcd_barrier(xbar); STAMP(); if (vb == 0 && threadIdx.x == 0) P.out[0] += 8.0f * (float)(int)((float)(ts_b - ts_a) * 0.01f * 0.125f + 0.5f); }
}

static void add_tr(TrTable& tt, int& n, const float* src, bf16_t* dst, const float* kscale, int K, int N, int ldsrc, int mode) {
    TrDesc& d = tt.d[n]; d.src = src; d.dst = dst; d.kscale = kscale; d.K = K; d.N = N; d.ldsrc = ldsrc; d.mode = mode; d.tiles_n = N / 64; d.tile0 = tt.total;
    tt.total += (K / 64) * (N / 64); ++n;
}

extern "C" void kernel_launch(void* const* d_in, const int* in_sizes, int n_in, void* d_out, int out_size, void* d_ws, size_t ws_size, hipStream_t stream) {
    if (n_in != 27 || ws_size < WS_END) { fprintf(stderr, "kernel_launch: unexpected n_in %d or ws_size %zu (need %zu)\n", n_in, ws_size, (size_t)WS_END); return; }
    Ptrs P{};
    for (int i = 0; i < 27; ++i) P.in[i] = (const float*)d_in[i];
    P.out = (float*)d_out; P.ws = (unsigned char*)d_ws;
    unsigned char* ws = P.ws;
    TrTable tt{}, tt2{}; int n = 0, n2 = 0;
    add_tr(tt, n, P.in[2], (bf16_t*)(ws + O_WT_IN), nullptr, 1024, NIN, 3864, 1);
    add_tr(tt, n, P.in[15], (bf16_t*)(ws + O_WT_CK1), nullptr, 2048, 128, 128, 0);
    add_tr(tt, n, P.in[17], (bf16_t*)(ws + O_WT_CV1), nullptr, 2048, 128, 128, 0);
    add_tr(tt, n, P.in[16], (bf16_t*)(ws + O_WT_CK2), nullptr, 128, 64, 64, 0);
    add_tr(tt, n, P.in[18], (bf16_t*)(ws + O_WT_CV2), nullptr, 128, 64, 64, 0);
    add_tr(tt2, n2, P.in[25], (bf16_t*)(ws + O_WT_UP), P.in[24], 1024, 4096, 4096, 0);
    add_tr(tt2, n2, P.in[26], (bf16_t*)(ws + O_WT_DOWN), nullptr, 4096, 1024, 1024, 0);
    add_tr(tt2, n2, P.in[23], (bf16_t*)(ws + O_WT_OUT), nullptr, 1024, 1024, 1024, 0);
    add_tr(tt2, n2, P.in[21], (bf16_t*)(ws + O_WT_PS), nullptr, 512, 1024, 1024, 0);
    add_tr(tt2, n2, P.in[22], (bf16_t*)(ws + O_WT_PN), nullptr, 512, 1024, 1024, 0);
    add_tr(tt2, n2, P.in[11], (bf16_t*)(ws + O_WT_GLU), nullptr, 512, 512, 512, 0);
    tt.n = n; tt2.n = n2;
    static int grid_blocks = 0;
    if (!grid_blocks) {
        int dev = 0, cus = 0, per_cu = 0;
        (void)hipGetDevice(&dev);
        (void)hipDeviceGetAttribute(&cus, hipDeviceAttributeMultiprocessorCount, dev);
        (void)hipFuncSetAttribute((const void*)k_mega, hipFuncAttributeMaxDynamicSharedMemorySize, SMEM_BYTES);
        (void)hipOccupancyMaxActiveBlocksPerMultiprocessor(&per_cu, k_mega, NTHR, SMEM_BYTES);
        if (per_cu < 1) { fprintf(stderr, "kernel_launch: occupancy query returned %d\n", per_cu); per_cu = 1; }
        grid_blocks = cus;
    }
    (void)hipMemsetAsync(ws + O_BAR, 0, XCD_BAR_WORDS * sizeof(unsigned), stream);
    void* args[] = {(void*)&P, (void*)&tt, (void*)&tt2};
    const hipError_t e = hipLaunchCooperativeKernel((void*)k_mega, dim3(grid_blocks), dim3(NTHR), args, SMEM_BYTES, stream);
    if (e != hipSuccess) fprintf(stderr, "cooperative launch failed: %s (grid %d)\n", hipGetErrorString(e), grid_blocks);
}
```
